# Optimizing an MI355X kernel written in HIP

```python
import math
import jax, jax.numpy as jnp
from jax import lax
import numpy as np

D_MODEL = 1024
BATCH = 8
SEQ = 2048
DEPTH = 1

D_MIX = D_MODEL
D_SSM = D_MIX // 2
D_ATT = D_MIX - D_SSM
SSM_HEAD_DIM = 64
SSM_HEADS = D_SSM // SSM_HEAD_DIM
SSM_GROUPS = 2
SSM_STATE = 128
SSM_CONV = 4
SSM_CHUNK = 128
D_XBC = D_SSM + 2 * SSM_GROUPS * SSM_STATE
ATT_HEAD_DIM = 64
ATT_HEADS = D_ATT // ATT_HEAD_DIM
Q_BLOCK = 128
D_IN_SSM = D_SSM + D_XBC + SSM_HEADS
D_IN_ATT = 3 * D_ATT + ATT_HEADS
D_IN = D_IN_SSM + D_IN_ATT
N_EXPERT_GROUPS = 4
EXPERTS_PER_GROUP = 8
N_EXPERTS = N_EXPERT_GROUPS * EXPERTS_PER_GROUP
TOP_K = 2
D_EXPERT = D_MODEL // 2
MOE_BLOCK = 128
ALPHA = (2.0 * DEPTH) ** 0.25
BETA = (8.0 * DEPTH) ** -0.25
EPS = 1e-5

kernel_name = 'hymba_ssd_fox_hmoe_deepnorm'


def layer_norm(x, g, b):
    xf = x.astype(jnp.float32)
    mu = jnp.mean(xf, axis=-1, keepdims=True)
    var = jnp.mean(jnp.square(xf - mu), axis=-1, keepdims=True)
    return ((xf - mu) * lax.rsqrt(var + EPS) * g + b).astype(x.dtype)


def rms_norm(xf, g):
    return xf * lax.rsqrt(jnp.mean(xf * xf, axis=-1, keepdims=True) + EPS) * g


def causal_dwconv(x, w, b):
    K, C = w.shape
    y = lax.conv_general_dilated(x, w[:, None, :].astype(x.dtype), window_strides=(1,),
                                 padding=[(K - 1, 0)],
                                 dimension_numbers=('NWC', 'WIO', 'NWC'),
                                 feature_group_count=C)
    return y + b


def segsum_exp(a):
    L = a.shape[-1]
    cs = jnp.cumsum(a, axis=-1)
    diff = cs[..., :, None] - cs[..., None, :]
    mask = jnp.tril(jnp.ones((L, L), dtype=bool))
    return jnp.exp(jnp.where(mask, diff, -jnp.inf))


def ssd_mixer(zxbcdt, conv_w, conv_b, dt_bias, a_log, d_skip, norm_g):
    f32 = jnp.float32
    Bsz, T, _ = zxbcdt.shape
    nc = T // SSM_CHUNK
    R = SSM_HEADS // SSM_GROUPS
    z, xbc, dt = jnp.split(zxbcdt, [D_SSM, D_SSM + D_XBC], axis=-1)
    xbc = jax.nn.silu(causal_dwconv(xbc, conv_w, conv_b))
    xs, Bm, Cm = jnp.split(xbc, [D_SSM, D_SSM + SSM_GROUPS * SSM_STATE], axis=-1)
    dt = jax.nn.softplus(dt.astype(f32) + dt_bias)
    A = -jnp.exp(a_log.astype(f32)).reshape(SSM_GROUPS, R)
    x = xs.astype(f32).reshape(Bsz, nc, SSM_CHUNK, SSM_GROUPS, R, SSM_HEAD_DIM)
    Bc = Bm.astype(f32).reshape(Bsz, nc, SSM_CHUNK, SSM_GROUPS, SSM_STATE)
    Cc = Cm.astype(f32).reshape(Bsz, nc, SSM_CHUNK, SSM_GROUPS, SSM_STATE)
    dtc = dt.reshape(Bsz, nc, SSM_CHUNK, SSM_GROUPS, R)
    xdt = x * dtc[..., None]
    a = jnp.moveaxis(dtc * A, 2, -1)
    a_cs = jnp.cumsum(a, axis=-1)
    Lmat = segsum_exp(a)
    cb = jnp.einsum('bclgn,bcsgn->bcgls', Cc, Bc)
    y_diag = jnp.einsum('bcgls,bcgrls,bcsgrp->bclgrp', cb, Lmat, xdt)
    decay_states = jnp.exp(a_cs[..., -1:] - a_cs)
    states = jnp.einsum('bclgn,bcgrl,bclgrp->bcgrpn', Bc, decay_states, xdt)
    chunk_a = jnp.pad(jnp.moveaxis(a_cs[..., -1], 1, -1), [(0, 0), (0, 0), (0, 0), (1, 0)])
    decay_chunk = segsum_exp(chunk_a)
    states = jnp.pad(states, [(0, 0), (1, 0), (0, 0), (0, 0), (0, 0), (0, 0)])
    new_states = jnp.einsum('bgrzc,bcgrpn->bzgrpn', decay_chunk, states)
    prev_states = new_states[:, :-1]
    y_off = jnp.einsum('bclgn,bcgrpn,bcgrl->bclgrp', Cc, prev_states, jnp.exp(a_cs))
    y = y_diag + y_off + x * d_skip.reshape(SSM_GROUPS, R)[:, :, None]
    y = y.reshape(Bsz, T, D_SSM) * jax.nn.silu(z.astype(f32))
    y = y.reshape(Bsz, T, SSM_GROUPS, D_SSM // SSM_GROUPS)
    y = y * lax.rsqrt(jnp.mean(y * y, axis=-1, keepdims=True) + EPS)
    return y.reshape(Bsz, T, D_SSM) * norm_g


def forgetting_attention(qkvf, fg_bias, norm_g):
    f32 = jnp.float32
    Bsz, T, _ = qkvf.shape
    nb = T // Q_BLOCK
    q, k, v, f = jnp.split(qkvf, [D_ATT, 2 * D_ATT, 3 * D_ATT], axis=-1)
    q = q.reshape(Bsz, T, ATT_HEADS, ATT_HEAD_DIM)
    k = k.reshape(Bsz, T, ATT_HEADS, ATT_HEAD_DIM)
    v = v.reshape(Bsz, T, ATT_HEADS, ATT_HEAD_DIM)
    log_f = jax.nn.log_sigmoid(f.astype(f32) + fg_bias)
    cum = jnp.transpose(jnp.cumsum(log_f, axis=1), (0, 2, 1))
    scale = ATT_HEAD_DIM ** -0.5
    q_blocks = jnp.moveaxis(q.reshape(Bsz, nb, Q_BLOCK, ATT_HEADS, ATT_HEAD_DIM), 1, 0)
    cq_blocks = jnp.moveaxis(cum.reshape(Bsz, ATT_HEADS, nb, Q_BLOCK), 2, 0)
    q_pos = jnp.arange(T, dtype=jnp.int32).reshape(nb, Q_BLOCK)
    k_pos = jnp.arange(T, dtype=jnp.int32)

    def one_block(args):
        qb, cqb, pb = args
        s = jnp.einsum('bqhd,bkhd->bhqk', qb, k).astype(f32) * scale
        s = s + (cqb[..., :, None] - cum[..., None, :])
        s = jnp.where(pb[:, None] >= k_pos[None, :], s, -jnp.inf)
        p = jax.nn.softmax(s, axis=-1)
        return jnp.einsum('bhqk,bkhd->bqhd', p, v.astype(f32))

    out = lax.map(one_block, (q_blocks, cq_blocks, q_pos))
    out = jnp.moveaxis(out, 0, 1).reshape(Bsz, T, D_ATT)
    return rms_norm(out, norm_g)


def hybrid_mixer(u, w_in, conv_w, conv_b, dt_bias, a_log, d_skip, ssm_norm_g,
                 fg_bias, att_norm_g, w_out):
    proj = u @ w_in
    ssm_in, att_in = jnp.split(proj, [D_IN_SSM], axis=-1)
    y_ssm = ssd_mixer(ssm_in, conv_w, conv_b, dt_bias, a_log, d_skip, ssm_norm_g)
    y_att = forgetting_attention(att_in, fg_bias, att_norm_g)
    y = jnp.concatenate([y_ssm, y_att], axis=-1).astype(u.dtype)
    return y @ w_out


def hier_moe(u, router_g_w, router_g_b, router_e_w, router_e_b, w_gate, w_up, w_down):
    f32 = jnp.float32
    Bsz, T, D = u.shape
    N = Bsz * T
    xf = u.reshape(N, D)
    g_prob = jax.nn.softmax((xf @ router_g_w).astype(f32) + router_g_b, axis=-1)
    g_idx = jnp.argmax(g_prob, axis=-1)
    g_p = jnp.take_along_axis(g_prob, g_idx[:, None], axis=-1)[:, 0]
    e_logits = ((xf @ router_e_w).astype(f32) + router_e_b).reshape(N, N_EXPERT_GROUPS, EXPERTS_PER_GROUP)
    e_sel = jnp.take_along_axis(e_logits, g_idx[:, None, None], axis=1)[:, 0]
    top_p, top_local = lax.top_k(jax.nn.softmax(e_sel, axis=-1), TOP_K)
    top_p = top_p / jnp.sum(top_p, axis=-1, keepdims=True)
    weights = g_p[:, None] * top_p
    experts = g_idx[:, None] * EXPERTS_PER_GROUP + top_local
    A = N * TOP_K
    flat_e = experts.reshape(A).astype(jnp.int32)
    flat_w = weights.reshape(A)
    flat_tok = jnp.arange(A, dtype=jnp.int32) // TOP_K
    order = jnp.argsort(flat_e, stable=True)
    sorted_e = flat_e[order]
    counts = jnp.bincount(flat_e, length=N_EXPERTS)
    padded = (counts + MOE_BLOCK - 1) // MOE_BLOCK * MOE_BLOCK
    start = jnp.cumsum(counts) - counts
    pad_end = jnp.cumsum(padded)
    pad_start = pad_end - padded
    dest = pad_start[sorted_e] + (jnp.arange(A, dtype=jnp.int32) - start[sorted_e])
    P = A + N_EXPERTS * MOE_BLOCK
    n_blocks = P // MOE_BLOCK
    row_tok = jnp.full((P,), N, dtype=jnp.int32).at[dest].set(flat_tok[order])
    row_w = jnp.zeros((P,), f32).at[dest].set(flat_w[order])
    block_e = jnp.minimum(jnp.searchsorted(pad_end, jnp.arange(n_blocks) * MOE_BLOCK, side='right'),
                          N_EXPERTS - 1)
    x_pad = jnp.concatenate([xf, jnp.zeros((1, D), xf.dtype)], axis=0)
    x_rows = x_pad[row_tok].reshape(n_blocks, MOE_BLOCK, D)

    def expert_block(args):
        xb, e = args
        h = jax.nn.silu(xb @ w_gate[e]) * (xb @ w_up[e])
        return h @ w_down[e]

    y_rows = lax.map(expert_block, (x_rows, block_e)).reshape(P, D)
    out = jax.ops.segment_sum(y_rows.astype(f32) * row_w[:, None], row_tok, num_segments=N + 1)[:N]
    return out.reshape(Bsz, T, D).astype(u.dtype)


def setup_inputs(seed: int = 0) -> dict:
    key = jax.random.key(seed)
    ks = jax.random.split(key, 26)
    L, D = DEPTH, D_MODEL
    f32 = jnp.float32

    def nrm(k, shape, s):
        return s * jax.random.normal(k, shape, f32)

    dt0 = jnp.exp(jax.random.uniform(ks[7], (L, SSM_HEADS), f32, minval=math.log(1e-3), maxval=math.log(1e-1)))
    return {
        'x': nrm(ks[0], (BATCH, SEQ, D), 1.0),
        'c': nrm(ks[1], (BATCH, D), 1.0),
        'ada_w': nrm(ks[2], (L, D, 6 * D), 0.1 * D ** -0.5),
        'ada_b': nrm(ks[3], (L, 6 * D), 0.02),
        'w_in': nrm(ks[4], (L, D, D_IN), D ** -0.5),
        'conv_w': nrm(ks[5], (L, SSM_CONV, D_XBC), SSM_CONV ** -0.5),
        'conv_b': nrm(ks[6], (L, D_XBC), 0.02),
        'dt_bias': dt0 + jnp.log(-jnp.expm1(-dt0)),
        'a_log': jnp.log(jax.random.uniform(ks[8], (L, SSM_HEADS), f32, minval=1.0, maxval=16.0)),
        'd_skip': 1.0 + nrm(ks[9], (L, SSM_HEADS), 0.1),
        'ssm_norm_g': 1.0 + nrm(ks[10], (L, D_SSM), 0.02),
        'fg_bias': jax.random.uniform(ks[11], (L, ATT_HEADS), f32, minval=1.0, maxval=5.0),
        'att_norm_g': 1.0 + nrm(ks[12], (L, D_ATT), 0.02),
        'w_out': nrm(ks[13], (L, D_MIX, D), BETA * D_MIX ** -0.5),
        'ln1_g': 1.0 + nrm(ks[14], (L, D), 0.02),
        'ln1_b': nrm(ks[15], (L, D), 0.02),
        'router_g_w': nrm(ks[16], (L, D, N_EXPERT_GROUPS), D ** -0.5),
        'router_g_b': nrm(ks[17], (L, N_EXPERT_GROUPS), 0.01),
        'router_e_w': nrm(ks[18], (L, D, N_EXPERTS), D ** -0.5),
        'router_e_b': nrm(ks[19], (L, N_EXPERTS), 0.01),
        'w_gate': nrm(ks[20], (L, N_EXPERTS, D, D_EXPERT), D ** -0.5),
        'w_up': nrm(ks[21], (L, N_EXPERTS, D, D_EXPERT), D ** -0.5),
        'w_down': nrm(ks[22], (L, N_EXPERTS, D_EXPERT, D), BETA * D_EXPERT ** -0.5),
        'ln2_g': 1.0 + nrm(ks[23], (L, D), 0.02),
        'ln2_b': nrm(ks[24], (L, D), 0.02),
    }


def reference(x, c, ada_w, ada_b, w_in, conv_w, conv_b, dt_bias, a_log, d_skip, ssm_norm_g,
              fg_bias, att_norm_g, w_out, ln1_g, ln1_b, router_g_w, router_g_b, router_e_w,
              router_e_b, w_gate, w_up, w_down, ln2_g, ln2_b):
    for l in range(DEPTH):
        mod = jax.nn.silu(c) @ ada_w[l] + ada_b[l]
        sh1, sc1, gt1, sh2, sc2, gt2 = [m[:, None, :] for m in jnp.split(mod, 6, axis=-1)]
        u = x * (1.0 + sc1) + sh1
        h = hybrid_mixer(u, w_in[l], conv_w[l], conv_b[l], dt_bias[l], a_log[l], d_skip[l],
                         ssm_norm_g[l], fg_bias[l], att_norm_g[l], w_out[l])
        x = layer_norm(ALPHA * x + (1.0 + gt1) * h, ln1_g[l], ln1_b[l])
        u = x * (1.0 + sc2) + sh2
        h = hier_moe(u, router_g_w[l], router_g_b[l], router_e_w[l], router_e_b[l],
                     w_gate[l], w_up[l], w_down[l])
        x = layer_norm(ALPHA * x + (1.0 + gt2) * h, ln2_g[l], ln2_b[l])
    return x
```

```cpp
#include <hip/hip_runtime.h>
#include <cstdio>
#include <cstdint>

constexpr int NB = 8, T = 2048, D = 1024, M = NB * T;
constexpr int DSSM = 512, DATT = 512, HD = 64, NH = 8, NG = 2, NST = 128, DXBC = 1024, DIN = 3088;
constexpr int NE = 32, DE = 512, LCAP = 16384;
constexpr int PW = 3072;
constexpr int PC_Z = 0, PC_XS = 512, PC_Q = 1536, PC_K = 2048, PC_V = 2560;
constexpr float ALPHA = 1.189207115002721f;
constexpr float EPS = 1e-5f;
constexpr float LOG2E = 1.4426950408889634f;
constexpr float QSCALE = 0.125f * LOG2E;
constexpr int MAXSLOT = 160 * 256;

constexpr size_t MiB = 1u << 20;
constexpr size_t WS_CTL = 0, CTL_ZERO_BYTES = 1 * MiB;
constexpr size_t WS_WIN = 1 * MiB, WS_WOUT = 7 * MiB, WS_WGU = 9 * MiB, WS_WDN = 73 * MiB;
constexpr size_t WS_A = 105 * MiB;
constexpr size_t WS_B = 137 * MiB;
constexpr size_t WS_YK1 = 233 * MiB;
constexpr size_t WS_MISC = 265 * MiB;
constexpr size_t WS_MOD = WS_MISC;
constexpr size_t WS_DTF = WS_MISC + 1 * MiB;
constexpr size_t WS_CK = WS_MISC + 2 * MiB;
constexpr size_t WS_TOKE = WS_MISC + 3 * MiB;
constexpr size_t WS_TOKW = WS_TOKE + 256 * 1024;
constexpr size_t WS_TOKS = WS_TOKW + 256 * 1024;
constexpr size_t WS_LIST = WS_MISC + 4 * MiB;
constexpr size_t WS_END = 272 * MiB;
constexpr int CW_CNT = 1024;

typedef unsigned short bf16;
typedef float f32x4 __attribute__((ext_vector_type(4)));
typedef unsigned u32x4 __attribute__((ext_vector_type(4)));
typedef unsigned u32x2 __attribute__((ext_vector_type(2)));

__device__ __forceinline__ unsigned f2bf(float f) { unsigned u = __builtin_bit_cast(unsigned, f); return (u + 0x7fffu + ((u >> 16) & 1u)) >> 16; }
__device__ __forceinline__ float bf2f(unsigned b) { return __builtin_bit_cast(float, (b & 0xffffu) << 16); }
__device__ __forceinline__ unsigned pk2(float lo, float hi) { return f2bf(lo) | (f2bf(hi) << 16); }
__device__ __forceinline__ float silu_f(float x) { return x / (1.f + expf(-x)); }
__device__ __forceinline__ float softplus_f(float x) { return fmaxf(x, 0.f) + log1pf(expf(-fabsf(x))); }
__device__ __forceinline__ float wave_sum(float v) {
#pragma unroll
    for (int o = 1; o < 64; o <<= 1) v += __shfl_xor(v, o);
    return v;
}

namespace nv {
__global__ void __launch_bounds__(256) k_mod(const float* c, const float* ada_w, const float* ada_b, float* mod) {
    const int j = blockIdx.x * 256 + threadIdx.x;
    __shared__ float sc[NB][D];
    for (int i = threadIdx.x; i < NB * D; i += 256) sc[i / D][i % D] = silu_f(c[i]);
    __syncthreads();
    float acc[NB];
#pragma unroll
    for (int b = 0; b < NB; ++b) acc[b] = 0.f;
    for (int k = 0; k < D; ++k) { const float w = ada_w[(size_t)k * 6144 + j];
#pragma unroll
        for (int b = 0; b < NB; ++b) acc[b] += sc[b][k] * w; }
#pragma unroll
    for (int b = 0; b < NB; ++b) mod[b * 6144 + j] = acc[b] + ada_b[j];
}

template <bool DUAL, class Ctx>
__global__ void __launch_bounds__(256) k_gemm(Ctx cx) {
    __shared__ float As[16][68], Bs[16][68], Bs2[DUAL ? 16 : 1][68];
    __shared__ int s_info[4];
    if (!cx.setup(s_info)) return;
    __syncthreads();
    const int tm = blockIdx.y * 64, tn = blockIdx.x * 64, tid = threadIdx.x, tx = tid & 15, ty = tid >> 4;
    const int K = cx.K();
    float acc[4][4], acc2[4][4];
#pragma unroll
    for (int i = 0; i < 4; ++i)
#pragma unroll
        for (int j = 0; j < 4; ++j) { acc[i][j] = 0.f; acc2[i][j] = 0.f; }
    for (int k0 = 0; k0 < K; k0 += 16) {
#pragma unroll
        for (int i = 0; i < 4; ++i) { const int idx = tid + i * 256, r = idx >> 4, kk = idx & 15; As[kk][r] = cx.a(s_info, tm + r, k0 + kk); }
#pragma unroll
        for (int i = 0; i < 4; ++i) { const int idx = tid + i * 256, kk = idx >> 6, n = idx & 63; Bs[kk][n] = cx.b(s_info, k0 + kk, tn + n); if (DUAL) Bs2[kk][n] = cx.b2(s_info, k0 + kk, tn + n); }
        __syncthreads();
#pragma unroll
        for (int kk = 0; kk < 16; ++kk) {
            float a[4], b[4], b2[4];
#pragma unroll
            for (int i = 0; i < 4; ++i) { a[i] = As[kk][ty * 4 + i]; b[i] = Bs[kk][tx * 4 + i]; b2[i] = DUAL ? Bs2[kk][tx * 4 + i] : 0.f; }
#pragma unroll
            for (int i = 0; i < 4; ++i)
#pragma unroll
                for (int j = 0; j < 4; ++j) { acc[i][j] += a[i] * b[j]; if (DUAL) acc2[i][j] += a[i] * b2[j]; }
        }
        __syncthreads();
    }
#pragma unroll
    for (int i = 0; i < 4; ++i)
#pragma unroll
        for (int j = 0; j < 4; ++j) cx.epi(s_info, tm + ty * 4 + i, tn + tx * 4 + j, acc[i][j], acc2[i][j]);
}

struct CxIn {
    const float* x; const float* mod; const float* w; bf16* proj; float* dtf;
    __device__ bool setup(int*) const { return true; }
    __device__ int K() const { return D; }
    __device__ float a(const int*, int m, int k) const { const int b = m / T; return x[(size_t)m * D + k] * (1.f + mod[b * 6144 + D + k]) + mod[b * 6144 + k]; }
    __device__ float b(const int*, int k, int n) const { return n < DIN ? w[(size_t)k * DIN + n] : 0.f; }
    __device__ float b2(const int*, int, int) const { return 0.f; }
    __device__ void epi(const int*, int m, int n, float v, float) const {
        if (n >= DIN) return;
        if (n < 1536) proj[(size_t)m * PW + n] = (bf16)f2bf(v);
        else if (n < 1544) dtf[m * 16 + (n - 1536)] = v;
        else if (n < 3080) { const int c = n - 8; proj[(size_t)m * PW + c] = (bf16)f2bf(c < PC_K ? v * QSCALE : v); }
        else dtf[m * 16 + 8 + (n - 3080)] = v;
    }
};
struct CxOut {
    const bf16* ycat; const float* w; float* h;
    __device__ bool setup(int*) const { return true; }
    __device__ int K() const { return D; }
    __device__ float a(const int*, int m, int k) const { return bf2f(ycat[(size_t)m * D + k]); }
    __device__ float b(const int*, int k, int n) const { return w[(size_t)k * D + n]; }
    __device__ float b2(const int*, int, int) const { return 0.f; }
    __device__ void epi(const int*, int m, int n, float v, float) const { h[(size_t)m * D + n] = v; }
};
__device__ __forceinline__ bool moe_setup(const unsigned* cnt, int* s_info) {
    const int e = blockIdx.z; const int n = (int)cnt[e];
    if ((int)blockIdx.y * 64 >= n) return false;
    if (threadIdx.x == 0) { int base = 0; for (int i = 0; i < e; ++i) base += ((int)cnt[i] + 255) / 256 * 256; s_info[0] = e; s_info[1] = n; s_info[2] = base; }
    return true;
}
struct CxMoe1 {
    const unsigned* cnt; const int* list; const bf16* u2; const float* wg; const float* wu; bf16* hmid;
    __device__ bool setup(int* s) const { return moe_setup(cnt, s); }
    __device__ int K() const { return D; }
    __device__ float a(const int* s, int m, int k) const { if (m >= s[1]) return 0.f; const int tok = list[s[0] * LCAP + m] >> 1; return bf2f(u2[(size_t)tok * D + k]); }
    __device__ float b(const int* s, int k, int n) const { return wg[((size_t)s[0] * D + k) * DE + n]; }
    __device__ float b2(const int* s, int k, int n) const { return wu[((size_t)s[0] * D + k) * DE + n]; }
    __device__ void epi(const int* s, int m, int n, float g, float u) const { if (m >= s[1]) return; hmid[(size_t)(s[2] + m) * DE + n] = (bf16)f2bf(silu_f(g) * u); }
};
struct CxMoe2 {
    const unsigned* cnt; const int* list; const bf16* hmid; const float* wd; bf16* yk0; bf16* yk1;
    __device__ bool setup(int* s) const { return moe_setup(cnt, s); }
    __device__ int K() const { return DE; }
    __device__ float a(const int* s, int m, int k) const { if (m >= s[1]) return 0.f; return bf2f(hmid[(size_t)(s[2] + m) * DE + k]); }
    __device__ float b(const int* s, int k, int n) const { return wd[((size_t)s[0] * DE + k) * D + n]; }
    __device__ float b2(const int*, int, int) const { return 0.f; }
    __device__ void epi(const int* s, int m, int n, float v, float) const { if (m >= s[1]) return; const int a = list[s[0] * LCAP + m]; bf16* y = (a & 1) ? yk1 : yk0; y[(size_t)(a >> 1) * D + n] = (bf16)f2bf(v); }
};

__global__ void k_cumf(const float* dtf, const float* fg_bias, float* ck) {
    const int bh = blockIdx.x * blockDim.x + threadIdx.x; if (bh >= NB * NH) return;
    const int b = bh / NH, h = bh % NH; const float fb = fg_bias[h]; float s = 0.f;
    for (int t = 0; t < T; ++t) { const float f = dtf[(size_t)(b * T + t) * 16 + 8 + h] + fb; s += -softplus_f(-f); ck[(size_t)bh * T + t] = s; }
}
__global__ void __launch_bounds__(256) k_conv(const bf16* proj, const float* cw, const float* cb, float* xact) {
    const size_t i = (size_t)blockIdx.x * 256 + threadIdx.x; const int m = (int)(i / DXBC), ch = (int)(i % DXBC), t = m % T;
    float acc = cb[ch];
#pragma unroll
    for (int j = 0; j < 4; ++j) { const int tt = t - 3 + j; if (tt >= 0) acc += cw[j * DXBC + ch] * bf2f(proj[(size_t)(m - 3 + j) * PW + PC_XS + ch]); }
    xact[i] = silu_f(acc);
}
__global__ void __launch_bounds__(256) k_ssd(const float* xact, const float* dtf, const float* dt_bias, const float* a_log, const float* d_skip, float* ypre) {
    const int b = blockIdx.x / NH, h = blockIdx.x % NH, g = h / 4, p = threadIdx.x >> 2, nq = threadIdx.x & 3;
    const float A = -expf(a_log[h]), Dh = d_skip[h], dtb = dt_bias[h];
    float st[32];
#pragma unroll
    for (int i = 0; i < 32; ++i) st[i] = 0.f;
    for (int t = 0; t < T; ++t) {
        const size_t m = (size_t)b * T + t;
        const float dtv = softplus_f(dtf[m * 16 + h] + dtb), dA = expf(dtv * A);
        const float xv = xact[m * DXBC + h * 64 + p], xd = xv * dtv;
        const f32x4* Bp = (const f32x4*)(xact + m * DXBC + 512 + g * 128 + nq * 32);
        const f32x4* Cp = (const f32x4*)(xact + m * DXBC + 768 + g * 128 + nq * 32);
        float y = 0.f;
#pragma unroll
        for (int i = 0; i < 8; ++i) { const f32x4 bv = Bp[i], cv = Cp[i];
#pragma unroll
            for (int j = 0; j < 4; ++j) { st[i * 4 + j] = dA * st[i * 4 + j] + xd * bv[j]; y += cv[j] * st[i * 4 + j]; } }
        y += __shfl_xor(y, 1); y += __shfl_xor(y, 2);
        if (nq == 0) ypre[m * DSSM + h * 64 + p] = y + Dh * xv;
    }
}
__global__ void __launch_bounds__(256) k_ssm_norm(const float* ypre, const bf16* proj, const float* ng, bf16* ycat) {
    const int w = (blockIdx.x * 256 + threadIdx.x) >> 6, lane = threadIdx.x & 63, m = w >> 1, g = w & 1;
    float v[4]; float ss = 0.f;
#pragma unroll
    for (int j = 0; j < 4; ++j) { const int c = g * 256 + lane * 4 + j; v[j] = ypre[(size_t)m * DSSM + c] * silu_f(bf2f(proj[(size_t)m * PW + PC_Z + c])); ss += v[j] * v[j]; }
    const float r = 1.f / sqrtf(wave_sum(ss) * (1.f / 256.f) + EPS);
#pragma unroll
    for (int j = 0; j < 4; ++j) { const int c = g * 256 + lane * 4 + j; ycat[(size_t)m * D + c] = (bf16)f2bf(v[j] * r * ng[c]); }
}
__global__ void __launch_bounds__(64) k_attn(bf16* proj, const float* ck) {
    __shared__ float Ks[64][64], Vs[64][64], cks[64];
    const int blk = blockIdx.x, qt = blk % 32, bh = blk / 32, b = bh / NH, h = bh % NH, lane = threadIdx.x;
    const int q = qt * 64 + lane; const size_t mq = (size_t)b * T + q;
    float Q[64], O[64];
#pragma unroll
    for (int d = 0; d < 64; ++d) { Q[d] = bf2f(proj[mq * PW + PC_Q + h * 64 + d]); O[d] = 0.f; }
    const float cq = ck[(size_t)bh * T + q];
    float mrun = -INFINITY, lrun = 0.f;
    for (int kt = 0; kt <= qt; ++kt) {
        __syncthreads();
        for (int i = lane; i < 64 * 64; i += 64) { const int r = i >> 6, d = i & 63; const size_t mk = (size_t)b * T + kt * 64 + r;
            Ks[r][d] = bf2f(proj[mk * PW + PC_K + h * 64 + d]); Vs[r][d] = bf2f(proj[mk * PW + PC_V + h * 64 + d]); }
        cks[lane] = ck[(size_t)bh * T + kt * 64 + lane];
        __syncthreads();
        const int jmax = (kt == qt) ? lane : 63;
        for (int j = 0; j <= jmax; ++j) {
            float s = 0.f;
#pragma unroll
            for (int d = 0; d < 64; ++d) s += Q[d] * Ks[j][d];
            s += (cq - cks[j]) * LOG2E;
            const float mn = fmaxf(mrun, s), al = exp2f(mrun - mn), pj = exp2f(s - mn);
            lrun = lrun * al + pj; mrun = mn;
#pragma unroll
            for (int d = 0; d < 64; ++d) O[d] = O[d] * al + pj * Vs[j][d];
        }
    }
    const float il = 1.f / lrun;
#pragma unroll
    for (int d = 0; d < 64; ++d) proj[mq * PW + PC_Q + h * 64 + d] = (bf16)f2bf(O[d] * il);
}
__global__ void __launch_bounds__(256) k_attn_norm(const bf16* proj, const float* ng, bf16* ycat) {
    const int m = (blockIdx.x * 256 + threadIdx.x) >> 6, lane = threadIdx.x & 63;
    float v[8]; float ss = 0.f;
#pragma unroll
    for (int j = 0; j < 8; ++j) { v[j] = bf2f(proj[(size_t)m * PW + PC_Q + lane * 8 + j]); ss += v[j] * v[j]; }
    const float r = 1.f / sqrtf(wave_sum(ss) * (1.f / 512.f) + EPS);
#pragma unroll
    for (int j = 0; j < 8; ++j) ycat[(size_t)m * D + 512 + lane * 8 + j] = (bf16)f2bf(v[j] * r * ng[lane * 8 + j]);
}
__global__ void __launch_bounds__(256) k_ln1_router(const float* x, float* hx1, const float* mod, const float* g1, const float* b1,
                                                    const float* rgw, const float* rgb, const float* rew, const float* reb,
                                                    bf16* u2, unsigned* cnt, int* list, int* toke, float* tokw, int* toks) {
    const int m = (blockIdx.x * 256 + threadIdx.x) >> 6, lane = threadIdx.x & 63, b = m / T;
    const float* mb = mod + b * 6144;
    float v[16]; float s = 0.f;
#pragma unroll
    for (int j = 0; j < 4; ++j) { const int c = 4 * lane + 256 * j; const f32x4 xv = *(const f32x4*)(x + (size_t)m * D + c), hv = *(const f32x4*)(hx1 + (size_t)m * D + c), gt = *(const f32x4*)(mb + 2 * D + c);
#pragma unroll
        for (int i = 0; i < 4; ++i) { v[j * 4 + i] = ALPHA * xv[i] + (1.f + gt[i]) * hv[i]; s += v[j * 4 + i]; } }
    const float mean = wave_sum(s) * (1.f / D); float s2 = 0.f;
#pragma unroll
    for (int i = 0; i < 16; ++i) { v[i] -= mean; s2 += v[i] * v[i]; }
    const float rstd = 1.f / sqrtf(wave_sum(s2) * (1.f / D) + EPS);
    float acc[36];
#pragma unroll
    for (int i = 0; i < 36; ++i) acc[i] = 0.f;
#pragma unroll
    for (int j = 0; j < 4; ++j) { const int c = 4 * lane + 256 * j; const f32x4 gg = *(const f32x4*)(g1 + c), bb = *(const f32x4*)(b1 + c), sc = *(const f32x4*)(mb + 4 * D + c), sh = *(const f32x4*)(mb + 3 * D + c);
        f32x4 x1, uu;
#pragma unroll
        for (int i = 0; i < 4; ++i) { x1[i] = v[j * 4 + i] * rstd * gg[i] + bb[i]; uu[i] = x1[i] * (1.f + sc[i]) + sh[i]; }
        *(f32x4*)(hx1 + (size_t)m * D + c) = x1;
        u32x2 pk; pk.x = pk2(uu[0], uu[1]); pk.y = pk2(uu[2], uu[3]); *(u32x2*)(u2 + (size_t)m * D + c) = pk;
#pragma unroll
        for (int i = 0; i < 4; ++i) { const int k = c + i; const f32x4 wg = *(const f32x4*)(rgw + (size_t)k * 4);
#pragma unroll
            for (int q = 0; q < 4; ++q) acc[q] += uu[i] * wg[q];
#pragma unroll
            for (int q8 = 0; q8 < 8; ++q8) { const f32x4 we = *(const f32x4*)(rew + (size_t)k * 32 + q8 * 4);
#pragma unroll
                for (int q = 0; q < 4; ++q) acc[4 + q8 * 4 + q] += uu[i] * we[q]; } } }
#pragma unroll
    for (int i = 0; i < 36; ++i) acc[i] = wave_sum(acc[i]);
    float lg[4]; float mx = -INFINITY; int gi = 0;
#pragma unroll
    for (int i = 0; i < 4; ++i) { lg[i] = acc[i] + rgb[i]; if (lg[i] > mx) { mx = lg[i]; gi = i; } }
    float se = 0.f;
#pragma unroll
    for (int i = 0; i < 4; ++i) se += expf(lg[i] - mx);
    const float gp = 1.f / se;
    float le[8]; float mxe = -INFINITY;
#pragma unroll
    for (int i = 0; i < 8; ++i) { float t = 0.f;
#pragma unroll
        for (int gq = 0; gq < 4; ++gq) t = (gi == gq) ? acc[4 + gq * 8 + i] + reb[gq * 8 + i] : t;
        le[i] = t; mxe = fmaxf(mxe, t); }
    float pe[8];
#pragma unroll
    for (int i = 0; i < 8; ++i) pe[i] = expf(le[i] - mxe);
    int i1 = 0; float p1 = -1.f;
#pragma unroll
    for (int i = 0; i < 8; ++i) if (pe[i] > p1) { p1 = pe[i]; i1 = i; }
    int i2 = 0; float p2 = -1.f;
#pragma unroll
    for (int i = 0; i < 8; ++i) if (i != i1 && pe[i] > p2) { p2 = pe[i]; i2 = i; }
    const float inv = 1.f / (p1 + p2);
    if (lane == 0) {
        const int e0 = gi * 8 + i1, e1 = gi * 8 + i2;
        const unsigned q0 = atomicAdd(&cnt[e0], 1u), q1 = atomicAdd(&cnt[e1], 1u);
        list[e0 * LCAP + q0] = m * 2; list[e1 * LCAP + q1] = m * 2 + 1;
        toke[m * 2] = e0; toke[m * 2 + 1] = e1; tokw[m * 2] = gp * p1 * inv; tokw[m * 2 + 1] = gp * p2 * inv; toks[m * 2] = (int)q0; toks[m * 2 + 1] = (int)q1;
    }
}
__global__ void __launch_bounds__(256) k_final(float* out, const float* mod, const bf16* yk0, const bf16* yk1, const float* tokw, const float* g2, const float* b2) {
    const int m = (blockIdx.x * 256 + threadIdx.x) >> 6, lane = threadIdx.x & 63, b = m / T;
    const float* mb = mod + b * 6144; const float w0 = tokw[m * 2], w1 = tokw[m * 2 + 1];
    float v[16]; float s = 0.f;
#pragma unroll
    for (int j = 0; j < 4; ++j) { const int c = 4 * lane + 256 * j; const f32x4 xv = *(const f32x4*)(out + (size_t)m * D + c), gt = *(const f32x4*)(mb + 5 * D + c);
        const u32x2 a = *(const u32x2*)(yk0 + (size_t)m * D + c), bq = *(const u32x2*)(yk1 + (size_t)m * D + c);
        const float y0[4] = {bf2f(a.x), bf2f(a.x >> 16), bf2f(a.y), bf2f(a.y >> 16)}, y1[4] = {bf2f(bq.x), bf2f(bq.x >> 16), bf2f(bq.y), bf2f(bq.y >> 16)};
#pragma unroll
        for (int i = 0; i < 4; ++i) { v[j * 4 + i] = ALPHA * xv[i] + (1.f + gt[i]) * (w0 * y0[i] + w1 * y1[i]); s += v[j * 4 + i]; } }
    const float mean = wave_sum(s) * (1.f / D); float s2 = 0.f;
#pragma unroll
    for (int i = 0; i < 16; ++i) { v[i] -= mean; s2 += v[i] * v[i]; }
    const float rstd = 1.f / sqrtf(wave_sum(s2) * (1.f / D) + EPS);
#pragma unroll
    for (int j = 0; j < 4; ++j) { const int c = 4 * lane + 256 * j; const f32x4 gg = *(const f32x4*)(g2 + c), bb = *(const f32x4*)(b2 + c); f32x4 o;
#pragma unroll
        for (int i = 0; i < 4; ++i) o[i] = v[j * 4 + i] * rstd * gg[i] + bb[i];
        *(f32x4*)(out + (size_t)m * D + c) = o; }
}
}

extern "C" void kernel_launch(void* const* d_in, const int* in_sizes, int n_in, void* d_out, int out_size, void* d_ws, size_t ws_size, hipStream_t stream) {
    if (n_in != 25 || in_sizes[0] != M * D || out_size != M * D || ws_size < WS_END) { fprintf(stderr, "kernel_launch: unexpected shapes / workspace (%zu)\n", ws_size); return; }
    const float* x = (const float*)d_in[0]; const float* c = (const float*)d_in[1]; const float* ada_w = (const float*)d_in[2]; const float* ada_b = (const float*)d_in[3];
    const float* w_in = (const float*)d_in[4]; const float* conv_w = (const float*)d_in[5]; const float* conv_b = (const float*)d_in[6]; const float* dt_bias = (const float*)d_in[7];
    const float* a_log = (const float*)d_in[8]; const float* d_skip = (const float*)d_in[9]; const float* ssm_ng = (const float*)d_in[10]; const float* fg_bias = (const float*)d_in[11];
    const float* att_ng = (const float*)d_in[12]; const float* w_out = (const float*)d_in[13]; const float* ln1_g = (const float*)d_in[14]; const float* ln1_b = (const float*)d_in[15];
    const float* rgw = (const float*)d_in[16]; const float* rgb = (const float*)d_in[17]; const float* rew = (const float*)d_in[18]; const float* reb = (const float*)d_in[19];
    const float* w_gate = (const float*)d_in[20]; const float* w_up = (const float*)d_in[21]; const float* w_down = (const float*)d_in[22]; const float* ln2_g = (const float*)d_in[23]; const float* ln2_b = (const float*)d_in[24];
    unsigned char* ws = (unsigned char*)d_ws; float* out = (float*)d_out;
    unsigned* ctl = (unsigned*)(ws + WS_CTL); unsigned* cnt = ctl + CW_CNT;
    float* mod = (float*)(ws + WS_MOD); float* dtf = (float*)(ws + WS_DTF); float* ck = (float*)(ws + WS_CK);
    int* toke = (int*)(ws + WS_TOKE); float* tokw = (float*)(ws + WS_TOKW); int* toks = (int*)(ws + WS_TOKS); int* list = (int*)(ws + WS_LIST);
    bf16* proj = (bf16*)(ws + WS_B); bf16* ycat = (bf16*)(ws + WS_A); bf16* u2 = (bf16*)(ws + WS_B); bf16* hmid = (bf16*)(ws + WS_B + 32 * MiB);
    bf16* yk0 = (bf16*)(ws + WS_A); bf16* yk1 = (bf16*)(ws + WS_YK1); float* ypre = (float*)(ws + WS_YK1); float* xact = out;

    hipMemsetAsync(ws + WS_CTL, 0, CTL_ZERO_BYTES, stream);
    nv::k_mod<<<6144 / 256, 256, 0, stream>>>(c, ada_w, ada_b, mod);
    { nv::CxIn cx{x, mod, w_in, proj, dtf}; nv::k_gemm<false, nv::CxIn><<<dim3((DIN + 63) / 64, M / 64, 1), 256, 0, stream>>>(cx); }
    nv::k_cumf<<<1, 64, 0, stream>>>(dtf, fg_bias, ck);
    nv::k_conv<<<(M * DXBC) / 256, 256, 0, stream>>>(proj, conv_w, conv_b, xact);
    nv::k_ssd<<<NB * NH, 256, 0, stream>>>(xact, dtf, dt_bias, a_log, d_skip, ypre);
    nv::k_ssm_norm<<<M * 2 / 4, 256, 0, stream>>>(ypre, proj, ssm_ng, ycat);
    nv::k_attn<<<NB * NH * 32, 64, 0, stream>>>(proj, ck);
    nv::k_attn_norm<<<M / 4, 256, 0, stream>>>(proj, att_ng, ycat);
    { nv::CxOut cx{ycat, w_out, out}; nv::k_gemm<false, nv::CxOut><<<dim3(D / 64, M / 64, 1), 256, 0, stream>>>(cx); }
    nv::k_ln1_router<<<M / 4, 256, 0, stream>>>(x, out, mod, ln1_g, ln1_b, rgw, rgb, rew, reb, u2, cnt, list, toke, tokw, toks);
    { nv::CxMoe1 cx{cnt, list, u2, w_gate, w_up, hmid}; nv::k_gemm<true, nv::CxMoe1><<<dim3(DE / 64, LCAP / 64, NE), 256, 0, stream>>>(cx); }
    { nv::CxMoe2 cx{cnt, list, hmid, w_down, yk0, yk1}; nv::k_gemm<false, nv::CxMoe2><<<dim3(D / 64, LCAP / 64, NE), 256, 0, stream>>>(cx); }
    nv::k_final<<<M / 4, 256, 0, stream>>>(out, mod, yk0, yk1, tokw, ln2_g, ln2_b);
}
```

```cpp
#include <hip/hip_runtime.h>
#include <cstdio>
#include <cstdint>

constexpr int NB = 8, T = 2048, D = 1024, M = NB * T;
constexpr int DSSM = 512, DATT = 512, HD = 64, NH = 8, NG = 2, NST = 128, DXBC = 1024, DIN = 3088;
constexpr int NE = 32, DE = 512, LCAP = 16384;
constexpr int PW = 3072;
constexpr int PC_Z = 0, PC_XS = 512, PC_Q = 1536, PC_K = 2048, PC_V = 2560;
constexpr float ALPHA = 1.189207115002721f;
constexpr float EPS = 1e-5f;
constexpr float LOG2E = 1.4426950408889634f;
constexpr float QSCALE = 0.125f * LOG2E;
constexpr int MAXSLOT = 160 * 256;

constexpr size_t MiB = 1u << 20;
constexpr size_t WS_CTL = 0, CTL_ZERO_BYTES = 1 * MiB;
constexpr size_t WS_WIN = 1 * MiB, WS_WOUT = 7 * MiB, WS_WGU = 9 * MiB, WS_WDN = 73 * MiB;
constexpr size_t WS_A = 105 * MiB;
constexpr size_t WS_B = 137 * MiB;
constexpr size_t WS_YK1 = 233 * MiB;
constexpr size_t WS_MISC = 265 * MiB;
constexpr size_t WS_MOD = WS_MISC;
constexpr size_t WS_DTF = WS_MISC + 1 * MiB;
constexpr size_t WS_CK = WS_MISC + 2 * MiB;
constexpr size_t WS_TOKE = WS_MISC + 3 * MiB;
constexpr size_t WS_TOKW = WS_TOKE + 256 * 1024;
constexpr size_t WS_TOKS = WS_TOKW + 256 * 1024;
constexpr size_t WS_LIST = WS_MISC + 4 * MiB;
constexpr size_t WS_MODP = WS_YK1;
constexpr size_t WS_END = 272 * MiB;
constexpr int CW_CNT = 1024;

typedef unsigned short bf16;
typedef float f32x4 __attribute__((ext_vector_type(4)));
typedef unsigned u32x4 __attribute__((ext_vector_type(4)));
typedef unsigned u32x2 __attribute__((ext_vector_type(2)));

__device__ __forceinline__ unsigned f2bf(float f) { unsigned u = __builtin_bit_cast(unsigned, f); return (u + 0x7fffu + ((u >> 16) & 1u)) >> 16; }
__device__ __forceinline__ float bf2f(unsigned b) { return __builtin_bit_cast(float, (b & 0xffffu) << 16); }
__device__ __forceinline__ unsigned pk2(float lo, float hi) { return f2bf(lo) | (f2bf(hi) << 16); }
__device__ __forceinline__ float silu_f(float x) { return x / (1.f + expf(-x)); }
__device__ __forceinline__ float softplus_f(float x) { return fmaxf(x, 0.f) + log1pf(expf(-fabsf(x))); }
__device__ __forceinline__ float wave_sum(float v) {
#pragma unroll
    for (int o = 1; o < 64; o <<= 1) v += __shfl_xor(v, o);
    return v;
}

namespace nv {
__global__ void __launch_bounds__(256) k_mod(const float* c, const float* ada_w, const float* ada_b, float* mod) {
    const int j = blockIdx.x * 256 + threadIdx.x;
    __shared__ float sc[NB][D];
    for (int i = threadIdx.x; i < NB * D; i += 256) sc[i / D][i % D] = silu_f(c[i]);
    __syncthreads();
    float acc[NB];
#pragma unroll
    for (int b = 0; b < NB; ++b) acc[b] = 0.f;
    for (int k = 0; k < D; ++k) { const float w = ada_w[(size_t)k * 6144 + j];
#pragma unroll
        for (int b = 0; b < NB; ++b) acc[b] += sc[b][k] * w; }
#pragma unroll
    for (int b = 0; b < NB; ++b) mod[b * 6144 + j] = acc[b] + ada_b[j];
}

template <bool DUAL, class Ctx>
__global__ void __launch_bounds__(256) k_gemm(Ctx cx) {
    __shared__ float As[16][68], Bs[16][68], Bs2[DUAL ? 16 : 1][68];
    __shared__ int s_info[4];
    if (!cx.setup(s_info)) return;
    __syncthreads();
    const int tm = blockIdx.y * 64, tn = blockIdx.x * 64, tid = threadIdx.x, tx = tid & 15, ty = tid >> 4;
    const int K = cx.K();
    float acc[4][4], acc2[4][4];
#pragma unroll
    for (int i = 0; i < 4; ++i)
#pragma unroll
        for (int j = 0; j < 4; ++j) { acc[i][j] = 0.f; acc2[i][j] = 0.f; }
    for (int k0 = 0; k0 < K; k0 += 16) {
#pragma unroll
        for (int i = 0; i < 4; ++i) { const int idx = tid + i * 256, r = idx >> 4, kk = idx & 15; As[kk][r] = cx.a(s_info, tm + r, k0 + kk); }
#pragma unroll
        for (int i = 0; i < 4; ++i) { const int idx = tid + i * 256, kk = idx >> 6, n = idx & 63; Bs[kk][n] = cx.b(s_info, k0 + kk, tn + n); if (DUAL) Bs2[kk][n] = cx.b2(s_info, k0 + kk, tn + n); }
        __syncthreads();
#pragma unroll
        for (int kk = 0; kk < 16; ++kk) {
            float a[4], b[4], b2[4];
#pragma unroll
            for (int i = 0; i < 4; ++i) { a[i] = As[kk][ty * 4 + i]; b[i] = Bs[kk][tx * 4 + i]; b2[i] = DUAL ? Bs2[kk][tx * 4 + i] : 0.f; }
#pragma unroll
            for (int i = 0; i < 4; ++i)
#pragma unroll
                for (int j = 0; j < 4; ++j) { acc[i][j] += a[i] * b[j]; if (DUAL) acc2[i][j] += a[i] * b2[j]; }
        }
        __syncthreads();
    }
#pragma unroll
    for (int i = 0; i < 4; ++i)
#pragma unroll
        for (int j = 0; j < 4; ++j) cx.epi(s_info, tm + ty * 4 + i, tn + tx * 4 + j, acc[i][j], acc2[i][j]);
}

struct CxIn {
    const float* x; const float* mod; const float* w; bf16* proj; float* dtf;
    __device__ bool setup(int*) const { return true; }
    __device__ int K() const { return D; }
    __device__ float a(const int*, int m, int k) const { const int b = m / T; return x[(size_t)m * D + k] * (1.f + mod[b * 6144 + D + k]) + mod[b * 6144 + k]; }
    __device__ float b(const int*, int k, int n) const { return n < DIN ? w[(size_t)k * DIN + n] : 0.f; }
    __device__ float b2(const int*, int, int) const { return 0.f; }
    __device__ void epi(const int*, int m, int n, float v, float) const {
        if (n >= DIN) return;
        if (n < 1536) proj[(size_t)m * PW + n] = (bf16)f2bf(v);
        else if (n < 1544) dtf[m * 16 + (n - 1536)] = v;
        else if (n < 3080) { const int c = n - 8; proj[(size_t)m * PW + c] = (bf16)f2bf(c < PC_K ? v * QSCALE : v); }
        else dtf[m * 16 + 8 + (n - 3080)] = v;
    }
};
struct CxOut {
    const bf16* ycat; const float* w; float* h;
    __device__ bool setup(int*) const { return true; }
    __device__ int K() const { return D; }
    __device__ float a(const int*, int m, int k) const { return bf2f(ycat[(size_t)m * D + k]); }
    __device__ float b(const int*, int k, int n) const { return w[(size_t)k * D + n]; }
    __device__ float b2(const int*, int, int) const { return 0.f; }
    __device__ void epi(const int*, int m, int n, float v, float) const { h[(size_t)m * D + n] = v; }
};
__device__ __forceinline__ bool moe_setup(const unsigned* cnt, int* s_info) {
    const int e = blockIdx.z; const int n = (int)cnt[e];
    if ((int)blockIdx.y * 64 >= n) return false;
    if (threadIdx.x == 0) { int base = 0; for (int i = 0; i < e; ++i) base += ((int)cnt[i] + 255) / 256 * 256; s_info[0] = e; s_info[1] = n; s_info[2] = base; }
    return true;
}
struct CxMoe1 {
    const unsigned* cnt; const int* list; const bf16* u2; const float* wg; const float* wu; bf16* hmid;
    __device__ bool setup(int* s) const { return moe_setup(cnt, s); }
    __device__ int K() const { return D; }
    __device__ float a(const int* s, int m, int k) const { if (m >= s[1]) return 0.f; const int tok = list[s[0] * LCAP + m] >> 1; return bf2f(u2[(size_t)tok * D + k]); }
    __device__ float b(const int* s, int k, int n) const { return wg[((size_t)s[0] * D + k) * DE + n]; }
    __device__ float b2(const int* s, int k, int n) const { return wu[((size_t)s[0] * D + k) * DE + n]; }
    __device__ void epi(const int* s, int m, int n, float g, float u) const { if (m >= s[1]) return; hmid[(size_t)(s[2] + m) * DE + n] = (bf16)f2bf(silu_f(g) * u); }
};
struct CxMoe2 {
    const unsigned* cnt; const int* list; const bf16* hmid; const float* wd; bf16* yk0; bf16* yk1;
    __device__ bool setup(int* s) const { return moe_setup(cnt, s); }
    __device__ int K() const { return DE; }
    __device__ float a(const int* s, int m, int k) const { if (m >= s[1]) return 0.f; return bf2f(hmid[(size_t)(s[2] + m) * DE + k]); }
    __device__ float b(const int* s, int k, int n) const { return wd[((size_t)s[0] * DE + k) * D + n]; }
    __device__ float b2(const int*, int, int) const { return 0.f; }
    __device__ void epi(const int* s, int m, int n, float v, float) const { if (m >= s[1]) return; const int a = list[s[0] * LCAP + m]; bf16* y = (a & 1) ? yk1 : yk0; y[(size_t)(a >> 1) * D + n] = (bf16)f2bf(v); }
};

__global__ void k_cumf(const float* dtf, const float* fg_bias, float* ck) {
    const int bh = blockIdx.x * blockDim.x + threadIdx.x; if (bh >= NB * NH) return;
    const int b = bh / NH, h = bh % NH; const float fb = fg_bias[h]; float s = 0.f;
    for (int t = 0; t < T; ++t) { const float f = dtf[(size_t)(b * T + t) * 16 + 8 + h] + fb; s += -softplus_f(-f); ck[(size_t)bh * T + t] = s; }
}
__global__ void __launch_bounds__(256) k_conv(const bf16* proj, const float* cw, const float* cb, float* xact) {
    const size_t i = (size_t)blockIdx.x * 256 + threadIdx.x; const int m = (int)(i / DXBC), ch = (int)(i % DXBC), t = m % T;
    float acc = cb[ch];
#pragma unroll
    for (int j = 0; j < 4; ++j) { const int tt = t - 3 + j; if (tt >= 0) acc += cw[j * DXBC + ch] * bf2f(proj[(size_t)(m - 3 + j) * PW + PC_XS + ch]); }
    xact[i] = silu_f(acc);
}
__global__ void __launch_bounds__(256) k_ssd(const float* xact, const float* dtf, const float* dt_bias, const float* a_log, const float* d_skip, float* ypre) {
    const int b = blockIdx.x / NH, h = blockIdx.x % NH, g = h / 4, p = threadIdx.x >> 2, nq = threadIdx.x & 3;
    const float A = -expf(a_log[h]), Dh = d_skip[h], dtb = dt_bias[h];
    float st[32];
#pragma unroll
    for (int i = 0; i < 32; ++i) st[i] = 0.f;
    for (int t = 0; t < T; ++t) {
        const size_t m = (size_t)b * T + t;
        const float dtv = softplus_f(dtf[m * 16 + h] + dtb), dA = expf(dtv * A);
        const float xv = xact[m * DXBC + h * 64 + p], xd = xv * dtv;
        const f32x4* Bp = (const f32x4*)(xact + m * DXBC + 512 + g * 128 + nq * 32);
        const f32x4* Cp = (const f32x4*)(xact + m * DXBC + 768 + g * 128 + nq * 32);
        float y = 0.f;
#pragma unroll
        for (int i = 0; i < 8; ++i) { const f32x4 bv = Bp[i], cv = Cp[i];
#pragma unroll
            for (int j = 0; j < 4; ++j) { st[i * 4 + j] = dA * st[i * 4 + j] + xd * bv[j]; y += cv[j] * st[i * 4 + j]; } }
        y += __shfl_xor(y, 1); y += __shfl_xor(y, 2);
        if (nq == 0) ypre[m * DSSM + h * 64 + p] = y + Dh * xv;
    }
}
__global__ void __launch_bounds__(256) k_ssm_norm(const float* ypre, const bf16* proj, const float* ng, bf16* ycat) {
    const int w = (blockIdx.x * 256 + threadIdx.x) >> 6, lane = threadIdx.x & 63, m = w >> 1, g = w & 1;
    float v[4]; float ss = 0.f;
#pragma unroll
    for (int j = 0; j < 4; ++j) { const int c = g * 256 + lane * 4 + j; v[j] = ypre[(size_t)m * DSSM + c] * silu_f(bf2f(proj[(size_t)m * PW + PC_Z + c])); ss += v[j] * v[j]; }
    const float r = 1.f / sqrtf(wave_sum(ss) * (1.f / 256.f) + EPS);
#pragma unroll
    for (int j = 0; j < 4; ++j) { const int c = g * 256 + lane * 4 + j; ycat[(size_t)m * D + c] = (bf16)f2bf(v[j] * r * ng[c]); }
}
__global__ void __launch_bounds__(64) k_attn(bf16* proj, const float* ck) {
    __shared__ float Ks[64][64], Vs[64][64], cks[64];
    const int blk = blockIdx.x, qt = blk % 32, bh = blk / 32, b = bh / NH, h = bh % NH, lane = threadIdx.x;
    const int q = qt * 64 + lane; const size_t mq = (size_t)b * T + q;
    float Q[64], O[64];
#pragma unroll
    for (int d = 0; d < 64; ++d) { Q[d] = bf2f(proj[mq * PW + PC_Q + h * 64 + d]); O[d] = 0.f; }
    const float cq = ck[(size_t)bh * T + q];
    float mrun = -INFINITY, lrun = 0.f;
    for (int kt = 0; kt <= qt; ++kt) {
        __syncthreads();
        for (int i = lane; i < 64 * 64; i += 64) { const int r = i >> 6, d = i & 63; const size_t mk = (size_t)b * T + kt * 64 + r;
            Ks[r][d] = bf2f(proj[mk * PW + PC_K + h * 64 + d]); Vs[r][d] = bf2f(proj[mk * PW + PC_V + h * 64 + d]); }
        cks[lane] = ck[(size_t)bh * T + kt * 64 + lane];
        __syncthreads();
        const int jmax = (kt == qt) ? lane : 63;
        for (int j = 0; j <= jmax; ++j) {
            float s = 0.f;
#pragma unroll
            for (int d = 0; d < 64; ++d) s += Q[d] * Ks[j][d];
            s += (cq - cks[j]) * LOG2E;
            const float mn = fmaxf(mrun, s), al = exp2f(mrun - mn), pj = exp2f(s - mn);
            lrun = lrun * al + pj; mrun = mn;
#pragma unroll
            for (int d = 0; d < 64; ++d) O[d] = O[d] * al + pj * Vs[j][d];
        }
    }
    const float il = 1.f / lrun;
#pragma unroll
    for (int d = 0; d < 64; ++d) proj[mq * PW + PC_Q + h * 64 + d] = (bf16)f2bf(O[d] * il);
}
__global__ void __launch_bounds__(256) k_attn_norm(const bf16* proj, const float* ng, bf16* ycat) {
    const int m = (blockIdx.x * 256 + threadIdx.x) >> 6, lane = threadIdx.x & 63;
    float v[8]; float ss = 0.f;
#pragma unroll
    for (int j = 0; j < 8; ++j) { v[j] = bf2f(proj[(size_t)m * PW + PC_Q + lane * 8 + j]); ss += v[j] * v[j]; }
    const float r = 1.f / sqrtf(wave_sum(ss) * (1.f / 512.f) + EPS);
#pragma unroll
    for (int j = 0; j < 8; ++j) ycat[(size_t)m * D + 512 + lane * 8 + j] = (bf16)f2bf(v[j] * r * ng[lane * 8 + j]);
}
__global__ void __launch_bounds__(256) k_ln1_router(const float* x, float* hx1, const float* mod, const float* g1, const float* b1,
                                                    const float* rgw, const float* rgb, const float* rew, const float* reb,
                                                    bf16* u2, unsigned* cnt, int* list, int* toke, float* tokw, int* toks) {
    const int m = (blockIdx.x * 256 + threadIdx.x) >> 6, lane = threadIdx.x & 63, b = m / T;
    const float* mb = mod + b * 6144;
    float v[16]; float s = 0.f;
#pragma unroll
    for (int j = 0; j < 4; ++j) { const int c = 4 * lane + 256 * j; const f32x4 xv = *(const f32x4*)(x + (size_t)m * D + c), hv = *(const f32x4*)(hx1 + (size_t)m * D + c), gt = *(const f32x4*)(mb + 2 * D + c);
#pragma unroll
        for (int i = 0; i < 4; ++i) { v[j * 4 + i] = ALPHA * xv[i] + (1.f + gt[i]) * hv[i]; s += v[j * 4 + i]; } }
    const float mean = wave_sum(s) * (1.f / D); float s2 = 0.f;
#pragma unroll
    for (int i = 0; i < 16; ++i) { v[i] -= mean; s2 += v[i] * v[i]; }
    const float rstd = 1.f / sqrtf(wave_sum(s2) * (1.f / D) + EPS);
    float acc[36];
#pragma unroll
    for (int i = 0; i < 36; ++i) acc[i] = 0.f;
#pragma unroll
    for (int j = 0; j < 4; ++j) { const int c = 4 * lane + 256 * j; const f32x4 gg = *(const f32x4*)(g1 + c), bb = *(const f32x4*)(b1 + c), sc = *(const f32x4*)(mb + 4 * D + c), sh = *(const f32x4*)(mb + 3 * D + c);
        f32x4 x1, uu;
#pragma unroll
        for (int i = 0; i < 4; ++i) { x1[i] = v[j * 4 + i] * rstd * gg[i] + bb[i]; uu[i] = x1[i] * (1.f + sc[i]) + sh[i]; }
        *(f32x4*)(hx1 + (size_t)m * D + c) = x1;
        u32x2 pk; pk.x = pk2(uu[0], uu[1]); pk.y = pk2(uu[2], uu[3]); *(u32x2*)(u2 + (size_t)m * D + c) = pk;
#pragma unroll
        for (int i = 0; i < 4; ++i) { const int k = c + i; const f32x4 wg = *(const f32x4*)(rgw + (size_t)k * 4);
#pragma unroll
            for (int q = 0; q < 4; ++q) acc[q] += uu[i] * wg[q];
#pragma unroll
            for (int q8 = 0; q8 < 8; ++q8) { const f32x4 we = *(const f32x4*)(rew + (size_t)k * 32 + q8 * 4);
#pragma unroll
                for (int q = 0; q < 4; ++q) acc[4 + q8 * 4 + q] += uu[i] * we[q]; } } }
#pragma unroll
    for (int i = 0; i < 36; ++i) acc[i] = wave_sum(acc[i]);
    float lg[4]; float mx = -INFINITY; int gi = 0;
#pragma unroll
    for (int i = 0; i < 4; ++i) { lg[i] = acc[i] + rgb[i]; if (lg[i] > mx) { mx = lg[i]; gi = i; } }
    float se = 0.f;
#pragma unroll
    for (int i = 0; i < 4; ++i) se += expf(lg[i] - mx);
    const float gp = 1.f / se;
    float le[8]; float mxe = -INFINITY;
#pragma unroll
    for (int i = 0; i < 8; ++i) { float t = 0.f;
#pragma unroll
        for (int gq = 0; gq < 4; ++gq) t = (gi == gq) ? acc[4 + gq * 8 + i] + reb[gq * 8 + i] : t;
        le[i] = t; mxe = fmaxf(mxe, t); }
    float pe[8];
#pragma unroll
    for (int i = 0; i < 8; ++i) pe[i] = expf(le[i] - mxe);
    int i1 = 0; float p1 = -1.f;
#pragma unroll
    for (int i = 0; i < 8; ++i) if (pe[i] > p1) { p1 = pe[i]; i1 = i; }
    int i2 = 0; float p2 = -1.f;
#pragma unroll
    for (int i = 0; i < 8; ++i) if (i != i1 && pe[i] > p2) { p2 = pe[i]; i2 = i; }
    const float inv = 1.f / (p1 + p2);
    if (lane == 0) {
        const int e0 = gi * 8 + i1, e1 = gi * 8 + i2;
        const unsigned q0 = atomicAdd(&cnt[e0], 1u), q1 = atomicAdd(&cnt[e1], 1u);
        list[e0 * LCAP + q0] = m * 2; list[e1 * LCAP + q1] = m * 2 + 1;
        toke[m * 2] = e0; toke[m * 2 + 1] = e1; tokw[m * 2] = gp * p1 * inv; tokw[m * 2 + 1] = gp * p2 * inv; toks[m * 2] = (int)q0; toks[m * 2 + 1] = (int)q1;
    }
}
__global__ void __launch_bounds__(256) k_final(float* out, const float* mod, const bf16* yk0, const bf16* yk1, const float* tokw, const float* g2, const float* b2) {
    const int m = (blockIdx.x * 256 + threadIdx.x) >> 6, lane = threadIdx.x & 63, b = m / T;
    const float* mb = mod + b * 6144; const float w0 = tokw[m * 2], w1 = tokw[m * 2 + 1];
    float v[16]; float s = 0.f;
#pragma unroll
    for (int j = 0; j < 4; ++j) { const int c = 4 * lane + 256 * j; const f32x4 xv = *(const f32x4*)(out + (size_t)m * D + c), gt = *(const f32x4*)(mb + 5 * D + c);
        const u32x2 a = *(const u32x2*)(yk0 + (size_t)m * D + c), bq = *(const u32x2*)(yk1 + (size_t)m * D + c);
        const float y0[4] = {bf2f(a.x), bf2f(a.x >> 16), bf2f(a.y), bf2f(a.y >> 16)}, y1[4] = {bf2f(bq.x), bf2f(bq.x >> 16), bf2f(bq.y), bf2f(bq.y >> 16)};
#pragma unroll
        for (int i = 0; i < 4; ++i) { v[j * 4 + i] = ALPHA * xv[i] + (1.f + gt[i]) * (w0 * y0[i] + w1 * y1[i]); s += v[j * 4 + i]; } }
    const float mean = wave_sum(s) * (1.f / D); float s2 = 0.f;
#pragma unroll
    for (int i = 0; i < 16; ++i) { v[i] -= mean; s2 += v[i] * v[i]; }
    const float rstd = 1.f / sqrtf(wave_sum(s2) * (1.f / D) + EPS);
#pragma unroll
    for (int j = 0; j < 4; ++j) { const int c = 4 * lane + 256 * j; const f32x4 gg = *(const f32x4*)(g2 + c), bb = *(const f32x4*)(b2 + c); f32x4 o;
#pragma unroll
        for (int i = 0; i < 4; ++i) o[i] = v[j * 4 + i] * rstd * gg[i] + bb[i];
        *(f32x4*)(out + (size_t)m * D + c) = o; }
}
}
namespace pg8 {
#define PG8_LAS __attribute__((address_space(3)))
typedef unsigned short bf16_t;
typedef short bf16x8 __attribute__((ext_vector_type(8)));
typedef float f32x4 __attribute__((ext_vector_type(4)));
typedef float f32x2 __attribute__((ext_vector_type(2)));
typedef unsigned u32x4 __attribute__((ext_vector_type(4)));
constexpr int BM = 256, BK = 64, HALF = 128, HTB = HALF * BK * 2  , STAGE_BYTES = 8 * HTB, NXCD = 8, WGM = 8;

__host__ __device__ __forceinline__ int lds_byte(int r, int c) { const int st = (r >> 4) * 2 + (c >> 5), rr = r & 15, cc = c & 31, ob = rr * 64 + cc * 2; return st * 1024 + (ob ^ (((ob >> 9) & 1) << 5)); }
__host__ __device__ __forceinline__ void stage_rc(int b, int& R, int& C) { const int st = b / 1024, sb = b % 1024, swz = sb ^ (((sb >> 9) & 1) << 5); R = (st >> 1) * 16 + swz / 64; C = (st & 1) * 32 + (swz % 64) / 2; }
__host__ __device__ __forceinline__ int perm32(int rho) { const int n = rho >> 4, i = rho & 15; return 8 * (i >> 2) + 4 * n + (i & 3); }

struct Unit { int pm, pn; unsigned boff; int x0, x1, x2; };
struct Gemm { const bf16_t* A; const bf16_t* Bt; int K; };

struct StaticOrder {
    int nM, nN, nwg, G, c, K;
    __device__ void init(int M, int N, int K_, int G_, int c_) { nM = M / BM; nN = N / BM; nwg = nM * nN; G = G_; c = c_; K = K_; }
    __device__ bool next(int i, Unit& u) const {
        const long L = (long)i * G + c; if (L >= nwg) return false;
        int wgid = (int)L; { const int q = nwg / NXCD, r = nwg % NXCD, xcd = wgid % NXCD, off = wgid / NXCD; wgid = (xcd < r ? xcd * (q + 1) : r * (q + 1) + (xcd - r) * q) + off; }
        const int nig = WGM * nN, gid = wgid / nig, fm = gid * WGM, gsz = (nM - fm) < WGM ? (nM - fm) : WGM;
        u.pm = fm + ((wgid % nig) % gsz); u.pn = (wgid % nig) / gsz; u.boff = (unsigned)u.pn * (unsigned)(BM * K * 2); u.x0 = u.x1 = u.x2 = 0; return true;
    }
    __device__ __forceinline__ unsigned arow(const Unit& u, int r) const { return (unsigned)(u.pm * BM + r) * (unsigned)(K * 2); }
};

__device__ __forceinline__ unsigned cvt_pk_bf16(float lo, float hi) { unsigned r; asm volatile("v_cvt_pk_bf16_f32 %0, %1, %2" : "=v"(r) : "v"(lo), "v"(hi)); return r; }

struct EpiProj {
    static constexpr bool PERM = true;
    bf16_t* O; int ldc; int q_lo, q_hi; float qs;
    __device__ __forceinline__ void operator()(const f32x4 (&acc)[2][2][4][2], const Unit& u, int wr, int wc, int fr, int fq) const {
        const int row0 = u.pm * BM + wr * 64 + fr, colt = u.pn * BM; const float sc = (colt >= q_lo && colt < q_hi) ? qs : 1.f;
        const int col0 = colt + wc * 32 + 8 * fq;
#pragma unroll
        for (int ai = 0; ai < 2; ++ai)
#pragma unroll
            for (int m = 0; m < 4; ++m) { bf16_t* rowp = O + (size_t)(row0 + ai * HALF + m * 16) * ldc + col0;
#pragma unroll
                for (int bj = 0; bj < 2; ++bj) { const f32x4 v0 = acc[ai][bj][m][0] * sc, v1 = acc[ai][bj][m][1] * sc;
                    u32x4 w; w.x = cvt_pk_bf16(v0[0], v0[1]); w.y = cvt_pk_bf16(v0[2], v0[3]); w.z = cvt_pk_bf16(v1[0], v1[1]); w.w = cvt_pk_bf16(v1[2], v1[3]);
                    *(u32x4*)(rowp + bj * HALF) = w; } }
    }
};
struct EpiF32 {
    static constexpr bool PERM = false;
    float* O; int ldc;
    __device__ __forceinline__ void operator()(const f32x4 (&acc)[2][2][4][2], const Unit& u, int wr, int wc, int fr, int fq) const {
        const int row0 = u.pm * BM + wr * 64 + fr, col0 = u.pn * BM + wc * 32 + 4 * fq;
#pragma unroll
        for (int ai = 0; ai < 2; ++ai)
#pragma unroll
            for (int m = 0; m < 4; ++m) { float* rowp = O + (size_t)(row0 + ai * HALF + m * 16) * ldc + col0;
#pragma unroll
                for (int bj = 0; bj < 2; ++bj)
#pragma unroll
                    for (int n = 0; n < 2; ++n) *(f32x4*)(rowp + bj * HALF + n * 16) = acc[ai][bj][m][n]; }
    }
};

template <class Epi, class Sched, bool ALIGN_EPI>
__device__ __forceinline__ void gemm_phase(PG8_LAS unsigned char* lds, const Gemm g, const Sched& S, const Epi& E) {
    const int tid = threadIdx.x, wid = __builtin_amdgcn_readfirstlane(tid >> 6), lane = tid & 63, wr = wid >> 2, wc = wid & 3, fr = lane & 15, fq = lane >> 4;
    const int K = g.K, nt = K / BK;
    int Rp[2], Cp[2]; unsigned voffB[2];
#pragma unroll
    for (int i = 0; i < 2; ++i) { int R, C; stage_rc(tid * 16 + i * 8192, R, C); Rp[i] = R; Cp[i] = C; const int Rb = Epi::PERM ? ((R & ~31) + perm32(R & 31)) : R; voffB[i] = (unsigned)(Rb * K + C) * 2u; }
    const size_t kstep = (size_t)(BK * 2);
    const size_t hstep = (size_t)HALF * K * 2;
    const unsigned ldsw = (unsigned)wid * 1024u;
    const int aoff = lds_byte(wr * 64 + fr, fq * 8), boff = lds_byte(wc * 32 + fr, fq * 8);
    const char* gA = (const char*)g.A;
#define PG8_SA(b, h) (((b) * 2 + (h)) * HTB)
#define PG8_SB(b, h) ((4 + (b) * 2 + (h)) * HTB)
#define PG8_STAGE(bufoff, gbase, voff) do { _Pragma("unroll") for (int _i = 0; _i < 2; ++_i) \
        __builtin_amdgcn_global_load_lds((const unsigned*)((const char*)(gbase) + (voff)[_i]), (PG8_LAS unsigned*)(lds + (bufoff) + ldsw + _i * 8192), 16, 0, 0); } while (0)
#define PG8_STAGE_A(bufoff, kb, V, h) do { _Pragma("unroll") for (int _i = 0; _i < 2; ++_i) \
        __builtin_amdgcn_global_load_lds((const unsigned*)(gA + (kb) + (V)[h][_i]), (PG8_LAS unsigned*)(lds + (bufoff) + ldsw + _i * 8192), 16, 0, 0); } while (0)
#define PG8_LDA(dst, b, h) do { _Pragma("unroll") for (int m = 0; m < 4; ++m) _Pragma("unroll") for (int k = 0; k < 2; ++k) dst[m][k] = *(const PG8_LAS bf16x8*)(lds + PG8_SA(b, h) + aoff + m * 2048 + k * 1024); } while (0)
#define PG8_LDB(dst, b, h) do { _Pragma("unroll") for (int n = 0; n < 2; ++n) _Pragma("unroll") for (int k = 0; k < 2; ++k) dst[n][k] = *(const PG8_LAS bf16x8*)(lds + PG8_SB(b, h) + boff + n * 2048 + k * 1024); } while (0)
#define PG8_MMA(ai, bj, At, Bt) do { __builtin_amdgcn_s_setprio(1); _Pragma("unroll") for (int m = 0; m < 4; ++m) _Pragma("unroll") for (int n = 0; n < 2; ++n) _Pragma("unroll") for (int k = 0; k < 2; ++k) \
        acc[ai][bj][m][n] = __builtin_amdgcn_mfma_f32_16x16x32_bf16(Bt[n][k], At[m][k], acc[ai][bj][m][n], 0, 0, 0); __builtin_amdgcn_s_setprio(0); } while (0)
#define PG8_WAIT_V(n) asm volatile("s_waitcnt vmcnt(" #n ")" ::: "memory")
#define PG8_WAIT_L(n) asm volatile("s_waitcnt lgkmcnt(" #n ")" ::: "memory")
#define PG8_BAR __builtin_amdgcn_s_barrier()
#define PG8_SCHED __builtin_amdgcn_sched_barrier(0)
    Unit cur, nxt; int ui = 0;
    if (!S.next(0, cur)) return;
    f32x4 acc[2][2][4][2];
#pragma unroll
    for (int a = 0; a < 2; ++a)
#pragma unroll
        for (int b = 0; b < 2; ++b)
#pragma unroll
            for (int m = 0; m < 4; ++m)
#pragma unroll
                for (int n = 0; n < 2; ++n) acc[a][b][m][n] = (f32x4){0.f, 0.f, 0.f, 0.f};
    bf16x8 At[4][2], B0[2][2], B1[2][2];
    unsigned vc[2][2], vn[2][2];
#pragma unroll
    for (int h = 0; h < 2; ++h)
#pragma unroll
        for (int i = 0; i < 2; ++i) vc[h][i] = S.arow(cur, h * HALF + Rp[i]) + (unsigned)(Cp[i] * 2);
    const char* cB = (const char*)g.Bt + cur.boff;
    PG8_STAGE(PG8_SB(0, 0), cB, voffB); PG8_STAGE(PG8_SB(0, 1), cB + hstep, voffB); PG8_STAGE_A(PG8_SA(0, 0), 0, vc, 0); PG8_STAGE_A(PG8_SA(0, 1), 0, vc, 1);
    if (wr == 1) PG8_BAR;
    PG8_WAIT_V(2); PG8_BAR;
    PG8_STAGE(PG8_SB(1, 0), cB + kstep, voffB); PG8_STAGE_A(PG8_SA(1, 0), kstep, vc, 0); PG8_STAGE(PG8_SB(1, 1), cB + hstep + kstep, voffB);
    PG8_WAIT_V(6); PG8_BAR;
    for (;;) {
        const bool has_next = S.next(ui + 1, nxt);
        const char* nB = has_next ? (const char*)g.Bt + nxt.boff : cB;
#pragma unroll
        for (int h = 0; h < 2; ++h)
#pragma unroll
            for (int i = 0; i < 2; ++i) vn[h][i] = has_next ? S.arow(nxt, h * HALF + Rp[i]) + (unsigned)(Cp[i] * 2) : vc[h][i];
        for (int t = 0; t < nt; t += 2) {
            const bool last = (t == nt - 2);
            const size_t k1 = (size_t)(t + 1) * kstep;
            const size_t k2 = last ? 0 : (size_t)(t + 2) * kstep, k3 = k2 + kstep;
            const char* b2 = last ? nB : cB + (size_t)(t + 2) * kstep; const char* b3 = b2 + kstep;
            unsigned v2[2][2];
#pragma unroll
            for (int h = 0; h < 2; ++h)
#pragma unroll
                for (int i = 0; i < 2; ++i) v2[h][i] = last ? vn[h][i] : vc[h][i];
            PG8_LDB(B0, 0, 0); PG8_LDB(B1, 0, 1); PG8_SCHED; PG8_LDA(At, 0, 0); PG8_STAGE_A(PG8_SA(1, 1), k1, vc, 1);
            PG8_WAIT_V(8); PG8_WAIT_L(0); PG8_BAR; PG8_MMA(0, 0, At, B0); PG8_MMA(0, 1, At, B1); PG8_BAR; PG8_SCHED;
            PG8_LDA(At, 0, 1); PG8_STAGE(PG8_SB(0, 0), b2, voffB); PG8_STAGE(PG8_SB(0, 1), b2 + hstep, voffB); PG8_STAGE_A(PG8_SA(0, 0), k2, v2, 0);
            PG8_WAIT_V(8); PG8_WAIT_L(0); PG8_BAR; PG8_MMA(1, 0, At, B0); PG8_MMA(1, 1, At, B1); PG8_BAR; PG8_SCHED;
            PG8_LDB(B0, 1, 0); PG8_LDB(B1, 1, 1); PG8_SCHED; PG8_LDA(At, 1, 0); PG8_STAGE_A(PG8_SA(0, 1), k2, v2, 1);
            PG8_WAIT_V(8); PG8_WAIT_L(0); PG8_BAR; PG8_MMA(0, 0, At, B0); PG8_MMA(0, 1, At, B1); PG8_BAR; PG8_SCHED;
            PG8_LDA(At, 1, 1); PG8_STAGE(PG8_SB(1, 0), b3, voffB); PG8_STAGE(PG8_SB(1, 1), b3 + hstep, voffB); PG8_STAGE_A(PG8_SA(1, 0), k3, v2, 0);
            PG8_WAIT_V(8); PG8_WAIT_L(0); PG8_BAR; PG8_MMA(1, 0, At, B0); PG8_MMA(1, 1, At, B1); PG8_BAR; PG8_SCHED;
        }
        if constexpr (ALIGN_EPI) { if (wr == 0) PG8_BAR; }
        E(acc, cur, wr, wc, fr, fq);
        if (!has_next) break;
#pragma unroll
        for (int a = 0; a < 2; ++a)
#pragma unroll
            for (int b = 0; b < 2; ++b)
#pragma unroll
                for (int m = 0; m < 4; ++m)
#pragma unroll
                    for (int n = 0; n < 2; ++n) acc[a][b][m][n] = (f32x4){0.f, 0.f, 0.f, 0.f};
        cur = nxt; cB = nB; ++ui;
#pragma unroll
        for (int h = 0; h < 2; ++h)
#pragma unroll
            for (int i = 0; i < 2; ++i) vc[h][i] = vn[h][i];
        if constexpr (ALIGN_EPI) { if (wr == 1) PG8_BAR; }
    }
    PG8_WAIT_V(0);
    if constexpr (!ALIGN_EPI) { if (wr == 0) PG8_BAR; }
    PG8_BAR;
#undef PG8_SA
#undef PG8_SB
#undef PG8_STAGE
#undef PG8_STAGE_A
#undef PG8_LDA
#undef PG8_LDB
#undef PG8_MMA
#undef PG8_WAIT_V
#undef PG8_WAIT_L
#undef PG8_BAR
#undef PG8_SCHED
}
}
constexpr int NWAVES = 8;
constexpr int RING_OFF = 0, RING_BYTES = 131072;
constexpr int LDSCTL_OFF = RING_BYTES, MISC_OFF = LDSCTL_OFF + 320;
constexpr int LDS_BYTES = 147456;
static_assert(MISC_OFF + 128 <= LDS_BYTES, "LDS map");
constexpr int CW_TMO = 0, CW_CODE = 1, CW_BAR = 4096, MAX_BAR_REGIONS = 8;

#define GAS __attribute__((address_space(1)))
#define LAS __attribute__((address_space(3)))
typedef short bf16x8 __attribute__((ext_vector_type(8)));
typedef GAS unsigned gu32;
#define RLX_AGENT __ATOMIC_RELAXED, __HIP_MEMORY_SCOPE_AGENT
#define LDS_WAIT() asm volatile("s_waitcnt lgkmcnt(0)" ::: "memory")
#define VM_WAIT() asm volatile("s_waitcnt vmcnt(0)" ::: "memory")

#define XB_TMO      128
#define XB_XCNT(j)  (256  + 64 * (j))
#define XB_XSUB(j)  (1280 + 64 * (j))
#define XB_XGEN(j)  (2304 + 64 * (j))
#define XB_TOP      3328
#define XB_TOPGEN   3392
#define XCD_BAR_WORDS 3456
#define XB_SPIN_CAP (1u << 18)

__device__ __forceinline__ unsigned xb_ld(unsigned* p)              { return __hip_atomic_load(p, __ATOMIC_RELAXED, __HIP_MEMORY_SCOPE_AGENT); }
__device__ __forceinline__ unsigned xb_add(unsigned* p, unsigned v) { return __hip_atomic_fetch_add(p, v, __ATOMIC_RELAXED, __HIP_MEMORY_SCOPE_AGENT); }
__device__ __forceinline__ unsigned xb_xcc_id() { return (unsigned)__builtin_amdgcn_s_getreg((3 << 11) | 20) & 0xFu; }
#define XB_SPIN(cond, bar) do { unsigned _sp = 0; while (cond) { __builtin_amdgcn_s_sleep(1); \
    if ((++_sp & 255u) == 0u) { if (xb_ld(&(bar)[XB_TMO])) break; if (_sp > XB_SPIN_CAP) { atomicAdd(&(bar)[XB_TMO], 1u); break; } } } } while (0)

struct XcdBarrier {
    unsigned* bar; unsigned x;
    volatile LAS unsigned* st;
};

__device__ __forceinline__ XcdBarrier xcd_barrier_post(unsigned* bar, volatile LAS unsigned* st) {
    XcdBarrier b; b.bar = bar; b.x = xb_xcc_id(); b.st = st;
    if (threadIdx.x == 0) (void)xb_add(&bar[XB_XCNT(b.x)], 1u);
    return b;
}
__device__ __forceinline__ void xcd_barrier_complete(unsigned* bar, unsigned x, unsigned& nloc, unsigned& nx) {
    const unsigned G = gridDim.x * gridDim.y * gridDim.z;
    unsigned sum, cnt, mine, sp = 0u;
    for (;;) {
        sum = 0u; cnt = 0u; mine = 0u;
#pragma unroll
        for (unsigned j = 0; j < 16; ++j) { const unsigned c = xb_ld(&bar[XB_XCNT(j)]); sum += c; cnt += (c > 0u) ? 1u : 0u; mine = (j == x) ? c : mine; }
        if (sum == G) break;
        __builtin_amdgcn_s_sleep(1);
        if ((++sp & 255u) == 0u) { if (xb_ld(&bar[XB_TMO])) break; if (sp > XB_SPIN_CAP) { atomicAdd(&bar[XB_TMO], 1u); break; } }
    }
    nloc = mine > 0u ? mine : 1u; nx = cnt > 0u ? cnt : 1u;
}

__device__ __forceinline__ void xcd_barrier(const XcdBarrier& b) {
    asm volatile("s_waitcnt vmcnt(0)" ::: "memory");
    __syncthreads();
    if (threadIdx.x == 0) {
        unsigned* bar = b.bar;
        __builtin_amdgcn_s_waitcnt(0);
        unsigned nloc = b.st[0], nx = b.st[1];
        if (nloc == 0u) { xcd_barrier_complete(bar, b.x, nloc, nx); b.st[0] = nloc; b.st[1] = nx; }
        const unsigned old = xb_add(&bar[XB_XSUB(b.x)], 1u);
        const unsigned gen = old / nloc;
        if (old + 1u == (gen + 1u) * nloc) {
            __builtin_amdgcn_fence(__ATOMIC_RELEASE, "agent");
            asm volatile("s_waitcnt vmcnt(0)" ::: "memory");
            const unsigned og = xb_add(&bar[XB_TOP], 1u);
            const unsigned tg = og / nx;
            if (og + 1u == (tg + 1u) * nx) xb_add(&bar[XB_TOPGEN], 1u);
            else XB_SPIN(xb_ld(&bar[XB_TOPGEN]) == tg, bar);
            __builtin_amdgcn_fence(__ATOMIC_ACQUIRE, "agent");
            xb_add(&bar[XB_XGEN(b.x)], 1u);
            asm volatile("s_waitcnt vmcnt(0)" ::: "memory");
        } else {
            XB_SPIN(xb_ld(&bar[XB_XGEN(b.x)]) == gen, bar);
            __builtin_amdgcn_fence(__ATOMIC_ACQUIRE, "agent");
            asm volatile("s_waitcnt vmcnt(0)" ::: "memory");
        }
    }
    __syncthreads();
}


struct Args {
    const float* in[25]; float* out; unsigned char* ws; int ph_lo, ph_hi, li, pad;
};
struct Frame {
    LAS unsigned char* lds; volatile LAS unsigned* MISC; gu32* ctl;
    int tid, lane, wave, vcu, G;
};

__device__ __forceinline__ void transpose_item(const float* Wsrc, int ld, bf16* dst, int Kd, LAS float* scr, int lane) {
#pragma unroll 8
    for (int i = 0; i < 32; ++i) { const int kk = 2 * i + (lane >> 5); scr[kk * 33 + (lane & 31)] = Wsrc[(size_t)kk * ld + (lane & 31)]; }
    LDS_WAIT(); asm volatile("" ::: "memory");
    const int c = lane & 7;
#pragma unroll
    for (int j = 0; j < 4; ++j) { const int n = (lane >> 3) + 8 * j; const LAS float* s = scr + (8 * c) * 33 + n;
        u32x4 o; o.x = pk2(s[0 * 33], s[1 * 33]); o.y = pk2(s[2 * 33], s[3 * 33]); o.z = pk2(s[4 * 33], s[5 * 33]); o.w = pk2(s[6 * 33], s[7 * 33]);
        *(GAS u32x4*)(dst + (size_t)n * Kd + 8 * c) = o; }
    LDS_WAIT(); asm volatile("" ::: "memory");
}
constexpr int P0_MODT = 96 * 16;
constexpr int P0_IWIN = 16 * 96, P0_IWOUT = 16 * 32, P0_IEXP = 768;
constexpr int P0_NTASK = P0_MODT + P0_IWIN + P0_IWOUT + NE * P0_IEXP;
__device__ __forceinline__ void p0_prologue(Frame& F, const Args& A) {
    LAS float* scr = (LAS float*)(F.lds + RING_OFF + F.wave * 16384);
    const int gw = F.vcu * NWAVES + F.wave, NGW = F.G * NWAVES, lane = F.lane;
    const float* c = A.in[1]; const float* ada_w = A.in[2]; const float* w_in = A.in[4]; const float* w_out = A.in[13];
    const float* w_gate = A.in[20]; const float* w_up = A.in[21]; const float* w_down = A.in[22];
    float* modp = (float*)(A.ws + WS_MODP);
    bf16* Win = (bf16*)(A.ws + WS_WIN); bf16* Wout = (bf16*)(A.ws + WS_WOUT); bf16* Wgu = (bf16*)(A.ws + WS_WGU); bf16* Wdn = (bf16*)(A.ws + WS_WDN);
    for (int it = gw; it < P0_NTASK; it += NGW) {
        int r = it;
        if (r < P0_MODT) {
            const int cg = r % 96, ks = r / 96;
            int sv[NB]; float acc[NB];
#pragma unroll
            for (int b = 0; b < NB; ++b) { sv[b] = __builtin_bit_cast(int, silu_f(c[b * D + ks * 64 + lane])); acc[b] = 0.f; }
            const float* wp = ada_w + (size_t)(ks * 64) * 6144 + cg * 64 + lane;
#pragma unroll 16
            for (int k = 0; k < 64; ++k) { const float w = wp[(size_t)k * 6144];
#pragma unroll
                for (int b = 0; b < NB; ++b) acc[b] += __builtin_bit_cast(float, __builtin_amdgcn_readlane(sv[b], k)) * w; }
#pragma unroll
            for (int b = 0; b < NB; ++b) modp[(size_t)(ks * NB + b) * 6144 + cg * 64 + lane] = acc[b];
            continue;
        }
        r -= P0_MODT;
        if (r < P0_IWIN) { const int kb = r / 96, nb = r % 96, n0 = 32 * nb, src0 = n0 + (n0 >= 1536 ? 8 : 0);
            transpose_item(w_in + (size_t)(64 * kb) * DIN + src0, DIN, Win + (size_t)n0 * D + 64 * kb, D, scr, lane); continue; }
        r -= P0_IWIN;
        if (r < P0_IWOUT) { const int kb = r / 32, nb = r % 32;
            transpose_item(w_out + (size_t)(64 * kb) * D + 32 * nb, D, Wout + (size_t)(32 * nb) * D + 64 * kb, D, scr, lane); continue; }
        r -= P0_IWOUT;
        const int e = r / P0_IEXP, q = r % P0_IEXP;
        if (q < 512) {
            const int up = q >> 8, qq = q & 255, kb = qq / 16, nb = qq % 16; const float* W = (up ? w_up : w_gate) + (size_t)e * D * DE;
            transpose_item(W + (size_t)(64 * kb) * DE + 32 * nb, DE, Wgu + ((size_t)e * 1024 + 256 * (nb / 4) + 32 * (nb % 4) + 128 * up) * D + 64 * kb, D, scr, lane);
        } else {
            const int qq = q - 512, kb = qq / 32, nb = qq % 32;
            transpose_item(w_down + (size_t)e * DE * D + (size_t)(64 * kb) * D + 32 * nb, D, Wdn + ((size_t)e * 1024 + 32 * nb) * DE + 64 * kb, DE, scr, lane);
        }
    }
}
constexpr int W16P = 1028;
__device__ __forceinline__ void p1_modulate(Frame& F, const Args& A) {
    const float* x = A.in[0]; const float* ada_b = A.in[3]; const float* w_in = A.in[4];
    const float* modp = (const float*)(A.ws + WS_MODP); float* mod = (float*)(A.ws + WS_MOD); float* dtf = (float*)(A.ws + WS_DTF); bf16* U = (bf16*)(A.ws + WS_A);
    LAS float* sh1 = (LAS float*)(F.lds + RING_OFF); LAS float* sc1 = sh1 + 1024; LAS float* W16 = sc1 + 1024;
    const int tid = F.tid, lane = F.lane;
    for (int idx = F.vcu * 512 + tid; idx < NB * 6144; idx += F.G * 512) { const int b = idx / 6144, j = idx % 6144; float s = ada_b[j];
        for (int ks = 0; ks < 16; ++ks) s += modp[(size_t)(ks * NB + b) * 6144 + j];
        mod[idx] = s; }
    for (int e = tid; e < 16 * 1024; e += 512) { const int k = e >> 4, j = e & 15; W16[j * W16P + k] = w_in[(size_t)k * DIN + (j < 8 ? 1536 + j : 3080 + (j - 8))]; }
    for (int rb = F.vcu; rb < M / 64; rb += F.G) {
    const int row0 = rb * 64, bb = row0 / T;
    __syncthreads();
    for (int j = tid; j < 2048; j += 512) { float s = ada_b[j];
        for (int ks = 0; ks < 16; ++ks) s += modp[(size_t)(ks * NB + bb) * 6144 + j];
        if (j < 1024) sh1[j] = s; else sc1[j - 1024] = 1.f + s; }
    LDS_WAIT(); __syncthreads();
    for (int rp = 0; rp < 4; ++rp) {
        const int r0 = row0 + F.wave * 8 + rp * 2;
        f32x4 u0[4], u1[4];
#pragma unroll
        for (int j = 0; j < 4; ++j) { const int cidx = 4 * lane + 256 * j; const f32x4 s = *(const LAS f32x4*)(sc1 + cidx), h = *(const LAS f32x4*)(sh1 + cidx);
            u0[j] = *(const f32x4*)(x + (size_t)r0 * D + cidx) * s + h; u1[j] = *(const f32x4*)(x + (size_t)(r0 + 1) * D + cidx) * s + h;
            u32x2 p0, p1; p0.x = pk2(u0[j][0], u0[j][1]); p0.y = pk2(u0[j][2], u0[j][3]); p1.x = pk2(u1[j][0], u1[j][1]); p1.y = pk2(u1[j][2], u1[j][3]);
            *(u32x2*)(U + (size_t)r0 * D + cidx) = p0; *(u32x2*)(U + (size_t)(r0 + 1) * D + cidx) = p1; }
        float o0 = 0.f, o1 = 0.f;
#pragma unroll 2
        for (int j16 = 0; j16 < 16; ++j16) { float a0 = 0.f, a1 = 0.f;
#pragma unroll
            for (int j = 0; j < 4; ++j) { const f32x4 w = *(const LAS f32x4*)(W16 + j16 * W16P + 4 * lane + 256 * j);
                a0 += (u0[j][0] * w[0] + u0[j][1] * w[1]) + (u0[j][2] * w[2] + u0[j][3] * w[3]); a1 += (u1[j][0] * w[0] + u1[j][1] * w[1]) + (u1[j][2] * w[2] + u1[j][3] * w[3]); }
            a0 = wave_sum(a0); a1 = wave_sum(a1); if (lane == j16) { o0 = a0; o1 = a1; } }
        if (lane < 16) { dtf[(size_t)r0 * 16 + lane] = o0; dtf[(size_t)(r0 + 1) * 16 + lane] = o1; }
    }
    }
}

__global__ void __launch_bounds__(NWAVES * 64, 2) mk_fwd(Args args) {
    extern __shared__ __attribute__((aligned(16))) unsigned char lds[];
    Frame F;
    F.lds = (LAS unsigned char*)lds; F.MISC = (volatile LAS unsigned*)(F.lds + MISC_OFF);
    F.tid = threadIdx.x; F.lane = F.tid & 63; F.wave = __builtin_amdgcn_readfirstlane(F.tid >> 6);
    F.G = gridDim.x; { const int bx = blockIdx.x; F.vcu = (F.G % 8 == 0) ? (bx % 8) * (F.G / 8) + bx / 8 : bx; }
    F.ctl = (gu32*)(args.ws + WS_CTL);
    for (int u = F.tid; u < (LDS_BYTES - LDSCTL_OFF) / 4; u += NWAVES * 64) ((LAS unsigned*)(F.lds + LDSCTL_OFF))[u] = 0u;
    __syncthreads();
    XcdBarrier bar = xcd_barrier_post((unsigned*)(F.ctl + CW_BAR) + args.li * XCD_BAR_WORDS, F.MISC + 8);
    const int lo = args.ph_lo, hi = args.ph_hi;
#define IN(k) (lo <= (k) && (k) < hi)
#define BOTH(k) (IN(k) && IN((k) + 1))
#define GRID_BAR() xcd_barrier(bar)

    if (IN(0)) { p0_prologue(F, args); if (BOTH(0)) GRID_BAR(); }
    if (IN(1)) { p1_modulate(F, args); __syncthreads(); if (BOTH(1)) GRID_BAR(); }
    if (IN(2)) {
        pg8::Gemm g{(const bf16*)(args.ws + WS_A), (const bf16*)(args.ws + WS_WIN), D};
        pg8::StaticOrder S; S.init(M, PW, D, F.G, (int)blockIdx.x);
        pg8::EpiProj E{(bf16*)(args.ws + WS_B), PW, PC_Q, PC_K, QSCALE};
        pg8::gemm_phase<pg8::EpiProj, pg8::StaticOrder, true>(F.lds + RING_OFF, g, S, E);
        if (BOTH(2)) GRID_BAR();
    }
#undef IN
#undef BOTH
}

static void launch_mk(const Args& base, int lo, int hi, int li, int grid, hipStream_t stream) {
    Args a = base; a.ph_lo = lo; a.ph_hi = hi; a.li = li; a.pad = 0;
    hipLaunchKernelGGL(mk_fwd, dim3(grid), dim3(NWAVES * 64), LDS_BYTES, stream, a);
    const hipError_t le = hipPeekAtLastError();
    if (le != hipSuccess) fprintf(stderr, "kernel_launch: launch [%d,%d) failed: %s\n", lo, hi, hipGetErrorName(le));
}
extern "C" void kernel_launch(void* const* d_in, const int* in_sizes, int n_in, void* d_out, int out_size, void* d_ws, size_t ws_size, hipStream_t stream) {
    static int grid = 0;
    if (grid == 0) {
        if (n_in != 25 || in_sizes[0] != M * D || out_size != M * D || ws_size < WS_END) { fprintf(stderr, "kernel_launch: unexpected shapes / workspace (%zu)\n", ws_size); grid = -1; return; }
        int dev = 0, cus = 0;
        if (hipGetDevice(&dev) != hipSuccess || hipDeviceGetAttribute(&cus, hipDeviceAttributeMultiprocessorCount, dev) != hipSuccess) { grid = -1; return; }
        if (hipFuncSetAttribute((const void*)mk_fwd, hipFuncAttributeMaxDynamicSharedMemorySize, LDS_BYTES) != hipSuccess) { fprintf(stderr, "kernel_launch: hipFuncSetAttribute failed\n"); grid = -1; return; }
        (void)hipGetLastError();
        grid = cus;
    }
    if (grid < 0) return;
    const float* x = (const float*)d_in[0];
    const float* conv_w = (const float*)d_in[5]; const float* conv_b = (const float*)d_in[6]; const float* dt_bias = (const float*)d_in[7];
    const float* a_log = (const float*)d_in[8]; const float* d_skip = (const float*)d_in[9]; const float* ssm_ng = (const float*)d_in[10]; const float* fg_bias = (const float*)d_in[11];
    const float* att_ng = (const float*)d_in[12]; const float* w_out = (const float*)d_in[13]; const float* ln1_g = (const float*)d_in[14]; const float* ln1_b = (const float*)d_in[15];
    const float* rgw = (const float*)d_in[16]; const float* rgb = (const float*)d_in[17]; const float* rew = (const float*)d_in[18]; const float* reb = (const float*)d_in[19];
    const float* w_gate = (const float*)d_in[20]; const float* w_up = (const float*)d_in[21]; const float* w_down = (const float*)d_in[22]; const float* ln2_g = (const float*)d_in[23]; const float* ln2_b = (const float*)d_in[24];
    unsigned char* ws = (unsigned char*)d_ws; float* out = (float*)d_out;
    unsigned* ctl = (unsigned*)(ws + WS_CTL); unsigned* cnt = ctl + CW_CNT;
    float* mod = (float*)(ws + WS_MOD); float* dtf = (float*)(ws + WS_DTF); float* ck = (float*)(ws + WS_CK);
    int* toke = (int*)(ws + WS_TOKE); float* tokw = (float*)(ws + WS_TOKW); int* toks = (int*)(ws + WS_TOKS); int* list = (int*)(ws + WS_LIST);
    bf16* proj = (bf16*)(ws + WS_B); bf16* ycat = (bf16*)(ws + WS_A); bf16* u2 = (bf16*)(ws + WS_B); bf16* hmid = (bf16*)(ws + WS_B + 32 * MiB);
    bf16* yk0 = (bf16*)(ws + WS_A); bf16* yk1 = (bf16*)(ws + WS_YK1); float* ypre = (float*)(ws + WS_YK1); float* xact = out;

    if (hipMemsetAsync(ws + WS_CTL, 0, CTL_ZERO_BYTES, stream) != hipSuccess) return;
    Args a{};
    for (int i = 0; i < 25; ++i) a.in[i] = (const float*)d_in[i];
    a.out = out; a.ws = ws;
    launch_mk(a, 0, 3, 0, grid, stream);
    nv::k_cumf<<<1, 64, 0, stream>>>(dtf, fg_bias, ck);
    nv::k_conv<<<(M * DXBC) / 256, 256, 0, stream>>>(proj, conv_w, conv_b, xact);
    nv::k_ssd<<<NB * NH, 256, 0, stream>>>(xact, dtf, dt_bias, a_log, d_skip, ypre);
    nv::k_ssm_norm<<<M * 2 / 4, 256, 0, stream>>>(ypre, proj, ssm_ng, ycat);
    nv::k_attn<<<NB * NH * 32, 64, 0, stream>>>(proj, ck);
    nv::k_attn_norm<<<M / 4, 256, 0, stream>>>(proj, att_ng, ycat);
    { nv::CxOut cx{ycat, w_out, out}; nv::k_gemm<false, nv::CxOut><<<dim3(D / 64, M / 64, 1), 256, 0, stream>>>(cx); }
    nv::k_ln1_router<<<M / 4, 256, 0, stream>>>(x, out, mod, ln1_g, ln1_b, rgw, rgb, rew, reb, u2, cnt, list, toke, tokw, toks);
    { nv::CxMoe1 cx{cnt, list, u2, w_gate, w_up, hmid}; nv::k_gemm<true, nv::CxMoe1><<<dim3(DE / 64, LCAP / 64, NE), 256, 0, stream>>>(cx); }
    { nv::CxMoe2 cx{cnt, list, hmid, w_down, yk0, yk1}; nv::k_gemm<false, nv::CxMoe2><<<dim3(D / 64, LCAP / 64, NE), 256, 0, stream>>>(cx); }
    nv::k_final<<<M / 4, 256, 0, stream>>>(out, mod, yk0, yk1, tokw, ln2_g, ln2_b);
}
```

```cpp
#include <hip/hip_runtime.h>
#include <cstdio>
#include <cstdint>

constexpr int NB = 8, T = 2048, D = 1024, M = NB * T;
constexpr int DSSM = 512, DATT = 512, HD = 64, NH = 8, NG = 2, NST = 128, DXBC = 1024, DIN = 3088;
constexpr int NE = 32, DE = 512, LCAP = 16384;
constexpr int PW = 3072;
constexpr int PC_Z = 0, PC_XS = 512, PC_Q = 1536, PC_K = 2048, PC_V = 2560;
constexpr float ALPHA = 1.189207115002721f;
constexpr float EPS = 1e-5f;
constexpr float LOG2E = 1.4426950408889634f;
constexpr float QSCALE = 0.125f * LOG2E;
constexpr int MAXSLOT = 160 * 256;

constexpr size_t MiB = 1u << 20;
constexpr size_t WS_CTL = 0, CTL_ZERO_BYTES = 1 * MiB;
constexpr size_t WS_WIN = 1 * MiB, WS_WOUT = 7 * MiB, WS_WGU = 9 * MiB, WS_WDN = 73 * MiB;
constexpr size_t WS_A = 105 * MiB;
constexpr size_t WS_B = 137 * MiB;
constexpr size_t WS_YK1 = 233 * MiB;
constexpr size_t WS_MISC = 265 * MiB;
constexpr size_t WS_MOD = WS_MISC;
constexpr size_t WS_DTF = WS_MISC + 1 * MiB;
constexpr size_t WS_CK = WS_MISC + 2 * MiB;
constexpr size_t WS_TOKE = WS_MISC + 3 * MiB;
constexpr size_t WS_TOKW = WS_TOKE + 256 * 1024;
constexpr size_t WS_TOKS = WS_TOKW + 256 * 1024;
constexpr size_t WS_LIST = WS_MISC + 4 * MiB;
constexpr size_t WS_MODP = WS_YK1;
constexpr size_t WS_END = 272 * MiB;
constexpr int CW_CNT = 1024;

typedef unsigned short bf16;
typedef float f32x4 __attribute__((ext_vector_type(4)));
typedef unsigned u32x4 __attribute__((ext_vector_type(4)));
typedef unsigned u32x2 __attribute__((ext_vector_type(2)));

__device__ __forceinline__ unsigned f2bf(float f) { unsigned u = __builtin_bit_cast(unsigned, f); return (u + 0x7fffu + ((u >> 16) & 1u)) >> 16; }
__device__ __forceinline__ float bf2f(unsigned b) { return __builtin_bit_cast(float, (b & 0xffffu) << 16); }
__device__ __forceinline__ unsigned pk2(float lo, float hi) { return f2bf(lo) | (f2bf(hi) << 16); }
__device__ __forceinline__ float silu_f(float x) { return x / (1.f + expf(-x)); }
__device__ __forceinline__ float softplus_f(float x) { return fmaxf(x, 0.f) + log1pf(expf(-fabsf(x))); }
__device__ __forceinline__ float wave_sum(float v) {
#pragma unroll
    for (int o = 1; o < 64; o <<= 1) v += __shfl_xor(v, o);
    return v;
}

namespace nv {
__global__ void __launch_bounds__(256) k_mod(const float* c, const float* ada_w, const float* ada_b, float* mod) {
    const int j = blockIdx.x * 256 + threadIdx.x;
    __shared__ float sc[NB][D];
    for (int i = threadIdx.x; i < NB * D; i += 256) sc[i / D][i % D] = silu_f(c[i]);
    __syncthreads();
    float acc[NB];
#pragma unroll
    for (int b = 0; b < NB; ++b) acc[b] = 0.f;
    for (int k = 0; k < D; ++k) { const float w = ada_w[(size_t)k * 6144 + j];
#pragma unroll
        for (int b = 0; b < NB; ++b) acc[b] += sc[b][k] * w; }
#pragma unroll
    for (int b = 0; b < NB; ++b) mod[b * 6144 + j] = acc[b] + ada_b[j];
}

template <bool DUAL, class Ctx>
__global__ void __launch_bounds__(256) k_gemm(Ctx cx) {
    __shared__ float As[16][68], Bs[16][68], Bs2[DUAL ? 16 : 1][68];
    __shared__ int s_info[4];
    if (!cx.setup(s_info)) return;
    __syncthreads();
    const int tm = blockIdx.y * 64, tn = blockIdx.x * 64, tid = threadIdx.x, tx = tid & 15, ty = tid >> 4;
    const int K = cx.K();
    float acc[4][4], acc2[4][4];
#pragma unroll
    for (int i = 0; i < 4; ++i)
#pragma unroll
        for (int j = 0; j < 4; ++j) { acc[i][j] = 0.f; acc2[i][j] = 0.f; }
    for (int k0 = 0; k0 < K; k0 += 16) {
#pragma unroll
        for (int i = 0; i < 4; ++i) { const int idx = tid + i * 256, r = idx >> 4, kk = idx & 15; As[kk][r] = cx.a(s_info, tm + r, k0 + kk); }
#pragma unroll
        for (int i = 0; i < 4; ++i) { const int idx = tid + i * 256, kk = idx >> 6, n = idx & 63; Bs[kk][n] = cx.b(s_info, k0 + kk, tn + n); if (DUAL) Bs2[kk][n] = cx.b2(s_info, k0 + kk, tn + n); }
        __syncthreads();
#pragma unroll
        for (int kk = 0; kk < 16; ++kk) {
            float a[4], b[4], b2[4];
#pragma unroll
            for (int i = 0; i < 4; ++i) { a[i] = As[kk][ty * 4 + i]; b[i] = Bs[kk][tx * 4 + i]; b2[i] = DUAL ? Bs2[kk][tx * 4 + i] : 0.f; }
#pragma unroll
            for (int i = 0; i < 4; ++i)
#pragma unroll
                for (int j = 0; j < 4; ++j) { acc[i][j] += a[i] * b[j]; if (DUAL) acc2[i][j] += a[i] * b2[j]; }
        }
        __syncthreads();
    }
#pragma unroll
    for (int i = 0; i < 4; ++i)
#pragma unroll
        for (int j = 0; j < 4; ++j) cx.epi(s_info, tm + ty * 4 + i, tn + tx * 4 + j, acc[i][j], acc2[i][j]);
}

struct CxIn {
    const float* x; const float* mod; const float* w; bf16* proj; float* dtf;
    __device__ bool setup(int*) const { return true; }
    __device__ int K() const { return D; }
    __device__ float a(const int*, int m, int k) const { const int b = m / T; return x[(size_t)m * D + k] * (1.f + mod[b * 6144 + D + k]) + mod[b * 6144 + k]; }
    __device__ float b(const int*, int k, int n) const { return n < DIN ? w[(size_t)k * DIN + n] : 0.f; }
    __device__ float b2(const int*, int, int) const { return 0.f; }
    __device__ void epi(const int*, int m, int n, float v, float) const {
        if (n >= DIN) return;
        if (n < 1536) proj[(size_t)m * PW + n] = (bf16)f2bf(v);
        else if (n < 1544) dtf[m * 16 + (n - 1536)] = v;
        else if (n < 3080) { const int c = n - 8; proj[(size_t)m * PW + c] = (bf16)f2bf(c < PC_K ? v * QSCALE : v); }
        else dtf[m * 16 + 8 + (n - 3080)] = v;
    }
};
struct CxOut {
    const bf16* ycat; const float* w; float* h;
    __device__ bool setup(int*) const { return true; }
    __device__ int K() const { return D; }
    __device__ float a(const int*, int m, int k) const { return bf2f(ycat[(size_t)m * D + k]); }
    __device__ float b(const int*, int k, int n) const { return w[(size_t)k * D + n]; }
    __device__ float b2(const int*, int, int) const { return 0.f; }
    __device__ void epi(const int*, int m, int n, float v, float) const { h[(size_t)m * D + n] = v; }
};
__device__ __forceinline__ bool moe_setup(const unsigned* cnt, int* s_info) {
    const int e = blockIdx.z; const int n = (int)cnt[e];
    if ((int)blockIdx.y * 64 >= n) return false;
    if (threadIdx.x == 0) { int base = 0; for (int i = 0; i < e; ++i) base += ((int)cnt[i] + 255) / 256 * 256; s_info[0] = e; s_info[1] = n; s_info[2] = base; }
    return true;
}
struct CxMoe1 {
    const unsigned* cnt; const int* list; const bf16* u2; const float* wg; const float* wu; bf16* hmid;
    __device__ bool setup(int* s) const { return moe_setup(cnt, s); }
    __device__ int K() const { return D; }
    __device__ float a(const int* s, int m, int k) const { if (m >= s[1]) return 0.f; const int tok = list[s[0] * LCAP + m] >> 1; return bf2f(u2[(size_t)tok * D + k]); }
    __device__ float b(const int* s, int k, int n) const { return wg[((size_t)s[0] * D + k) * DE + n]; }
    __device__ float b2(const int* s, int k, int n) const { return wu[((size_t)s[0] * D + k) * DE + n]; }
    __device__ void epi(const int* s, int m, int n, float g, float u) const { if (m >= s[1]) return; hmid[(size_t)(s[2] + m) * DE + n] = (bf16)f2bf(silu_f(g) * u); }
};
struct CxMoe2 {
    const unsigned* cnt; const int* list; const bf16* hmid; const float* wd; bf16* yk0; bf16* yk1;
    __device__ bool setup(int* s) const { return moe_setup(cnt, s); }
    __device__ int K() const { return DE; }
    __device__ float a(const int* s, int m, int k) const { if (m >= s[1]) return 0.f; return bf2f(hmid[(size_t)(s[2] + m) * DE + k]); }
    __device__ float b(const int* s, int k, int n) const { return wd[((size_t)s[0] * DE + k) * D + n]; }
    __device__ float b2(const int*, int, int) const { return 0.f; }
    __device__ void epi(const int* s, int m, int n, float v, float) const { if (m >= s[1]) return; const int a = list[s[0] * LCAP + m]; bf16* y = (a & 1) ? yk1 : yk0; y[(size_t)(a >> 1) * D + n] = (bf16)f2bf(v); }
};

__global__ void k_cumf(const float* dtf, const float* fg_bias, float* ck) {
    const int bh = blockIdx.x * blockDim.x + threadIdx.x; if (bh >= NB * NH) return;
    const int b = bh / NH, h = bh % NH; const float fb = fg_bias[h]; float s = 0.f;
    for (int t = 0; t < T; ++t) { const float f = dtf[(size_t)(b * T + t) * 16 + 8 + h] + fb; s += -softplus_f(-f); ck[(size_t)bh * T + t] = s; }
}
__global__ void __launch_bounds__(256) k_conv(const bf16* proj, const float* cw, const float* cb, float* xact) {
    const size_t i = (size_t)blockIdx.x * 256 + threadIdx.x; const int m = (int)(i / DXBC), ch = (int)(i % DXBC), t = m % T;
    float acc = cb[ch];
#pragma unroll
    for (int j = 0; j < 4; ++j) { const int tt = t - 3 + j; if (tt >= 0) acc += cw[j * DXBC + ch] * bf2f(proj[(size_t)(m - 3 + j) * PW + PC_XS + ch]); }
    xact[i] = silu_f(acc);
}
__global__ void __launch_bounds__(256) k_ssd(const float* xact, const float* dtf, const float* dt_bias, const float* a_log, const float* d_skip, float* ypre) {
    const int b = blockIdx.x / NH, h = blockIdx.x % NH, g = h / 4, p = threadIdx.x >> 2, nq = threadIdx.x & 3;
    const float A = -expf(a_log[h]), Dh = d_skip[h], dtb = dt_bias[h];
    float st[32];
#pragma unroll
    for (int i = 0; i < 32; ++i) st[i] = 0.f;
    for (int t = 0; t < T; ++t) {
        const size_t m = (size_t)b * T + t;
        const float dtv = softplus_f(dtf[m * 16 + h] + dtb), dA = expf(dtv * A);
        const float xv = xact[m * DXBC + h * 64 + p], xd = xv * dtv;
        const f32x4* Bp = (const f32x4*)(xact + m * DXBC + 512 + g * 128 + nq * 32);
        const f32x4* Cp = (const f32x4*)(xact + m * DXBC + 768 + g * 128 + nq * 32);
        float y = 0.f;
#pragma unroll
        for (int i = 0; i < 8; ++i) { const f32x4 bv = Bp[i], cv = Cp[i];
#pragma unroll
            for (int j = 0; j < 4; ++j) { st[i * 4 + j] = dA * st[i * 4 + j] + xd * bv[j]; y += cv[j] * st[i * 4 + j]; } }
        y += __shfl_xor(y, 1); y += __shfl_xor(y, 2);
        if (nq == 0) ypre[m * DSSM + h * 64 + p] = y + Dh * xv;
    }
}
__global__ void __launch_bounds__(256) k_ssm_norm(const float* ypre, const bf16* proj, const float* ng, bf16* ycat) {
    const int w = (blockIdx.x * 256 + threadIdx.x) >> 6, lane = threadIdx.x & 63, m = w >> 1, g = w & 1;
    float v[4]; float ss = 0.f;
#pragma unroll
    for (int j = 0; j < 4; ++j) { const int c = g * 256 + lane * 4 + j; v[j] = ypre[(size_t)m * DSSM + c] * silu_f(bf2f(proj[(size_t)m * PW + PC_Z + c])); ss += v[j] * v[j]; }
    const float r = 1.f / sqrtf(wave_sum(ss) * (1.f / 256.f) + EPS);
#pragma unroll
    for (int j = 0; j < 4; ++j) { const int c = g * 256 + lane * 4 + j; ycat[(size_t)m * D + c] = (bf16)f2bf(v[j] * r * ng[c]); }
}
__global__ void __launch_bounds__(64) k_attn(bf16* proj, const float* ck) {
    __shared__ float Ks[64][64], Vs[64][64], cks[64];
    const int blk = blockIdx.x, qt = blk % 32, bh = blk / 32, b = bh / NH, h = bh % NH, lane = threadIdx.x;
    const int q = qt * 64 + lane; const size_t mq = (size_t)b * T + q;
    float Q[64], O[64];
#pragma unroll
    for (int d = 0; d < 64; ++d) { Q[d] = bf2f(proj[mq * PW + PC_Q + h * 64 + d]); O[d] = 0.f; }
    const float cq = ck[(size_t)bh * T + q];
    float mrun = -INFINITY, lrun = 0.f;
    for (int kt = 0; kt <= qt; ++kt) {
        __syncthreads();
        for (int i = lane; i < 64 * 64; i += 64) { const int r = i >> 6, d = i & 63; const size_t mk = (size_t)b * T + kt * 64 + r;
            Ks[r][d] = bf2f(proj[mk * PW + PC_K + h * 64 + d]); Vs[r][d] = bf2f(proj[mk * PW + PC_V + h * 64 + d]); }
        cks[lane] = ck[(size_t)bh * T + kt * 64 + lane];
        __syncthreads();
        const int jmax = (kt == qt) ? lane : 63;
        for (int j = 0; j <= jmax; ++j) {
            float s = 0.f;
#pragma unroll
            for (int d = 0; d < 64; ++d) s += Q[d] * Ks[j][d];
            s += (cq - cks[j]) * LOG2E;
            const float mn = fmaxf(mrun, s), al = exp2f(mrun - mn), pj = exp2f(s - mn);
            lrun = lrun * al + pj; mrun = mn;
#pragma unroll
            for (int d = 0; d < 64; ++d) O[d] = O[d] * al + pj * Vs[j][d];
        }
    }
    const float il = 1.f / lrun;
#pragma unroll
    for (int d = 0; d < 64; ++d) proj[mq * PW + PC_Q + h * 64 + d] = (bf16)f2bf(O[d] * il);
}
__global__ void __launch_bounds__(256) k_attn_norm(const bf16* proj, const float* ng, bf16* ycat) {
    const int m = (blockIdx.x * 256 + threadIdx.x) >> 6, lane = threadIdx.x & 63;
    float v[8]; float ss = 0.f;
#pragma unroll
    for (int j = 0; j < 8; ++j) { v[j] = bf2f(proj[(size_t)m * PW + PC_Q + lane * 8 + j]); ss += v[j] * v[j]; }
    const float r = 1.f / sqrtf(wave_sum(ss) * (1.f / 512.f) + EPS);
#pragma unroll
    for (int j = 0; j < 8; ++j) ycat[(size_t)m * D + 512 + lane * 8 + j] = (bf16)f2bf(v[j] * r * ng[lane * 8 + j]);
}
__global__ void __launch_bounds__(256) k_ln1_router(const float* x, float* hx1, const float* mod, const float* g1, const float* b1,
                                                    const float* rgw, const float* rgb, const float* rew, const float* reb,
                                                    bf16* u2, unsigned* cnt, int* list, int* toke, float* tokw, int* toks) {
    const int m = (blockIdx.x * 256 + threadIdx.x) >> 6, lane = threadIdx.x & 63, b = m / T;
    const float* mb = mod + b * 6144;
    float v[16]; float s = 0.f;
#pragma unroll
    for (int j = 0; j < 4; ++j) { const int c = 4 * lane + 256 * j; const f32x4 xv = *(const f32x4*)(x + (size_t)m * D + c), hv = *(const f32x4*)(hx1 + (size_t)m * D + c), gt = *(const f32x4*)(mb + 2 * D + c);
#pragma unroll
        for (int i = 0; i < 4; ++i) { v[j * 4 + i] = ALPHA * xv[i] + (1.f + gt[i]) * hv[i]; s += v[j * 4 + i]; } }
    const float mean = wave_sum(s) * (1.f / D); float s2 = 0.f;
#pragma unroll
    for (int i = 0; i < 16; ++i) { v[i] -= mean; s2 += v[i] * v[i]; }
    const float rstd = 1.f / sqrtf(wave_sum(s2) * (1.f / D) + EPS);
    float acc[36];
#pragma unroll
    for (int i = 0; i < 36; ++i) acc[i] = 0.f;
#pragma unroll
    for (int j = 0; j < 4; ++j) { const int c = 4 * lane + 256 * j; const f32x4 gg = *(const f32x4*)(g1 + c), bb = *(const f32x4*)(b1 + c), sc = *(const f32x4*)(mb + 4 * D + c), sh = *(const f32x4*)(mb + 3 * D + c);
        f32x4 x1, uu;
#pragma unroll
        for (int i = 0; i < 4; ++i) { x1[i] = v[j * 4 + i] * rstd * gg[i] + bb[i]; uu[i] = x1[i] * (1.f + sc[i]) + sh[i]; }
        *(f32x4*)(hx1 + (size_t)m * D + c) = x1;
        u32x2 pk; pk.x = pk2(uu[0], uu[1]); pk.y = pk2(uu[2], uu[3]); *(u32x2*)(u2 + (size_t)m * D + c) = pk;
#pragma unroll
        for (int i = 0; i < 4; ++i) { const int k = c + i; const f32x4 wg = *(const f32x4*)(rgw + (size_t)k * 4);
#pragma unroll
            for (int q = 0; q < 4; ++q) acc[q] += uu[i] * wg[q];
#pragma unroll
            for (int q8 = 0; q8 < 8; ++q8) { const f32x4 we = *(const f32x4*)(rew + (size_t)k * 32 + q8 * 4);
#pragma unroll
                for (int q = 0; q < 4; ++q) acc[4 + q8 * 4 + q] += uu[i] * we[q]; } } }
#pragma unroll
    for (int i = 0; i < 36; ++i) acc[i] = wave_sum(acc[i]);
    float lg[4]; float mx = -INFINITY; int gi = 0;
#pragma unroll
    for (int i = 0; i < 4; ++i) { lg[i] = acc[i] + rgb[i]; if (lg[i] > mx) { mx = lg[i]; gi = i; } }
    float se = 0.f;
#pragma unroll
    for (int i = 0; i < 4; ++i) se += expf(lg[i] - mx);
    const float gp = 1.f / se;
    float le[8]; float mxe = -INFINITY;
#pragma unroll
    for (int i = 0; i < 8; ++i) { float t = 0.f;
#pragma unroll
        for (int gq = 0; gq < 4; ++gq) t = (gi == gq) ? acc[4 + gq * 8 + i] + reb[gq * 8 + i] : t;
        le[i] = t; mxe = fmaxf(mxe, t); }
    float pe[8];
#pragma unroll
    for (int i = 0; i < 8; ++i) pe[i] = expf(le[i] - mxe);
    int i1 = 0; float p1 = -1.f;
#pragma unroll
    for (int i = 0; i < 8; ++i) if (pe[i] > p1) { p1 = pe[i]; i1 = i; }
    int i2 = 0; float p2 = -1.f;
#pragma unroll
    for (int i = 0; i < 8; ++i) if (i != i1 && pe[i] > p2) { p2 = pe[i]; i2 = i; }
    const float inv = 1.f / (p1 + p2);
    if (lane == 0) {
        const int e0 = gi * 8 + i1, e1 = gi * 8 + i2;
        const unsigned q0 = atomicAdd(&cnt[e0], 1u), q1 = atomicAdd(&cnt[e1], 1u);
        list[e0 * LCAP + q0] = m * 2; list[e1 * LCAP + q1] = m * 2 + 1;
        toke[m * 2] = e0; toke[m * 2 + 1] = e1; tokw[m * 2] = gp * p1 * inv; tokw[m * 2 + 1] = gp * p2 * inv; toks[m * 2] = (int)q0; toks[m * 2 + 1] = (int)q1;
    }
}
__global__ void __launch_bounds__(256) k_final(float* out, const float* mod, const bf16* yk0, const bf16* yk1, const float* tokw, const float* g2, const float* b2) {
    const int m = (blockIdx.x * 256 + threadIdx.x) >> 6, lane = threadIdx.x & 63, b = m / T;
    const float* mb = mod + b * 6144; const float w0 = tokw[m * 2], w1 = tokw[m * 2 + 1];
    float v[16]; float s = 0.f;
#pragma unroll
    for (int j = 0; j < 4; ++j) { const int c = 4 * lane + 256 * j; const f32x4 xv = *(const f32x4*)(out + (size_t)m * D + c), gt = *(const f32x4*)(mb + 5 * D + c);
        const u32x2 a = *(const u32x2*)(yk0 + (size_t)m * D + c), bq = *(const u32x2*)(yk1 + (size_t)m * D + c);
        const float y0[4] = {bf2f(a.x), bf2f(a.x >> 16), bf2f(a.y), bf2f(a.y >> 16)}, y1[4] = {bf2f(bq.x), bf2f(bq.x >> 16), bf2f(bq.y), bf2f(bq.y >> 16)};
#pragma unroll
        for (int i = 0; i < 4; ++i) { v[j * 4 + i] = ALPHA * xv[i] + (1.f + gt[i]) * (w0 * y0[i] + w1 * y1[i]); s += v[j * 4 + i]; } }
    const float mean = wave_sum(s) * (1.f / D); float s2 = 0.f;
#pragma unroll
    for (int i = 0; i < 16; ++i) { v[i] -= mean; s2 += v[i] * v[i]; }
    const float rstd = 1.f / sqrtf(wave_sum(s2) * (1.f / D) + EPS);
#pragma unroll
    for (int j = 0; j < 4; ++j) { const int c = 4 * lane + 256 * j; const f32x4 gg = *(const f32x4*)(g2 + c), bb = *(const f32x4*)(b2 + c); f32x4 o;
#pragma unroll
        for (int i = 0; i < 4; ++i) o[i] = v[j * 4 + i] * rstd * gg[i] + bb[i];
        *(f32x4*)(out + (size_t)m * D + c) = o; }
}
}
namespace pg8 {
#define PG8_LAS __attribute__((address_space(3)))
typedef unsigned short bf16_t;
typedef short bf16x8 __attribute__((ext_vector_type(8)));
typedef float f32x4 __attribute__((ext_vector_type(4)));
typedef float f32x2 __attribute__((ext_vector_type(2)));
typedef unsigned u32x4 __attribute__((ext_vector_type(4)));
constexpr int BM = 256, BK = 64, HALF = 128, HTB = HALF * BK * 2  , STAGE_BYTES = 8 * HTB, NXCD = 8, WGM = 8;

__host__ __device__ __forceinline__ int lds_byte(int r, int c) { const int st = (r >> 4) * 2 + (c >> 5), rr = r & 15, cc = c & 31, ob = rr * 64 + cc * 2; return st * 1024 + (ob ^ (((ob >> 9) & 1) << 5)); }
__host__ __device__ __forceinline__ void stage_rc(int b, int& R, int& C) { const int st = b / 1024, sb = b % 1024, swz = sb ^ (((sb >> 9) & 1) << 5); R = (st >> 1) * 16 + swz / 64; C = (st & 1) * 32 + (swz % 64) / 2; }
__host__ __device__ __forceinline__ int perm32(int rho) { const int n = rho >> 4, i = rho & 15; return 8 * (i >> 2) + 4 * n + (i & 3); }

struct Unit { int pm, pn; unsigned boff; int x0, x1, x2; };
struct Gemm { const bf16_t* A; const bf16_t* Bt; int K; };

struct StaticOrder {
    int nM, nN, nwg, G, c, K;
    __device__ void init(int M, int N, int K_, int G_, int c_) { nM = M / BM; nN = N / BM; nwg = nM * nN; G = G_; c = c_; K = K_; }
    __device__ bool next(int i, Unit& u) const {
        const long L = (long)i * G + c; if (L >= nwg) return false;
        int wgid = (int)L; { const int q = nwg / NXCD, r = nwg % NXCD, xcd = wgid % NXCD, off = wgid / NXCD; wgid = (xcd < r ? xcd * (q + 1) : r * (q + 1) + (xcd - r) * q) + off; }
        const int nig = WGM * nN, gid = wgid / nig, fm = gid * WGM, gsz = (nM - fm) < WGM ? (nM - fm) : WGM;
        u.pm = fm + ((wgid % nig) % gsz); u.pn = (wgid % nig) / gsz; u.boff = (unsigned)u.pn * (unsigned)(BM * K * 2); u.x0 = u.x1 = u.x2 = 0; return true;
    }
    __device__ __forceinline__ unsigned arow(const Unit& u, int r) const { return (unsigned)(u.pm * BM + r) * (unsigned)(K * 2); }
};

__device__ __forceinline__ unsigned cvt_pk_bf16(float lo, float hi) { unsigned r; asm volatile("v_cvt_pk_bf16_f32 %0, %1, %2" : "=v"(r) : "v"(lo), "v"(hi)); return r; }

struct EpiProj {
    static constexpr bool PERM = true;
    bf16_t* O; int ldc; int q_lo, q_hi; float qs;
    __device__ __forceinline__ void operator()(const f32x4 (&acc)[2][2][4][2], const Unit& u, int wr, int wc, int fr, int fq) const {
        const int row0 = u.pm * BM + wr * 64 + fr, colt = u.pn * BM; const float sc = (colt >= q_lo && colt < q_hi) ? qs : 1.f;
        const int col0 = colt + wc * 32 + 8 * fq;
#pragma unroll
        for (int ai = 0; ai < 2; ++ai)
#pragma unroll
            for (int m = 0; m < 4; ++m) { bf16_t* rowp = O + (size_t)(row0 + ai * HALF + m * 16) * ldc + col0;
#pragma unroll
                for (int bj = 0; bj < 2; ++bj) { const f32x4 v0 = acc[ai][bj][m][0] * sc, v1 = acc[ai][bj][m][1] * sc;
                    u32x4 w; w.x = cvt_pk_bf16(v0[0], v0[1]); w.y = cvt_pk_bf16(v0[2], v0[3]); w.z = cvt_pk_bf16(v1[0], v1[1]); w.w = cvt_pk_bf16(v1[2], v1[3]);
                    *(u32x4*)(rowp + bj * HALF) = w; } }
    }
};
struct EpiF32 {
    static constexpr bool PERM = false;
    float* O; int ldc;
    __device__ __forceinline__ void operator()(const f32x4 (&acc)[2][2][4][2], const Unit& u, int wr, int wc, int fr, int fq) const {
        const int row0 = u.pm * BM + wr * 64 + fr, col0 = u.pn * BM + wc * 32 + 4 * fq;
#pragma unroll
        for (int ai = 0; ai < 2; ++ai)
#pragma unroll
            for (int m = 0; m < 4; ++m) { float* rowp = O + (size_t)(row0 + ai * HALF + m * 16) * ldc + col0;
#pragma unroll
                for (int bj = 0; bj < 2; ++bj)
#pragma unroll
                    for (int n = 0; n < 2; ++n) *(f32x4*)(rowp + bj * HALF + n * 16) = acc[ai][bj][m][n]; }
    }
};

struct EpiMoe1 {
    static constexpr bool PERM = true;
    bf16_t* H; int ldc;
    __device__ __forceinline__ void operator()(const f32x4 (&acc)[2][2][4][2], const Unit& u, int wr, int wc, int fr, int fq) const {
        const int row0 = u.pm * BM + wr * 64 + fr, col0 = u.pn * HALF + wc * 32 + 8 * fq;
#pragma unroll
        for (int ai = 0; ai < 2; ++ai)
#pragma unroll
            for (int m = 0; m < 4; ++m) { float hv[8];
#pragma unroll
                for (int n = 0; n < 2; ++n)
#pragma unroll
                    for (int j = 0; j < 4; ++j) { const float gt = acc[ai][0][m][n][j], up = acc[ai][1][m][n][j]; hv[n * 4 + j] = gt * __builtin_amdgcn_rcpf(1.f + __expf(-gt)) * up; }
                u32x4 w; w.x = cvt_pk_bf16(hv[0], hv[1]); w.y = cvt_pk_bf16(hv[2], hv[3]); w.z = cvt_pk_bf16(hv[4], hv[5]); w.w = cvt_pk_bf16(hv[6], hv[7]);
                *(u32x4*)(H + (size_t)(row0 + ai * HALF + m * 16) * ldc + col0) = w; }
    }
};
struct EpiMoe2 {
    static constexpr bool PERM = true;
    bf16_t* Y0; long ydelta; int ldc; const int* list;
    __device__ __forceinline__ void operator()(const f32x4 (&acc)[2][2][4][2], const Unit& u, int wr, int wc, int fr, int fq) const {
        const int col0 = u.pn * BM + wc * 32 + 8 * fq; const int* lp = list + u.x0 * LCAP + u.x1;
#pragma unroll
        for (int ai = 0; ai < 2; ++ai)
#pragma unroll
            for (int m = 0; m < 4; ++m) { const int r = ai * HALF + wr * 64 + m * 16 + fr;
                if (r < u.x2) { const int a = lp[r]; bf16_t* rowp = (bf16_t*)((char*)Y0 + (long)(a & 1) * ydelta) + (size_t)(a >> 1) * ldc + col0;
#pragma unroll
                    for (int bj = 0; bj < 2; ++bj) { const f32x4 v0 = acc[ai][bj][m][0], v1 = acc[ai][bj][m][1];
                        u32x4 w; w.x = cvt_pk_bf16(v0[0], v0[1]); w.y = cvt_pk_bf16(v0[2], v0[3]); w.z = cvt_pk_bf16(v1[0], v1[1]); w.w = cvt_pk_bf16(v1[2], v1[3]);
                        *(u32x4*)(rowp + bj * HALF) = w; } } }
    }
};
struct MoeOrder {
    const PG8_LAS unsigned* tab; const PG8_LAS unsigned* cnts; int ntiles, G, c, mode; const int* list;
    __device__ bool next(int i, Unit& u) const {
        const int L = i * G + c; if (L >= ntiles * 4) return false;
        const int tile = L >> 2; const unsigned w = tab[tile]; const int e = (int)(w & 0xffu), row0 = (int)(w >> 8), rem = (int)cnts[e] - row0;
        u.pm = tile; u.pn = L & 3; u.x0 = e; u.x1 = row0; u.x2 = rem < BM ? rem : BM;
        u.boff = mode == 0 ? (unsigned)(e * 1024 + u.pn * BM) * 2048u : (unsigned)(e * 1024 + u.pn * BM) * 1024u; return true;
    }
    __device__ __forceinline__ unsigned arow(const Unit& u, int r) const {
        if (mode == 0) { const int rr = r < u.x2 ? r : 0; return (unsigned)(list[u.x0 * LCAP + u.x1 + rr] >> 1) * 2048u; }
        return (unsigned)(u.pm * BM + r) * 1024u;
    }
};

template <class Epi, class Sched, bool ALIGN_EPI>
__device__ __forceinline__ void gemm_phase(PG8_LAS unsigned char* lds, const Gemm g, const Sched& S, const Epi& E) {
    const int tid = threadIdx.x, wid = __builtin_amdgcn_readfirstlane(tid >> 6), lane = tid & 63, wr = wid >> 2, wc = wid & 3, fr = lane & 15, fq = lane >> 4;
    const int K = g.K, nt = K / BK;
    int Rp[2], Cp[2]; unsigned voffB[2];
#pragma unroll
    for (int i = 0; i < 2; ++i) { int R, C; stage_rc(tid * 16 + i * 8192, R, C); Rp[i] = R; Cp[i] = C; const int Rb = Epi::PERM ? ((R & ~31) + perm32(R & 31)) : R; voffB[i] = (unsigned)(Rb * K + C) * 2u; }
    const size_t kstep = (size_t)(BK * 2);
    const size_t hstep = (size_t)HALF * K * 2;
    const unsigned ldsw = (unsigned)wid * 1024u;
    const int aoff = lds_byte(wr * 64 + fr, fq * 8), boff = lds_byte(wc * 32 + fr, fq * 8);
    const char* gA = (const char*)g.A;
#define PG8_SA(b, h) (((b) * 2 + (h)) * HTB)
#define PG8_SB(b, h) ((4 + (b) * 2 + (h)) * HTB)
#define PG8_STAGE(bufoff, gbase, voff) do { _Pragma("unroll") for (int _i = 0; _i < 2; ++_i) \
        __builtin_amdgcn_global_load_lds((const unsigned*)((const char*)(gbase) + (voff)[_i]), (PG8_LAS unsigned*)(lds + (bufoff) + ldsw + _i * 8192), 16, 0, 0); } while (0)
#define PG8_STAGE_A(bufoff, kb, V, h) do { _Pragma("unroll") for (int _i = 0; _i < 2; ++_i) \
        __builtin_amdgcn_global_load_lds((const unsigned*)(gA + (kb) + (V)[h][_i]), (PG8_LAS unsigned*)(lds + (bufoff) + ldsw + _i * 8192), 16, 0, 0); } while (0)
#define PG8_LDA(dst, b, h) do { _Pragma("unroll") for (int m = 0; m < 4; ++m) _Pragma("unroll") for (int k = 0; k < 2; ++k) dst[m][k] = *(const PG8_LAS bf16x8*)(lds + PG8_SA(b, h) + aoff + m * 2048 + k * 1024); } while (0)
#define PG8_LDB(dst, b, h) do { _Pragma("unroll") for (int n = 0; n < 2; ++n) _Pragma("unroll") for (int k = 0; k < 2; ++k) dst[n][k] = *(const PG8_LAS bf16x8*)(lds + PG8_SB(b, h) + boff + n * 2048 + k * 1024); } while (0)
#define PG8_MMA(ai, bj, At, Bt) do { __builtin_amdgcn_s_setprio(1); _Pragma("unroll") for (int m = 0; m < 4; ++m) _Pragma("unroll") for (int n = 0; n < 2; ++n) _Pragma("unroll") for (int k = 0; k < 2; ++k) \
        acc[ai][bj][m][n] = __builtin_amdgcn_mfma_f32_16x16x32_bf16(Bt[n][k], At[m][k], acc[ai][bj][m][n], 0, 0, 0); __builtin_amdgcn_s_setprio(0); } while (0)
#define PG8_WAIT_V(n) asm volatile("s_waitcnt vmcnt(" #n ")" ::: "memory")
#define PG8_WAIT_L(n) asm volatile("s_waitcnt lgkmcnt(" #n ")" ::: "memory")
#define PG8_BAR __builtin_amdgcn_s_barrier()
#define PG8_SCHED __builtin_amdgcn_sched_barrier(0)
    Unit cur, nxt; int ui = 0;
    if (!S.next(0, cur)) return;
    f32x4 acc[2][2][4][2];
#pragma unroll
    for (int a = 0; a < 2; ++a)
#pragma unroll
        for (int b = 0; b < 2; ++b)
#pragma unroll
            for (int m = 0; m < 4; ++m)
#pragma unroll
                for (int n = 0; n < 2; ++n) acc[a][b][m][n] = (f32x4){0.f, 0.f, 0.f, 0.f};
    bf16x8 At[4][2], B0[2][2], B1[2][2];
    unsigned vc[2][2], vn[2][2];
#pragma unroll
    for (int h = 0; h < 2; ++h)
#pragma unroll
        for (int i = 0; i < 2; ++i) vc[h][i] = S.arow(cur, h * HALF + Rp[i]) + (unsigned)(Cp[i] * 2);
    const char* cB = (const char*)g.Bt + cur.boff;
    PG8_STAGE(PG8_SB(0, 0), cB, voffB); PG8_STAGE(PG8_SB(0, 1), cB + hstep, voffB); PG8_STAGE_A(PG8_SA(0, 0), 0, vc, 0); PG8_STAGE_A(PG8_SA(0, 1), 0, vc, 1);
    if (wr == 1) PG8_BAR;
    PG8_WAIT_V(2); PG8_BAR;
    PG8_STAGE(PG8_SB(1, 0), cB + kstep, voffB); PG8_STAGE_A(PG8_SA(1, 0), kstep, vc, 0); PG8_STAGE(PG8_SB(1, 1), cB + hstep + kstep, voffB);
    PG8_WAIT_V(6); PG8_BAR;
    for (;;) {
        const bool has_next = S.next(ui + 1, nxt);
        const char* nB = has_next ? (const char*)g.Bt + nxt.boff : cB;
#pragma unroll
        for (int h = 0; h < 2; ++h)
#pragma unroll
            for (int i = 0; i < 2; ++i) vn[h][i] = has_next ? S.arow(nxt, h * HALF + Rp[i]) + (unsigned)(Cp[i] * 2) : vc[h][i];
        for (int t = 0; t < nt; t += 2) {
            const bool last = (t == nt - 2);
            const size_t k1 = (size_t)(t + 1) * kstep;
            const size_t k2 = last ? 0 : (size_t)(t + 2) * kstep, k3 = k2 + kstep;
            const char* b2 = last ? nB : cB + (size_t)(t + 2) * kstep; const char* b3 = b2 + kstep;
            unsigned v2[2][2];
#pragma unroll
            for (int h = 0; h < 2; ++h)
#pragma unroll
                for (int i = 0; i < 2; ++i) v2[h][i] = last ? vn[h][i] : vc[h][i];
            PG8_LDB(B0, 0, 0); PG8_LDB(B1, 0, 1); PG8_SCHED; PG8_LDA(At, 0, 0); PG8_STAGE_A(PG8_SA(1, 1), k1, vc, 1);
            PG8_WAIT_V(8); PG8_WAIT_L(0); PG8_BAR; PG8_MMA(0, 0, At, B0); PG8_MMA(0, 1, At, B1); PG8_BAR; PG8_SCHED;
            PG8_LDA(At, 0, 1); PG8_STAGE(PG8_SB(0, 0), b2, voffB); PG8_STAGE(PG8_SB(0, 1), b2 + hstep, voffB); PG8_STAGE_A(PG8_SA(0, 0), k2, v2, 0);
            PG8_WAIT_V(8); PG8_WAIT_L(0); PG8_BAR; PG8_MMA(1, 0, At, B0); PG8_MMA(1, 1, At, B1); PG8_BAR; PG8_SCHED;
            PG8_LDB(B0, 1, 0); PG8_LDB(B1, 1, 1); PG8_SCHED; PG8_LDA(At, 1, 0); PG8_STAGE_A(PG8_SA(0, 1), k2, v2, 1);
            PG8_WAIT_V(8); PG8_WAIT_L(0); PG8_BAR; PG8_MMA(0, 0, At, B0); PG8_MMA(0, 1, At, B1); PG8_BAR; PG8_SCHED;
            PG8_LDA(At, 1, 1); PG8_STAGE(PG8_SB(1, 0), b3, voffB); PG8_STAGE(PG8_SB(1, 1), b3 + hstep, voffB); PG8_STAGE_A(PG8_SA(1, 0), k3, v2, 0);
            PG8_WAIT_V(8); PG8_WAIT_L(0); PG8_BAR; PG8_MMA(1, 0, At, B0); PG8_MMA(1, 1, At, B1); PG8_BAR; PG8_SCHED;
        }
        if constexpr (ALIGN_EPI) { if (wr == 0) PG8_BAR; }
        E(acc, cur, wr, wc, fr, fq);
        if (!has_next) break;
#pragma unroll
        for (int a = 0; a < 2; ++a)
#pragma unroll
            for (int b = 0; b < 2; ++b)
#pragma unroll
                for (int m = 0; m < 4; ++m)
#pragma unroll
                    for (int n = 0; n < 2; ++n) acc[a][b][m][n] = (f32x4){0.f, 0.f, 0.f, 0.f};
        cur = nxt; cB = nB; ++ui;
#pragma unroll
        for (int h = 0; h < 2; ++h)
#pragma unroll
            for (int i = 0; i < 2; ++i) vc[h][i] = vn[h][i];
        if constexpr (ALIGN_EPI) { if (wr == 1) PG8_BAR; }
    }
    PG8_WAIT_V(0);
    if constexpr (!ALIGN_EPI) { if (wr == 0) PG8_BAR; }
    PG8_BAR;
#undef PG8_SA
#undef PG8_SB
#undef PG8_STAGE
#undef PG8_STAGE_A
#undef PG8_LDA
#undef PG8_LDB
#undef PG8_MMA
#undef PG8_WAIT_V
#undef PG8_WAIT_L
#undef PG8_BAR
#undef PG8_SCHED
}
}
constexpr int NWAVES = 8;
constexpr int RING_OFF = 0, RING_BYTES = 131072;
constexpr int LDSCTL_OFF = RING_BYTES, MISC_OFF = LDSCTL_OFF + 320;
constexpr int LDS_BYTES = 147456;
static_assert(MISC_OFF + 128 <= LDS_BYTES, "LDS map");
constexpr int TAB_OFF = MISC_OFF + 128;
static_assert(TAB_OFF + 224 * 4 <= LDS_BYTES, "LDS map");
constexpr int CW_TMO = 0, CW_CODE = 1, CW_BAR = 4096, MAX_BAR_REGIONS = 8;

#define GAS __attribute__((address_space(1)))
#define LAS __attribute__((address_space(3)))
typedef short bf16x8 __attribute__((ext_vector_type(8)));
typedef GAS unsigned gu32;
#define RLX_AGENT __ATOMIC_RELAXED, __HIP_MEMORY_SCOPE_AGENT
#define LDS_WAIT() asm volatile("s_waitcnt lgkmcnt(0)" ::: "memory")
#define VM_WAIT() asm volatile("s_waitcnt vmcnt(0)" ::: "memory")

#define XB_TMO      128
#define XB_XCNT(j)  (256  + 64 * (j))
#define XB_XSUB(j)  (1280 + 64 * (j))
#define XB_XGEN(j)  (2304 + 64 * (j))
#define XB_TOP      3328
#define XB_TOPGEN   3392
#define XCD_BAR_WORDS 3456
#define XB_SPIN_CAP (1u << 18)

__device__ __forceinline__ unsigned xb_ld(unsigned* p)              { return __hip_atomic_load(p, __ATOMIC_RELAXED, __HIP_MEMORY_SCOPE_AGENT); }
__device__ __forceinline__ unsigned xb_add(unsigned* p, unsigned v) { return __hip_atomic_fetch_add(p, v, __ATOMIC_RELAXED, __HIP_MEMORY_SCOPE_AGENT); }
__device__ __forceinline__ unsigned xb_xcc_id() { return (unsigned)__builtin_amdgcn_s_getreg((3 << 11) | 20) & 0xFu; }
#define XB_SPIN(cond, bar) do { unsigned _sp = 0; while (cond) { __builtin_amdgcn_s_sleep(1); \
    if ((++_sp & 255u) == 0u) { if (xb_ld(&(bar)[XB_TMO])) break; if (_sp > XB_SPIN_CAP) { atomicAdd(&(bar)[XB_TMO], 1u); break; } } } } while (0)

struct XcdBarrier {
    unsigned* bar; unsigned x;
    volatile LAS unsigned* st;
};

__device__ __forceinline__ XcdBarrier xcd_barrier_post(unsigned* bar, volatile LAS unsigned* st) {
    XcdBarrier b; b.bar = bar; b.x = xb_xcc_id(); b.st = st;
    if (threadIdx.x == 0) (void)xb_add(&bar[XB_XCNT(b.x)], 1u);
    return b;
}
__device__ __forceinline__ void xcd_barrier_complete(unsigned* bar, unsigned x, unsigned& nloc, unsigned& nx) {
    const unsigned G = gridDim.x * gridDim.y * gridDim.z;
    unsigned sum, cnt, mine, sp = 0u;
    for (;;) {
        sum = 0u; cnt = 0u; mine = 0u;
#pragma unroll
        for (unsigned j = 0; j < 16; ++j) { const unsigned c = xb_ld(&bar[XB_XCNT(j)]); sum += c; cnt += (c > 0u) ? 1u : 0u; mine = (j == x) ? c : mine; }
        if (sum == G) break;
        __builtin_amdgcn_s_sleep(1);
        if ((++sp & 255u) == 0u) { if (xb_ld(&bar[XB_TMO])) break; if (sp > XB_SPIN_CAP) { atomicAdd(&bar[XB_TMO], 1u); break; } }
    }
    nloc = mine > 0u ? mine : 1u; nx = cnt > 0u ? cnt : 1u;
}

__device__ __forceinline__ void xcd_barrier(const XcdBarrier& b) {
    asm volatile("s_waitcnt vmcnt(0)" ::: "memory");
    __syncthreads();
    if (threadIdx.x == 0) {
        unsigned* bar = b.bar;
        __builtin_amdgcn_s_waitcnt(0);
        unsigned nloc = b.st[0], nx = b.st[1];
        if (nloc == 0u) { xcd_barrier_complete(bar, b.x, nloc, nx); b.st[0] = nloc; b.st[1] = nx; }
        const unsigned old = xb_add(&bar[XB_XSUB(b.x)], 1u);
        const unsigned gen = old / nloc;
        if (old + 1u == (gen + 1u) * nloc) {
            __builtin_amdgcn_fence(__ATOMIC_RELEASE, "agent");
            asm volatile("s_waitcnt vmcnt(0)" ::: "memory");
            const unsigned og = xb_add(&bar[XB_TOP], 1u);
            const unsigned tg = og / nx;
            if (og + 1u == (tg + 1u) * nx) xb_add(&bar[XB_TOPGEN], 1u);
            else XB_SPIN(xb_ld(&bar[XB_TOPGEN]) == tg, bar);
            __builtin_amdgcn_fence(__ATOMIC_ACQUIRE, "agent");
            xb_add(&bar[XB_XGEN(b.x)], 1u);
            asm volatile("s_waitcnt vmcnt(0)" ::: "memory");
        } else {
            XB_SPIN(xb_ld(&bar[XB_XGEN(b.x)]) == gen, bar);
            __builtin_amdgcn_fence(__ATOMIC_ACQUIRE, "agent");
            asm volatile("s_waitcnt vmcnt(0)" ::: "memory");
        }
    }
    __syncthreads();
}


struct Args {
    const float* in[25]; float* out; unsigned char* ws; int ph_lo, ph_hi, li, pad;
};
struct Frame {
    LAS unsigned char* lds; volatile LAS unsigned* MISC; gu32* ctl;
    int tid, lane, wave, vcu, G;
};

__device__ __forceinline__ void transpose_item(const float* Wsrc, int ld, bf16* dst, int Kd, LAS float* scr, int lane) {
#pragma unroll 8
    for (int i = 0; i < 32; ++i) { const int kk = 2 * i + (lane >> 5); scr[kk * 33 + (lane & 31)] = Wsrc[(size_t)kk * ld + (lane & 31)]; }
    LDS_WAIT(); asm volatile("" ::: "memory");
    const int c = lane & 7;
#pragma unroll
    for (int j = 0; j < 4; ++j) { const int n = (lane >> 3) + 8 * j; const LAS float* s = scr + (8 * c) * 33 + n;
        u32x4 o; o.x = pk2(s[0 * 33], s[1 * 33]); o.y = pk2(s[2 * 33], s[3 * 33]); o.z = pk2(s[4 * 33], s[5 * 33]); o.w = pk2(s[6 * 33], s[7 * 33]);
        *(GAS u32x4*)(dst + (size_t)n * Kd + 8 * c) = o; }
    LDS_WAIT(); asm volatile("" ::: "memory");
}
constexpr int P0_MODT = 96 * 16;
constexpr int P0_IWIN = 16 * 96, P0_IWOUT = 16 * 32, P0_IEXP = 768;
constexpr int P0_NTASK = P0_MODT + P0_IWIN + P0_IWOUT + NE * P0_IEXP;
__device__ __forceinline__ void p0_prologue(Frame& F, const Args& A) {
    LAS float* scr = (LAS float*)(F.lds + RING_OFF + F.wave * 16384);
    const int gw = F.vcu * NWAVES + F.wave, NGW = F.G * NWAVES, lane = F.lane;
    const float* c = A.in[1]; const float* ada_w = A.in[2]; const float* w_in = A.in[4]; const float* w_out = A.in[13];
    const float* w_gate = A.in[20]; const float* w_up = A.in[21]; const float* w_down = A.in[22];
    float* modp = (float*)(A.ws + WS_MODP);
    bf16* Win = (bf16*)(A.ws + WS_WIN); bf16* Wout = (bf16*)(A.ws + WS_WOUT); bf16* Wgu = (bf16*)(A.ws + WS_WGU); bf16* Wdn = (bf16*)(A.ws + WS_WDN);
    for (int it = gw; it < P0_NTASK; it += NGW) {
        int r = it;
        if (r < P0_MODT) {
            const int cg = r % 96, ks = r / 96;
            int sv[NB]; float acc[NB];
#pragma unroll
            for (int b = 0; b < NB; ++b) { sv[b] = __builtin_bit_cast(int, silu_f(c[b * D + ks * 64 + lane])); acc[b] = 0.f; }
            const float* wp = ada_w + (size_t)(ks * 64) * 6144 + cg * 64 + lane;
#pragma unroll 16
            for (int k = 0; k < 64; ++k) { const float w = wp[(size_t)k * 6144];
#pragma unroll
                for (int b = 0; b < NB; ++b) acc[b] += __builtin_bit_cast(float, __builtin_amdgcn_readlane(sv[b], k)) * w; }
#pragma unroll
            for (int b = 0; b < NB; ++b) modp[(size_t)(ks * NB + b) * 6144 + cg * 64 + lane] = acc[b];
            continue;
        }
        r -= P0_MODT;
        if (r < P0_IWIN) { const int kb = r / 96, nb = r % 96, n0 = 32 * nb, src0 = n0 + (n0 >= 1536 ? 8 : 0);
            transpose_item(w_in + (size_t)(64 * kb) * DIN + src0, DIN, Win + (size_t)n0 * D + 64 * kb, D, scr, lane); continue; }
        r -= P0_IWIN;
        if (r < P0_IWOUT) { const int kb = r / 32, nb = r % 32;
            transpose_item(w_out + (size_t)(64 * kb) * D + 32 * nb, D, Wout + (size_t)(32 * nb) * D + 64 * kb, D, scr, lane); continue; }
        r -= P0_IWOUT;
        const int e = r / P0_IEXP, q = r % P0_IEXP;
        if (q < 512) {
            const int up = q >> 8, qq = q & 255, kb = qq / 16, nb = qq % 16; const float* W = (up ? w_up : w_gate) + (size_t)e * D * DE;
            transpose_item(W + (size_t)(64 * kb) * DE + 32 * nb, DE, Wgu + ((size_t)e * 1024 + 256 * (nb / 4) + 32 * (nb % 4) + 128 * up) * D + 64 * kb, D, scr, lane);
        } else {
            const int qq = q - 512, kb = qq / 32, nb = qq % 32;
            transpose_item(w_down + (size_t)e * DE * D + (size_t)(64 * kb) * D + 32 * nb, D, Wdn + ((size_t)e * 1024 + 32 * nb) * DE + 64 * kb, DE, scr, lane);
        }
    }
}
constexpr int W16P = 1028;
__device__ __forceinline__ void p1_modulate(Frame& F, const Args& A) {
    const float* x = A.in[0]; const float* ada_b = A.in[3]; const float* w_in = A.in[4];
    const float* modp = (const float*)(A.ws + WS_MODP); float* mod = (float*)(A.ws + WS_MOD); float* dtf = (float*)(A.ws + WS_DTF); bf16* U = (bf16*)(A.ws + WS_A);
    LAS float* sh1 = (LAS float*)(F.lds + RING_OFF); LAS float* sc1 = sh1 + 1024; LAS float* W16 = sc1 + 1024;
    const int tid = F.tid, lane = F.lane;
    for (int idx = F.vcu * 512 + tid; idx < NB * 6144; idx += F.G * 512) { const int b = idx / 6144, j = idx % 6144; float s = ada_b[j];
        for (int ks = 0; ks < 16; ++ks) s += modp[(size_t)(ks * NB + b) * 6144 + j];
        mod[idx] = s; }
    for (int e = tid; e < 16 * 1024; e += 512) { const int k = e >> 4, j = e & 15; W16[j * W16P + k] = w_in[(size_t)k * DIN + (j < 8 ? 1536 + j : 3080 + (j - 8))]; }
    for (int rb = F.vcu; rb < M / 64; rb += F.G) {
    const int row0 = rb * 64, bb = row0 / T;
    __syncthreads();
    for (int j = tid; j < 2048; j += 512) { float s = ada_b[j];
        for (int ks = 0; ks < 16; ++ks) s += modp[(size_t)(ks * NB + bb) * 6144 + j];
        if (j < 1024) sh1[j] = s; else sc1[j - 1024] = 1.f + s; }
    LDS_WAIT(); __syncthreads();
    for (int rp = 0; rp < 4; ++rp) {
        const int r0 = row0 + F.wave * 8 + rp * 2;
        f32x4 u0[4], u1[4];
#pragma unroll
        for (int j = 0; j < 4; ++j) { const int cidx = 4 * lane + 256 * j; const f32x4 s = *(const LAS f32x4*)(sc1 + cidx), h = *(const LAS f32x4*)(sh1 + cidx);
            u0[j] = *(const f32x4*)(x + (size_t)r0 * D + cidx) * s + h; u1[j] = *(const f32x4*)(x + (size_t)(r0 + 1) * D + cidx) * s + h;
            u32x2 p0, p1; p0.x = pk2(u0[j][0], u0[j][1]); p0.y = pk2(u0[j][2], u0[j][3]); p1.x = pk2(u1[j][0], u1[j][1]); p1.y = pk2(u1[j][2], u1[j][3]);
            *(u32x2*)(U + (size_t)r0 * D + cidx) = p0; *(u32x2*)(U + (size_t)(r0 + 1) * D + cidx) = p1; }
        float o0 = 0.f, o1 = 0.f;
#pragma unroll 2
        for (int j16 = 0; j16 < 16; ++j16) { float a0 = 0.f, a1 = 0.f;
#pragma unroll
            for (int j = 0; j < 4; ++j) { const f32x4 w = *(const LAS f32x4*)(W16 + j16 * W16P + 4 * lane + 256 * j);
                a0 += (u0[j][0] * w[0] + u0[j][1] * w[1]) + (u0[j][2] * w[2] + u0[j][3] * w[3]); a1 += (u1[j][0] * w[0] + u1[j][1] * w[1]) + (u1[j][2] * w[2] + u1[j][3] * w[3]); }
            a0 = wave_sum(a0); a1 = wave_sum(a1); if (lane == j16) { o0 = a0; o1 = a1; } }
        if (lane < 16) { dtf[(size_t)r0 * 16 + lane] = o0; dtf[(size_t)(r0 + 1) * 16 + lane] = o1; }
    }
    }
}

__global__ void __launch_bounds__(NWAVES * 64, 2) mk_fwd(Args args) {
    extern __shared__ __attribute__((aligned(16))) unsigned char lds[];
    Frame F;
    F.lds = (LAS unsigned char*)lds; F.MISC = (volatile LAS unsigned*)(F.lds + MISC_OFF);
    F.tid = threadIdx.x; F.lane = F.tid & 63; F.wave = __builtin_amdgcn_readfirstlane(F.tid >> 6);
    F.G = gridDim.x; { const int bx = blockIdx.x; F.vcu = (F.G % 8 == 0) ? (bx % 8) * (F.G / 8) + bx / 8 : bx; }
    F.ctl = (gu32*)(args.ws + WS_CTL);
    for (int u = F.tid; u < (LDS_BYTES - LDSCTL_OFF) / 4; u += NWAVES * 64) ((LAS unsigned*)(F.lds + LDSCTL_OFF))[u] = 0u;
    __syncthreads();
    XcdBarrier bar = xcd_barrier_post((unsigned*)(F.ctl + CW_BAR) + args.li * XCD_BAR_WORDS, F.MISC + 8);
    const int lo = args.ph_lo, hi = args.ph_hi;
#define IN(k) (lo <= (k) && (k) < hi)
#define BOTH(k) (IN(k) && IN((k) + 1))
#define GRID_BAR() xcd_barrier(bar)

    if (IN(0)) { p0_prologue(F, args); if (BOTH(0)) GRID_BAR(); }
    if (IN(1)) { p1_modulate(F, args); __syncthreads(); if (BOTH(1)) GRID_BAR(); }
    if (IN(2)) {
        pg8::Gemm g{(const bf16*)(args.ws + WS_A), (const bf16*)(args.ws + WS_WIN), D};
        pg8::StaticOrder S; S.init(M, PW, D, F.G, (int)blockIdx.x);
        pg8::EpiProj E{(bf16*)(args.ws + WS_B), PW, PC_Q, PC_K, QSCALE};
        pg8::gemm_phase<pg8::EpiProj, pg8::StaticOrder, true>(F.lds + RING_OFF, g, S, E);
        if (BOTH(2)) GRID_BAR();
    }
    if (IN(6)) {
        pg8::Gemm g{(const bf16*)(args.ws + WS_A), (const bf16*)(args.ws + WS_WOUT), D};
        pg8::StaticOrder S; S.init(M, D, D, F.G, (int)blockIdx.x);
        pg8::EpiF32 E{args.out, D};
        pg8::gemm_phase<pg8::EpiF32, pg8::StaticOrder, false>(F.lds + RING_OFF, g, S, E);
        if (BOTH(6)) GRID_BAR();
    }
    if (IN(8) || IN(9)) {
        LAS unsigned* tab = (LAS unsigned*)(F.lds + TAB_OFF); LAS unsigned* cnts = tab + 192;
        if (F.tid < NE) cnts[F.tid] = __hip_atomic_load(F.ctl + CW_CNT + F.tid, RLX_AGENT);
        LDS_WAIT(); __syncthreads();
        if (F.tid == 0) { int nt = 0; for (int e = 0; e < NE; ++e) { const int n = (int)cnts[e]; for (int r0 = 0; r0 < n && nt < 160; r0 += 256) tab[nt++] = (unsigned)e | ((unsigned)r0 << 8); } tab[191] = (unsigned)nt; }
        LDS_WAIT(); __syncthreads();
    }
    if (IN(8)) {
        const LAS unsigned* tab = (const LAS unsigned*)(F.lds + TAB_OFF);
        pg8::Gemm g{(const bf16*)(args.ws + WS_B), (const bf16*)(args.ws + WS_WGU), D};
        pg8::MoeOrder S{tab, tab + 192, (int)tab[191], F.G, (int)blockIdx.x, 0, (const int*)(args.ws + WS_LIST)};
        pg8::EpiMoe1 E{(bf16*)(args.ws + WS_B + 32 * MiB), DE};
        pg8::gemm_phase<pg8::EpiMoe1, pg8::MoeOrder, true>(F.lds + RING_OFF, g, S, E);
        if (BOTH(8)) GRID_BAR();
    }
    if (IN(9)) {
        const LAS unsigned* tab = (const LAS unsigned*)(F.lds + TAB_OFF);
        pg8::Gemm g{(const bf16*)(args.ws + WS_B + 32 * MiB), (const bf16*)(args.ws + WS_WDN), DE};
        pg8::MoeOrder S{tab, tab + 192, (int)tab[191], F.G, (int)blockIdx.x, 1, (const int*)(args.ws + WS_LIST)};
        pg8::EpiMoe2 E{(bf16*)(args.ws + WS_A), (long)(WS_YK1 - WS_A), D, (const int*)(args.ws + WS_LIST)};
        pg8::gemm_phase<pg8::EpiMoe2, pg8::MoeOrder, true>(F.lds + RING_OFF, g, S, E);
        if (BOTH(9)) GRID_BAR();
    }
#undef IN
#undef BOTH
}

static void launch_mk(const Args& base, int lo, int hi, int li, int grid, hipStream_t stream) {
    Args a = base; a.ph_lo = lo; a.ph_hi = hi; a.li = li; a.pad = 0;
    hipLaunchKernelGGL(mk_fwd, dim3(grid), dim3(NWAVES * 64), LDS_BYTES, stream, a);
    const hipError_t le = hipPeekAtLastError();
    if (le != hipSuccess) fprintf(stderr, "kernel_launch: launch [%d,%d) failed: %s\n", lo, hi, hipGetErrorName(le));
}
extern "C" void kernel_launch(void* const* d_in, const int* in_sizes, int n_in, void* d_out, int out_size, void* d_ws, size_t ws_size, hipStream_t stream) {
    static int grid = 0;
    if (grid == 0) {
        if (n_in != 25 || in_sizes[0] != M * D || out_size != M * D || ws_size < WS_END) { fprintf(stderr, "kernel_launch: unexpected shapes / workspace (%zu)\n", ws_size); grid = -1; return; }
        int dev = 0, cus = 0;
        if (hipGetDevice(&dev) != hipSuccess || hipDeviceGetAttribute(&cus, hipDeviceAttributeMultiprocessorCount, dev) != hipSuccess) { grid = -1; return; }
        if (hipFuncSetAttribute((const void*)mk_fwd, hipFuncAttributeMaxDynamicSharedMemorySize, LDS_BYTES) != hipSuccess) { fprintf(stderr, "kernel_launch: hipFuncSetAttribute failed\n"); grid = -1; return; }
        (void)hipGetLastError();
        grid = cus;
    }
    if (grid < 0) return;
    const float* x = (const float*)d_in[0];
    const float* conv_w = (const float*)d_in[5]; const float* conv_b = (const float*)d_in[6]; const float* dt_bias = (const float*)d_in[7];
    const float* a_log = (const float*)d_in[8]; const float* d_skip = (const float*)d_in[9]; const float* ssm_ng = (const float*)d_in[10]; const float* fg_bias = (const float*)d_in[11];
    const float* att_ng = (const float*)d_in[12]; const float* w_out = (const float*)d_in[13]; const float* ln1_g = (const float*)d_in[14]; const float* ln1_b = (const float*)d_in[15];
    const float* rgw = (const float*)d_in[16]; const float* rgb = (const float*)d_in[17]; const float* rew = (const float*)d_in[18]; const float* reb = (const float*)d_in[19];
    const float* w_gate = (const float*)d_in[20]; const float* w_up = (const float*)d_in[21]; const float* w_down = (const float*)d_in[22]; const float* ln2_g = (const float*)d_in[23]; const float* ln2_b = (const float*)d_in[24];
    unsigned char* ws = (unsigned char*)d_ws; float* out = (float*)d_out;
    unsigned* ctl = (unsigned*)(ws + WS_CTL); unsigned* cnt = ctl + CW_CNT;
    float* mod = (float*)(ws + WS_MOD); float* dtf = (float*)(ws + WS_DTF); float* ck = (float*)(ws + WS_CK);
    int* toke = (int*)(ws + WS_TOKE); float* tokw = (float*)(ws + WS_TOKW); int* toks = (int*)(ws + WS_TOKS); int* list = (int*)(ws + WS_LIST);
    bf16* proj = (bf16*)(ws + WS_B); bf16* ycat = (bf16*)(ws + WS_A); bf16* u2 = (bf16*)(ws + WS_B); bf16* hmid = (bf16*)(ws + WS_B + 32 * MiB);
    bf16* yk0 = (bf16*)(ws + WS_A); bf16* yk1 = (bf16*)(ws + WS_YK1); float* ypre = (float*)(ws + WS_YK1); float* xact = out;

    if (hipMemsetAsync(ws + WS_CTL, 0, CTL_ZERO_BYTES, stream) != hipSuccess) return;
    Args a{};
    for (int i = 0; i < 25; ++i) a.in[i] = (const float*)d_in[i];
    a.out = out; a.ws = ws;
    launch_mk(a, 0, 3, 0, grid, stream);
    nv::k_cumf<<<1, 64, 0, stream>>>(dtf, fg_bias, ck);
    nv::k_conv<<<(M * DXBC) / 256, 256, 0, stream>>>(proj, conv_w, conv_b, xact);
    nv::k_ssd<<<NB * NH, 256, 0, stream>>>(xact, dtf, dt_bias, a_log, d_skip, ypre);
    nv::k_ssm_norm<<<M * 2 / 4, 256, 0, stream>>>(ypre, proj, ssm_ng, ycat);
    nv::k_attn<<<NB * NH * 32, 64, 0, stream>>>(proj, ck);
    nv::k_attn_norm<<<M / 4, 256, 0, stream>>>(proj, att_ng, ycat);
    launch_mk(a, 6, 7, 1, grid, stream);
    nv::k_ln1_router<<<M / 4, 256, 0, stream>>>(x, out, mod, ln1_g, ln1_b, rgw, rgb, rew, reb, u2, cnt, list, toke, tokw, toks);
    launch_mk(a, 8, 10, 2, grid, stream);
    nv::k_final<<<M / 4, 256, 0, stream>>>(out, mod, yk0, yk1, tokw, ln2_g, ln2_b);
}
```

```cpp
#include <hip/hip_runtime.h>
#include <cstdio>
#include <cstdint>

constexpr int NB = 8, T = 2048, D = 1024, M = NB * T;
constexpr int DSSM = 512, DATT = 512, HD = 64, NH = 8, NG = 2, NST = 128, DXBC = 1024, DIN = 3088;
constexpr int NE = 32, DE = 512, LCAP = 16384;
constexpr int PW = 3072;
constexpr int PC_Z = 0, PC_XS = 512, PC_Q = 1536, PC_K = 2048, PC_V = 2560;
constexpr float ALPHA = 1.189207115002721f;
constexpr float EPS = 1e-5f;
constexpr float LOG2E = 1.4426950408889634f;
constexpr float QSCALE = 0.125f * LOG2E;
constexpr int MAXSLOT = 160 * 256;

constexpr size_t MiB = 1u << 20;
constexpr size_t WS_CTL = 0, CTL_ZERO_BYTES = 1 * MiB;
constexpr size_t WS_WIN = 1 * MiB, WS_WOUT = 7 * MiB, WS_WGU = 9 * MiB, WS_WDN = 73 * MiB;
constexpr size_t WS_A = 105 * MiB;
constexpr size_t WS_B = 137 * MiB;
constexpr size_t WS_YK1 = 233 * MiB;
constexpr size_t WS_MISC = 265 * MiB;
constexpr size_t WS_MOD = WS_MISC;
constexpr size_t WS_DTF = WS_MISC + 1 * MiB;
constexpr size_t WS_CK = WS_MISC + 2 * MiB;
constexpr size_t WS_TOKE = WS_MISC + 3 * MiB;
constexpr size_t WS_TOKW = WS_TOKE + 256 * 1024;
constexpr size_t WS_TOKS = WS_TOKW + 256 * 1024;
constexpr size_t WS_LIST = WS_MISC + 4 * MiB;
constexpr size_t WS_MODP = WS_YK1;
constexpr size_t WS_END = 272 * MiB;
constexpr int CW_CNT = 1024;

typedef unsigned short bf16;
typedef float f32x4 __attribute__((ext_vector_type(4)));
typedef unsigned u32x4 __attribute__((ext_vector_type(4)));
typedef unsigned u32x2 __attribute__((ext_vector_type(2)));

__device__ __forceinline__ unsigned f2bf(float f) { unsigned u = __builtin_bit_cast(unsigned, f); return (u + 0x7fffu + ((u >> 16) & 1u)) >> 16; }
__device__ __forceinline__ float bf2f(unsigned b) { return __builtin_bit_cast(float, (b & 0xffffu) << 16); }
__device__ __forceinline__ unsigned pk2(float lo, float hi) { return f2bf(lo) | (f2bf(hi) << 16); }
__device__ __forceinline__ float silu_f(float x) { return x / (1.f + expf(-x)); }
__device__ __forceinline__ float softplus_f(float x) { return fmaxf(x, 0.f) + log1pf(expf(-fabsf(x))); }
__device__ __forceinline__ float wave_sum(float v) {
#pragma unroll
    for (int o = 1; o < 64; o <<= 1) v += __shfl_xor(v, o);
    return v;
}

namespace nv {
__global__ void __launch_bounds__(256) k_mod(const float* c, const float* ada_w, const float* ada_b, float* mod) {
    const int j = blockIdx.x * 256 + threadIdx.x;
    __shared__ float sc[NB][D];
    for (int i = threadIdx.x; i < NB * D; i += 256) sc[i / D][i % D] = silu_f(c[i]);
    __syncthreads();
    float acc[NB];
#pragma unroll
    for (int b = 0; b < NB; ++b) acc[b] = 0.f;
    for (int k = 0; k < D; ++k) { const float w = ada_w[(size_t)k * 6144 + j];
#pragma unroll
        for (int b = 0; b < NB; ++b) acc[b] += sc[b][k] * w; }
#pragma unroll
    for (int b = 0; b < NB; ++b) mod[b * 6144 + j] = acc[b] + ada_b[j];
}

template <bool DUAL, class Ctx>
__global__ void __launch_bounds__(256) k_gemm(Ctx cx) {
    __shared__ float As[16][68], Bs[16][68], Bs2[DUAL ? 16 : 1][68];
    __shared__ int s_info[4];
    if (!cx.setup(s_info)) return;
    __syncthreads();
    const int tm = blockIdx.y * 64, tn = blockIdx.x * 64, tid = threadIdx.x, tx = tid & 15, ty = tid >> 4;
    const int K = cx.K();
    float acc[4][4], acc2[4][4];
#pragma unroll
    for (int i = 0; i < 4; ++i)
#pragma unroll
        for (int j = 0; j < 4; ++j) { acc[i][j] = 0.f; acc2[i][j] = 0.f; }
    for (int k0 = 0; k0 < K; k0 += 16) {
#pragma unroll
        for (int i = 0; i < 4; ++i) { const int idx = tid + i * 256, r = idx >> 4, kk = idx & 15; As[kk][r] = cx.a(s_info, tm + r, k0 + kk); }
#pragma unroll
        for (int i = 0; i < 4; ++i) { const int idx = tid + i * 256, kk = idx >> 6, n = idx & 63; Bs[kk][n] = cx.b(s_info, k0 + kk, tn + n); if (DUAL) Bs2[kk][n] = cx.b2(s_info, k0 + kk, tn + n); }
        __syncthreads();
#pragma unroll
        for (int kk = 0; kk < 16; ++kk) {
            float a[4], b[4], b2[4];
#pragma unroll
            for (int i = 0; i < 4; ++i) { a[i] = As[kk][ty * 4 + i]; b[i] = Bs[kk][tx * 4 + i]; b2[i] = DUAL ? Bs2[kk][tx * 4 + i] : 0.f; }
#pragma unroll
            for (int i = 0; i < 4; ++i)
#pragma unroll
                for (int j = 0; j < 4; ++j) { acc[i][j] += a[i] * b[j]; if (DUAL) acc2[i][j] += a[i] * b2[j]; }
        }
        __syncthreads();
    }
#pragma unroll
    for (int i = 0; i < 4; ++i)
#pragma unroll
        for (int j = 0; j < 4; ++j) cx.epi(s_info, tm + ty * 4 + i, tn + tx * 4 + j, acc[i][j], acc2[i][j]);
}

struct CxIn {
    const float* x; const float* mod; const float* w; bf16* proj; float* dtf;
    __device__ bool setup(int*) const { return true; }
    __device__ int K() const { return D; }
    __device__ float a(const int*, int m, int k) const { const int b = m / T; return x[(size_t)m * D + k] * (1.f + mod[b * 6144 + D + k]) + mod[b * 6144 + k]; }
    __device__ float b(const int*, int k, int n) const { return n < DIN ? w[(size_t)k * DIN + n] : 0.f; }
    __device__ float b2(const int*, int, int) const { return 0.f; }
    __device__ void epi(const int*, int m, int n, float v, float) const {
        if (n >= DIN) return;
        if (n < 1536) proj[(size_t)m * PW + n] = (bf16)f2bf(v);
        else if (n < 1544) dtf[m * 16 + (n - 1536)] = v;
        else if (n < 3080) { const int c = n - 8; proj[(size_t)m * PW + c] = (bf16)f2bf(c < PC_K ? v * QSCALE : v); }
        else dtf[m * 16 + 8 + (n - 3080)] = v;
    }
};
struct CxOut {
    const bf16* ycat; const float* w; float* h;
    __device__ bool setup(int*) const { return true; }
    __device__ int K() const { return D; }
    __device__ float a(const int*, int m, int k) const { return bf2f(ycat[(size_t)m * D + k]); }
    __device__ float b(const int*, int k, int n) const { return w[(size_t)k * D + n]; }
    __device__ float b2(const int*, int, int) const { return 0.f; }
    __device__ void epi(const int*, int m, int n, float v, float) const { h[(size_t)m * D + n] = v; }
};
__device__ __forceinline__ bool moe_setup(const unsigned* cnt, int* s_info) {
    const int e = blockIdx.z; const int n = (int)cnt[e];
    if ((int)blockIdx.y * 64 >= n) return false;
    if (threadIdx.x == 0) { int base = 0; for (int i = 0; i < e; ++i) base += ((int)cnt[i] + 255) / 256 * 256; s_info[0] = e; s_info[1] = n; s_info[2] = base; }
    return true;
}
struct CxMoe1 {
    const unsigned* cnt; const int* list; const bf16* u2; const float* wg; const float* wu; bf16* hmid;
    __device__ bool setup(int* s) const { return moe_setup(cnt, s); }
    __device__ int K() const { return D; }
    __device__ float a(const int* s, int m, int k) const { if (m >= s[1]) return 0.f; const int tok = list[s[0] * LCAP + m] >> 1; return bf2f(u2[(size_t)tok * D + k]); }
    __device__ float b(const int* s, int k, int n) const { return wg[((size_t)s[0] * D + k) * DE + n]; }
    __device__ float b2(const int* s, int k, int n) const { return wu[((size_t)s[0] * D + k) * DE + n]; }
    __device__ void epi(const int* s, int m, int n, float g, float u) const { if (m >= s[1]) return; hmid[(size_t)(s[2] + m) * DE + n] = (bf16)f2bf(silu_f(g) * u); }
};
struct CxMoe2 {
    const unsigned* cnt; const int* list; const bf16* hmid; const float* wd; bf16* yk0; bf16* yk1;
    __device__ bool setup(int* s) const { return moe_setup(cnt, s); }
    __device__ int K() const { return DE; }
    __device__ float a(const int* s, int m, int k) const { if (m >= s[1]) return 0.f; return bf2f(hmid[(size_t)(s[2] + m) * DE + k]); }
    __device__ float b(const int* s, int k, int n) const { return wd[((size_t)s[0] * DE + k) * D + n]; }
    __device__ float b2(const int*, int, int) const { return 0.f; }
    __device__ void epi(const int* s, int m, int n, float v, float) const { if (m >= s[1]) return; const int a = list[s[0] * LCAP + m]; bf16* y = (a & 1) ? yk1 : yk0; y[(size_t)(a >> 1) * D + n] = (bf16)f2bf(v); }
};

__global__ void k_cumf(const float* dtf, const float* fg_bias, float* ck) {
    const int bh = blockIdx.x * blockDim.x + threadIdx.x; if (bh >= NB * NH) return;
    const int b = bh / NH, h = bh % NH; const float fb = fg_bias[h]; float s = 0.f;
    for (int t = 0; t < T; ++t) { const float f = dtf[(size_t)(b * T + t) * 16 + 8 + h] + fb; s += -softplus_f(-f); ck[(size_t)bh * T + t] = s; }
}
__global__ void __launch_bounds__(256) k_conv(const bf16* proj, const float* cw, const float* cb, float* xact) {
    const size_t i = (size_t)blockIdx.x * 256 + threadIdx.x; const int m = (int)(i / DXBC), ch = (int)(i % DXBC), t = m % T;
    float acc = cb[ch];
#pragma unroll
    for (int j = 0; j < 4; ++j) { const int tt = t - 3 + j; if (tt >= 0) acc += cw[j * DXBC + ch] * bf2f(proj[(size_t)(m - 3 + j) * PW + PC_XS + ch]); }
    xact[i] = silu_f(acc);
}
__global__ void __launch_bounds__(256) k_ssd(const float* xact, const float* dtf, const float* dt_bias, const float* a_log, const float* d_skip, float* ypre) {
    const int b = blockIdx.x / NH, h = blockIdx.x % NH, g = h / 4, p = threadIdx.x >> 2, nq = threadIdx.x & 3;
    const float A = -expf(a_log[h]), Dh = d_skip[h], dtb = dt_bias[h];
    float st[32];
#pragma unroll
    for (int i = 0; i < 32; ++i) st[i] = 0.f;
    for (int t = 0; t < T; ++t) {
        const size_t m = (size_t)b * T + t;
        const float dtv = softplus_f(dtf[m * 16 + h] + dtb), dA = expf(dtv * A);
        const float xv = xact[m * DXBC + h * 64 + p], xd = xv * dtv;
        const f32x4* Bp = (const f32x4*)(xact + m * DXBC + 512 + g * 128 + nq * 32);
        const f32x4* Cp = (const f32x4*)(xact + m * DXBC + 768 + g * 128 + nq * 32);
        float y = 0.f;
#pragma unroll
        for (int i = 0; i < 8; ++i) { const f32x4 bv = Bp[i], cv = Cp[i];
#pragma unroll
            for (int j = 0; j < 4; ++j) { st[i * 4 + j] = dA * st[i * 4 + j] + xd * bv[j]; y += cv[j] * st[i * 4 + j]; } }
        y += __shfl_xor(y, 1); y += __shfl_xor(y, 2);
        if (nq == 0) ypre[m * DSSM + h * 64 + p] = y + Dh * xv;
    }
}
__global__ void __launch_bounds__(256) k_ssm_norm(const float* ypre, const bf16* proj, const float* ng, bf16* ycat) {
    const int w = (blockIdx.x * 256 + threadIdx.x) >> 6, lane = threadIdx.x & 63, m = w >> 1, g = w & 1;
    float v[4]; float ss = 0.f;
#pragma unroll
    for (int j = 0; j < 4; ++j) { const int c = g * 256 + lane * 4 + j; v[j] = ypre[(size_t)m * DSSM + c] * silu_f(bf2f(proj[(size_t)m * PW + PC_Z + c])); ss += v[j] * v[j]; }
    const float r = 1.f / sqrtf(wave_sum(ss) * (1.f / 256.f) + EPS);
#pragma unroll
    for (int j = 0; j < 4; ++j) { const int c = g * 256 + lane * 4 + j; ycat[(size_t)m * D + c] = (bf16)f2bf(v[j] * r * ng[c]); }
}
__global__ void __launch_bounds__(64) k_attn(bf16* proj, const float* ck) {
    __shared__ float Ks[64][64], Vs[64][64], cks[64];
    const int blk = blockIdx.x, qt = blk % 32, bh = blk / 32, b = bh / NH, h = bh % NH, lane = threadIdx.x;
    const int q = qt * 64 + lane; const size_t mq = (size_t)b * T + q;
    float Q[64], O[64];
#pragma unroll
    for (int d = 0; d < 64; ++d) { Q[d] = bf2f(proj[mq * PW + PC_Q + h * 64 + d]); O[d] = 0.f; }
    const float cq = ck[(size_t)bh * T + q];
    float mrun = -INFINITY, lrun = 0.f;
    for (int kt = 0; kt <= qt; ++kt) {
        __syncthreads();
        for (int i = lane; i < 64 * 64; i += 64) { const int r = i >> 6, d = i & 63; const size_t mk = (size_t)b * T + kt * 64 + r;
            Ks[r][d] = bf2f(proj[mk * PW + PC_K + h * 64 + d]); Vs[r][d] = bf2f(proj[mk * PW + PC_V + h * 64 + d]); }
        cks[lane] = ck[(size_t)bh * T + kt * 64 + lane];
        __syncthreads();
        const int jmax = (kt == qt) ? lane : 63;
        for (int j = 0; j <= jmax; ++j) {
            float s = 0.f;
#pragma unroll
            for (int d = 0; d < 64; ++d) s += Q[d] * Ks[j][d];
            s += (cq - cks[j]) * LOG2E;
            const float mn = fmaxf(mrun, s), al = exp2f(mrun - mn), pj = exp2f(s - mn);
            lrun = lrun * al + pj; mrun = mn;
#pragma unroll
            for (int d = 0; d < 64; ++d) O[d] = O[d] * al + pj * Vs[j][d];
        }
    }
    const float il = 1.f / lrun;
#pragma unroll
    for (int d = 0; d < 64; ++d) proj[mq * PW + PC_Q + h * 64 + d] = (bf16)f2bf(O[d] * il);
}
__global__ void __launch_bounds__(256) k_attn_norm(const bf16* proj, const float* ng, bf16* ycat) {
    const int m = (blockIdx.x * 256 + threadIdx.x) >> 6, lane = threadIdx.x & 63;
    float v[8]; float ss = 0.f;
#pragma unroll
    for (int j = 0; j < 8; ++j) { v[j] = bf2f(proj[(size_t)m * PW + PC_Q + lane * 8 + j]); ss += v[j] * v[j]; }
    const float r = 1.f / sqrtf(wave_sum(ss) * (1.f / 512.f) + EPS);
#pragma unroll
    for (int j = 0; j < 8; ++j) ycat[(size_t)m * D + 512 + lane * 8 + j] = (bf16)f2bf(v[j] * r * ng[lane * 8 + j]);
}
__global__ void __launch_bounds__(256) k_ln1_router(const float* x, float* hx1, const float* mod, const float* g1, const float* b1,
                                                    const float* rgw, const float* rgb, const float* rew, const float* reb,
                                                    bf16* u2, unsigned* cnt, int* list, int* toke, float* tokw, int* toks) {
    const int m = (blockIdx.x * 256 + threadIdx.x) >> 6, lane = threadIdx.x & 63, b = m / T;
    const float* mb = mod + b * 6144;
    float v[16]; float s = 0.f;
#pragma unroll
    for (int j = 0; j < 4; ++j) { const int c = 4 * lane + 256 * j; const f32x4 xv = *(const f32x4*)(x + (size_t)m * D + c), hv = *(const f32x4*)(hx1 + (size_t)m * D + c), gt = *(const f32x4*)(mb + 2 * D + c);
#pragma unroll
        for (int i = 0; i < 4; ++i) { v[j * 4 + i] = ALPHA * xv[i] + (1.f + gt[i]) * hv[i]; s += v[j * 4 + i]; } }
    const float mean = wave_sum(s) * (1.f / D); float s2 = 0.f;
#pragma unroll
    for (int i = 0; i < 16; ++i) { v[i] -= mean; s2 += v[i] * v[i]; }
    const float rstd = 1.f / sqrtf(wave_sum(s2) * (1.f / D) + EPS);
    float acc[36];
#pragma unroll
    for (int i = 0; i < 36; ++i) acc[i] = 0.f;
#pragma unroll
    for (int j = 0; j < 4; ++j) { const int c = 4 * lane + 256 * j; const f32x4 gg = *(const f32x4*)(g1 + c), bb = *(const f32x4*)(b1 + c), sc = *(const f32x4*)(mb + 4 * D + c), sh = *(const f32x4*)(mb + 3 * D + c);
        f32x4 x1, uu;
#pragma unroll
        for (int i = 0; i < 4; ++i) { x1[i] = v[j * 4 + i] * rstd * gg[i] + bb[i]; uu[i] = x1[i] * (1.f + sc[i]) + sh[i]; }
        *(f32x4*)(hx1 + (size_t)m * D + c) = x1;
        u32x2 pk; pk.x = pk2(uu[0], uu[1]); pk.y = pk2(uu[2], uu[3]); *(u32x2*)(u2 + (size_t)m * D + c) = pk;
#pragma unroll
        for (int i = 0; i < 4; ++i) { const int k = c + i; const f32x4 wg = *(const f32x4*)(rgw + (size_t)k * 4);
#pragma unroll
            for (int q = 0; q < 4; ++q) acc[q] += uu[i] * wg[q];
#pragma unroll
            for (int q8 = 0; q8 < 8; ++q8) { const f32x4 we = *(const f32x4*)(rew + (size_t)k * 32 + q8 * 4);
#pragma unroll
                for (int q = 0; q < 4; ++q) acc[4 + q8 * 4 + q] += uu[i] * we[q]; } } }
#pragma unroll
    for (int i = 0; i < 36; ++i) acc[i] = wave_sum(acc[i]);
    float lg[4]; float mx = -INFINITY; int gi = 0;
#pragma unroll
    for (int i = 0; i < 4; ++i) { lg[i] = acc[i] + rgb[i]; if (lg[i] > mx) { mx = lg[i]; gi = i; } }
    float se = 0.f;
#pragma unroll
    for (int i = 0; i < 4; ++i) se += expf(lg[i] - mx);
    const float gp = 1.f / se;
    float le[8]; float mxe = -INFINITY;
#pragma unroll
    for (int i = 0; i < 8; ++i) { float t = 0.f;
#pragma unroll
        for (int gq = 0; gq < 4; ++gq) t = (gi == gq) ? acc[4 + gq * 8 + i] + reb[gq * 8 + i] : t;
        le[i] = t; mxe = fmaxf(mxe, t); }
    float pe[8];
#pragma unroll
    for (int i = 0; i < 8; ++i) pe[i] = expf(le[i] - mxe);
    int i1 = 0; float p1 = -1.f;
#pragma unroll
    for (int i = 0; i < 8; ++i) if (pe[i] > p1) { p1 = pe[i]; i1 = i; }
    int i2 = 0; float p2 = -1.f;
#pragma unroll
    for (int i = 0; i < 8; ++i) if (i != i1 && pe[i] > p2) { p2 = pe[i]; i2 = i; }
    const float inv = 1.f / (p1 + p2);
    if (lane == 0) {
        const int e0 = gi * 8 + i1, e1 = gi * 8 + i2;
        const unsigned q0 = atomicAdd(&cnt[e0], 1u), q1 = atomicAdd(&cnt[e1], 1u);
        list[e0 * LCAP + q0] = m * 2; list[e1 * LCAP + q1] = m * 2 + 1;
        toke[m * 2] = e0; toke[m * 2 + 1] = e1; tokw[m * 2] = gp * p1 * inv; tokw[m * 2 + 1] = gp * p2 * inv; toks[m * 2] = (int)q0; toks[m * 2 + 1] = (int)q1;
    }
}
__global__ void __launch_bounds__(256) k_final(float* out, const float* mod, const bf16* yk0, const bf16* yk1, const float* tokw, const float* g2, const float* b2) {
    const int m = (blockIdx.x * 256 + threadIdx.x) >> 6, lane = threadIdx.x & 63, b = m / T;
    const float* mb = mod + b * 6144; const float w0 = tokw[m * 2], w1 = tokw[m * 2 + 1];
    float v[16]; float s = 0.f;
#pragma unroll
    for (int j = 0; j < 4; ++j) { const int c = 4 * lane + 256 * j; const f32x4 xv = *(const f32x4*)(out + (size_t)m * D + c), gt = *(const f32x4*)(mb + 5 * D + c);
        const u32x2 a = *(const u32x2*)(yk0 + (size_t)m * D + c), bq = *(const u32x2*)(yk1 + (size_t)m * D + c);
        const float y0[4] = {bf2f(a.x), bf2f(a.x >> 16), bf2f(a.y), bf2f(a.y >> 16)}, y1[4] = {bf2f(bq.x), bf2f(bq.x >> 16), bf2f(bq.y), bf2f(bq.y >> 16)};
#pragma unroll
        for (int i = 0; i < 4; ++i) { v[j * 4 + i] = ALPHA * xv[i] + (1.f + gt[i]) * (w0 * y0[i] + w1 * y1[i]); s += v[j * 4 + i]; } }
    const float mean = wave_sum(s) * (1.f / D); float s2 = 0.f;
#pragma unroll
    for (int i = 0; i < 16; ++i) { v[i] -= mean; s2 += v[i] * v[i]; }
    const float rstd = 1.f / sqrtf(wave_sum(s2) * (1.f / D) + EPS);
#pragma unroll
    for (int j = 0; j < 4; ++j) { const int c = 4 * lane + 256 * j; const f32x4 gg = *(const f32x4*)(g2 + c), bb = *(const f32x4*)(b2 + c); f32x4 o;
#pragma unroll
        for (int i = 0; i < 4; ++i) o[i] = v[j * 4 + i] * rstd * gg[i] + bb[i];
        *(f32x4*)(out + (size_t)m * D + c) = o; }
}
}
namespace pg8 {
#define PG8_LAS __attribute__((address_space(3)))
typedef unsigned short bf16_t;
typedef short bf16x8 __attribute__((ext_vector_type(8)));
typedef float f32x4 __attribute__((ext_vector_type(4)));
typedef float f32x2 __attribute__((ext_vector_type(2)));
typedef unsigned u32x4 __attribute__((ext_vector_type(4)));
constexpr int BM = 256, BK = 64, HALF = 128, HTB = HALF * BK * 2  , STAGE_BYTES = 8 * HTB, NXCD = 8, WGM = 8;

__host__ __device__ __forceinline__ int lds_byte(int r, int c) { const int st = (r >> 4) * 2 + (c >> 5), rr = r & 15, cc = c & 31, ob = rr * 64 + cc * 2; return st * 1024 + (ob ^ (((ob >> 9) & 1) << 5)); }
__host__ __device__ __forceinline__ void stage_rc(int b, int& R, int& C) { const int st = b / 1024, sb = b % 1024, swz = sb ^ (((sb >> 9) & 1) << 5); R = (st >> 1) * 16 + swz / 64; C = (st & 1) * 32 + (swz % 64) / 2; }
__host__ __device__ __forceinline__ int perm32(int rho) { const int n = rho >> 4, i = rho & 15; return 8 * (i >> 2) + 4 * n + (i & 3); }

struct Unit { int pm, pn; unsigned boff; int x0, x1, x2; };
struct Gemm { const bf16_t* A; const bf16_t* Bt; int K; };

struct StaticOrder {
    int nM, nN, nwg, G, c, K;
    __device__ void init(int M, int N, int K_, int G_, int c_) { nM = M / BM; nN = N / BM; nwg = nM * nN; G = G_; c = c_; K = K_; }
    __device__ bool next(int i, Unit& u) const {
        const long L = (long)i * G + c; if (L >= nwg) return false;
        int wgid = (int)L; { const int q = nwg / NXCD, r = nwg % NXCD, xcd = wgid % NXCD, off = wgid / NXCD; wgid = (xcd < r ? xcd * (q + 1) : r * (q + 1) + (xcd - r) * q) + off; }
        const int nig = WGM * nN, gid = wgid / nig, fm = gid * WGM, gsz = (nM - fm) < WGM ? (nM - fm) : WGM;
        u.pm = fm + ((wgid % nig) % gsz); u.pn = (wgid % nig) / gsz; u.boff = (unsigned)u.pn * (unsigned)(BM * K * 2); u.x0 = u.x1 = u.x2 = 0; return true;
    }
    __device__ __forceinline__ unsigned arow(const Unit& u, int r) const { return (unsigned)(u.pm * BM + r) * (unsigned)(K * 2); }
};

__device__ __forceinline__ unsigned cvt_pk_bf16(float lo, float hi) { unsigned r; asm volatile("v_cvt_pk_bf16_f32 %0, %1, %2" : "=v"(r) : "v"(lo), "v"(hi)); return r; }

struct EpiProj {
    static constexpr bool PERM = true;
    bf16_t* O; int ldc; int q_lo, q_hi; float qs;
    __device__ __forceinline__ void operator()(const f32x4 (&acc)[2][2][4][2], const Unit& u, int wr, int wc, int fr, int fq) const {
        const int row0 = u.pm * BM + wr * 64 + fr, colt = u.pn * BM; const float sc = (colt >= q_lo && colt < q_hi) ? qs : 1.f;
        const int col0 = colt + wc * 32 + 8 * fq;
#pragma unroll
        for (int ai = 0; ai < 2; ++ai)
#pragma unroll
            for (int m = 0; m < 4; ++m) { bf16_t* rowp = O + (size_t)(row0 + ai * HALF + m * 16) * ldc + col0;
#pragma unroll
                for (int bj = 0; bj < 2; ++bj) { const f32x4 v0 = acc[ai][bj][m][0] * sc, v1 = acc[ai][bj][m][1] * sc;
                    u32x4 w; w.x = cvt_pk_bf16(v0[0], v0[1]); w.y = cvt_pk_bf16(v0[2], v0[3]); w.z = cvt_pk_bf16(v1[0], v1[1]); w.w = cvt_pk_bf16(v1[2], v1[3]);
                    *(u32x4*)(rowp + bj * HALF) = w; } }
    }
};
struct EpiF32 {
    static constexpr bool PERM = false;
    float* O; int ldc;
    __device__ __forceinline__ void operator()(const f32x4 (&acc)[2][2][4][2], const Unit& u, int wr, int wc, int fr, int fq) const {
        const int row0 = u.pm * BM + wr * 64 + fr, col0 = u.pn * BM + wc * 32 + 4 * fq;
#pragma unroll
        for (int ai = 0; ai < 2; ++ai)
#pragma unroll
            for (int m = 0; m < 4; ++m) { float* rowp = O + (size_t)(row0 + ai * HALF + m * 16) * ldc + col0;
#pragma unroll
                for (int bj = 0; bj < 2; ++bj)
#pragma unroll
                    for (int n = 0; n < 2; ++n) *(f32x4*)(rowp + bj * HALF + n * 16) = acc[ai][bj][m][n]; }
    }
};

struct EpiMoe1 {
    static constexpr bool PERM = true;
    bf16_t* H; int ldc;
    __device__ __forceinline__ void operator()(const f32x4 (&acc)[2][2][4][2], const Unit& u, int wr, int wc, int fr, int fq) const {
        const int row0 = u.pm * BM + wr * 64 + fr, col0 = u.pn * HALF + wc * 32 + 8 * fq;
#pragma unroll
        for (int ai = 0; ai < 2; ++ai)
#pragma unroll
            for (int m = 0; m < 4; ++m) { float hv[8];
#pragma unroll
                for (int n = 0; n < 2; ++n)
#pragma unroll
                    for (int j = 0; j < 4; ++j) { const float gt = acc[ai][0][m][n][j], up = acc[ai][1][m][n][j]; hv[n * 4 + j] = gt * __builtin_amdgcn_rcpf(1.f + __expf(-gt)) * up; }
                u32x4 w; w.x = cvt_pk_bf16(hv[0], hv[1]); w.y = cvt_pk_bf16(hv[2], hv[3]); w.z = cvt_pk_bf16(hv[4], hv[5]); w.w = cvt_pk_bf16(hv[6], hv[7]);
                *(u32x4*)(H + (size_t)(row0 + ai * HALF + m * 16) * ldc + col0) = w; }
    }
};
struct EpiMoe2 {
    static constexpr bool PERM = true;
    bf16_t* Y0; long ydelta; int ldc; const int* list;
    __device__ __forceinline__ void operator()(const f32x4 (&acc)[2][2][4][2], const Unit& u, int wr, int wc, int fr, int fq) const {
        const int col0 = u.pn * BM + wc * 32 + 8 * fq; const int* lp = list + u.x0 * LCAP + u.x1;
#pragma unroll
        for (int ai = 0; ai < 2; ++ai)
#pragma unroll
            for (int m = 0; m < 4; ++m) { const int r = ai * HALF + wr * 64 + m * 16 + fr;
                if (r < u.x2) { const int a = lp[r]; bf16_t* rowp = (bf16_t*)((char*)Y0 + (long)(a & 1) * ydelta) + (size_t)(a >> 1) * ldc + col0;
#pragma unroll
                    for (int bj = 0; bj < 2; ++bj) { const f32x4 v0 = acc[ai][bj][m][0], v1 = acc[ai][bj][m][1];
                        u32x4 w; w.x = cvt_pk_bf16(v0[0], v0[1]); w.y = cvt_pk_bf16(v0[2], v0[3]); w.z = cvt_pk_bf16(v1[0], v1[1]); w.w = cvt_pk_bf16(v1[2], v1[3]);
                        *(u32x4*)(rowp + bj * HALF) = w; } } }
    }
};
struct MoeOrder {
    const PG8_LAS unsigned* tab; const PG8_LAS unsigned* cnts; int ntiles, G, c, mode; const int* list;
    __device__ bool next(int i, Unit& u) const {
        const int L = i * G + c; if (L >= ntiles * 4) return false;
        const int tile = L >> 2; const unsigned w = tab[tile]; const int e = (int)(w & 0xffu), row0 = (int)(w >> 8), rem = (int)cnts[e] - row0;
        u.pm = tile; u.pn = L & 3; u.x0 = e; u.x1 = row0; u.x2 = rem < BM ? rem : BM;
        u.boff = mode == 0 ? (unsigned)(e * 1024 + u.pn * BM) * 2048u : (unsigned)(e * 1024 + u.pn * BM) * 1024u; return true;
    }
    __device__ __forceinline__ unsigned arow(const Unit& u, int r) const {
        if (mode == 0) { const int rr = r < u.x2 ? r : 0; return (unsigned)(list[u.x0 * LCAP + u.x1 + rr] >> 1) * 2048u; }
        return (unsigned)(u.pm * BM + r) * 1024u;
    }
};

template <class Epi, class Sched, bool ALIGN_EPI>
__device__ __forceinline__ void gemm_phase(PG8_LAS unsigned char* lds, const Gemm g, const Sched& S, const Epi& E) {
    const int tid = threadIdx.x, wid = __builtin_amdgcn_readfirstlane(tid >> 6), lane = tid & 63, wr = wid >> 2, wc = wid & 3, fr = lane & 15, fq = lane >> 4;
    const int K = g.K, nt = K / BK;
    int Rp[2], Cp[2]; unsigned voffB[2];
#pragma unroll
    for (int i = 0; i < 2; ++i) { int R, C; stage_rc(tid * 16 + i * 8192, R, C); Rp[i] = R; Cp[i] = C; const int Rb = Epi::PERM ? ((R & ~31) + perm32(R & 31)) : R; voffB[i] = (unsigned)(Rb * K + C) * 2u; }
    const size_t kstep = (size_t)(BK * 2);
    const size_t hstep = (size_t)HALF * K * 2;
    const unsigned ldsw = (unsigned)wid * 1024u;
    const int aoff = lds_byte(wr * 64 + fr, fq * 8), boff = lds_byte(wc * 32 + fr, fq * 8);
    const char* gA = (const char*)g.A;
#define PG8_SA(b, h) (((b) * 2 + (h)) * HTB)
#define PG8_SB(b, h) ((4 + (b) * 2 + (h)) * HTB)
#define PG8_STAGE(bufoff, gbase, voff) do { _Pragma("unroll") for (int _i = 0; _i < 2; ++_i) \
        __builtin_amdgcn_global_load_lds((const unsigned*)((const char*)(gbase) + (voff)[_i]), (PG8_LAS unsigned*)(lds + (bufoff) + ldsw + _i * 8192), 16, 0, 0); } while (0)
#define PG8_STAGE_A(bufoff, kb, V, h) do { _Pragma("unroll") for (int _i = 0; _i < 2; ++_i) \
        __builtin_amdgcn_global_load_lds((const unsigned*)(gA + (kb) + (V)[h][_i]), (PG8_LAS unsigned*)(lds + (bufoff) + ldsw + _i * 8192), 16, 0, 0); } while (0)
#define PG8_LDA(dst, b, h) do { _Pragma("unroll") for (int m = 0; m < 4; ++m) _Pragma("unroll") for (int k = 0; k < 2; ++k) dst[m][k] = *(const PG8_LAS bf16x8*)(lds + PG8_SA(b, h) + aoff + m * 2048 + k * 1024); } while (0)
#define PG8_LDB(dst, b, h) do { _Pragma("unroll") for (int n = 0; n < 2; ++n) _Pragma("unroll") for (int k = 0; k < 2; ++k) dst[n][k] = *(const PG8_LAS bf16x8*)(lds + PG8_SB(b, h) + boff + n * 2048 + k * 1024); } while (0)
#define PG8_MMA(ai, bj, At, Bt) do { __builtin_amdgcn_s_setprio(1); _Pragma("unroll") for (int m = 0; m < 4; ++m) _Pragma("unroll") for (int n = 0; n < 2; ++n) _Pragma("unroll") for (int k = 0; k < 2; ++k) \
        acc[ai][bj][m][n] = __builtin_amdgcn_mfma_f32_16x16x32_bf16(Bt[n][k], At[m][k], acc[ai][bj][m][n], 0, 0, 0); __builtin_amdgcn_s_setprio(0); } while (0)
#define PG8_WAIT_V(n) asm volatile("s_waitcnt vmcnt(" #n ")" ::: "memory")
#define PG8_WAIT_L(n) asm volatile("s_waitcnt lgkmcnt(" #n ")" ::: "memory")
#define PG8_BAR __builtin_amdgcn_s_barrier()
#define PG8_SCHED __builtin_amdgcn_sched_barrier(0)
    Unit cur, nxt; int ui = 0;
    if (!S.next(0, cur)) return;
    f32x4 acc[2][2][4][2];
#pragma unroll
    for (int a = 0; a < 2; ++a)
#pragma unroll
        for (int b = 0; b < 2; ++b)
#pragma unroll
            for (int m = 0; m < 4; ++m)
#pragma unroll
                for (int n = 0; n < 2; ++n) acc[a][b][m][n] = (f32x4){0.f, 0.f, 0.f, 0.f};
    bf16x8 At[4][2], B0[2][2], B1[2][2];
    unsigned vc[2][2], vn[2][2];
#pragma unroll
    for (int h = 0; h < 2; ++h)
#pragma unroll
        for (int i = 0; i < 2; ++i) vc[h][i] = S.arow(cur, h * HALF + Rp[i]) + (unsigned)(Cp[i] * 2);
    const char* cB = (const char*)g.Bt + cur.boff;
    PG8_STAGE(PG8_SB(0, 0), cB, voffB); PG8_STAGE(PG8_SB(0, 1), cB + hstep, voffB); PG8_STAGE_A(PG8_SA(0, 0), 0, vc, 0); PG8_STAGE_A(PG8_SA(0, 1), 0, vc, 1);
    if (wr == 1) PG8_BAR;
    PG8_WAIT_V(2); PG8_BAR;
    PG8_STAGE(PG8_SB(1, 0), cB + kstep, voffB); PG8_STAGE_A(PG8_SA(1, 0), kstep, vc, 0); PG8_STAGE(PG8_SB(1, 1), cB + hstep + kstep, voffB);
    PG8_WAIT_V(6); PG8_BAR;
    for (;;) {
        const bool has_next = S.next(ui + 1, nxt);
        const char* nB = has_next ? (const char*)g.Bt + nxt.boff : cB;
#pragma unroll
        for (int h = 0; h < 2; ++h)
#pragma unroll
            for (int i = 0; i < 2; ++i) vn[h][i] = has_next ? S.arow(nxt, h * HALF + Rp[i]) + (unsigned)(Cp[i] * 2) : vc[h][i];
        for (int t = 0; t < nt; t += 2) {
            const bool last = (t == nt - 2);
            const size_t k1 = (size_t)(t + 1) * kstep;
            const size_t k2 = last ? 0 : (size_t)(t + 2) * kstep, k3 = k2 + kstep;
            const char* b2 = last ? nB : cB + (size_t)(t + 2) * kstep; const char* b3 = b2 + kstep;
            unsigned v2[2][2];
#pragma unroll
            for (int h = 0; h < 2; ++h)
#pragma unroll
                for (int i = 0; i < 2; ++i) v2[h][i] = last ? vn[h][i] : vc[h][i];
            PG8_LDB(B0, 0, 0); PG8_LDB(B1, 0, 1); PG8_SCHED; PG8_LDA(At, 0, 0); PG8_STAGE_A(PG8_SA(1, 1), k1, vc, 1);
            PG8_WAIT_V(8); PG8_WAIT_L(0); PG8_BAR; PG8_MMA(0, 0, At, B0); PG8_MMA(0, 1, At, B1); PG8_BAR; PG8_SCHED;
            PG8_LDA(At, 0, 1); PG8_STAGE(PG8_SB(0, 0), b2, voffB); PG8_STAGE(PG8_SB(0, 1), b2 + hstep, voffB); PG8_STAGE_A(PG8_SA(0, 0), k2, v2, 0);
            PG8_WAIT_V(8); PG8_WAIT_L(0); PG8_BAR; PG8_MMA(1, 0, At, B0); PG8_MMA(1, 1, At, B1); PG8_BAR; PG8_SCHED;
            PG8_LDB(B0, 1, 0); PG8_LDB(B1, 1, 1); PG8_SCHED; PG8_LDA(At, 1, 0); PG8_STAGE_A(PG8_SA(0, 1), k2, v2, 1);
            PG8_WAIT_V(8); PG8_WAIT_L(0); PG8_BAR; PG8_MMA(0, 0, At, B0); PG8_MMA(0, 1, At, B1); PG8_BAR; PG8_SCHED;
            PG8_LDA(At, 1, 1); PG8_STAGE(PG8_SB(1, 0), b3, voffB); PG8_STAGE(PG8_SB(1, 1), b3 + hstep, voffB); PG8_STAGE_A(PG8_SA(1, 0), k3, v2, 0);
            PG8_WAIT_V(8); PG8_WAIT_L(0); PG8_BAR; PG8_MMA(1, 0, At, B0); PG8_MMA(1, 1, At, B1); PG8_BAR; PG8_SCHED;
        }
        if constexpr (ALIGN_EPI) { if (wr == 0) PG8_BAR; }
        E(acc, cur, wr, wc, fr, fq);
        if (!has_next) break;
#pragma unroll
        for (int a = 0; a < 2; ++a)
#pragma unroll
            for (int b = 0; b < 2; ++b)
#pragma unroll
                for (int m = 0; m < 4; ++m)
#pragma unroll
                    for (int n = 0; n < 2; ++n) acc[a][b][m][n] = (f32x4){0.f, 0.f, 0.f, 0.f};
        cur = nxt; cB = nB; ++ui;
#pragma unroll
        for (int h = 0; h < 2; ++h)
#pragma unroll
            for (int i = 0; i < 2; ++i) vc[h][i] = vn[h][i];
        if constexpr (ALIGN_EPI) { if (wr == 1) PG8_BAR; }
    }
    PG8_WAIT_V(0);
    if constexpr (!ALIGN_EPI) { if (wr == 0) PG8_BAR; }
    PG8_BAR;
#undef PG8_SA
#undef PG8_SB
#undef PG8_STAGE
#undef PG8_STAGE_A
#undef PG8_LDA
#undef PG8_LDB
#undef PG8_MMA
#undef PG8_WAIT_V
#undef PG8_WAIT_L
#undef PG8_BAR
#undef PG8_SCHED
}
}
#include <hip/hip_bf16.h>
#include <cmath>
namespace attn_body {
using bf16=__hip_bfloat16;
using bf16x8=__attribute__((ext_vector_type(8)))short;
using s16x4=__attribute__((ext_vector_type(4)))short;
using f32x16=__attribute__((ext_vector_type(16)))float;
using u32x4=__attribute__((ext_vector_type(4)))unsigned;
constexpr int BATCH=8,NHEAD=8,SEQ=2048,D=64,DM=3072;
constexpr int NW=8,QBLK=32,QB=QBLK*NW,KVBLK=64,NQB=SEQ/QB;
constexpr int ATTN_PITCH=DM, ATTN_UNIT_ROWS=QB;
__device__ __forceinline__ int crow(int r,int hi){return (r&3)+8*(r>>2)+4*hi;}
#define SBAR() __builtin_amdgcn_sched_barrier(0)
__device__ __forceinline__ void cmask(f32x16&p0,f32x16&p1,int jb,int qrel,int hi){
  const float NEG=-INFINITY; int kb=64*jb+4*hi;
  #pragma unroll
  for(int r=0;r<16;++r){int kv=kb+(r&3)+8*(r>>2); if(kv>qrel)p0[r]=NEG; if(kv+32>qrel)p1[r]=NEG;}
}

constexpr int NSLOT=3, SLOTB=8192;
constexpr int LDS_K=0, LDS_V=NSLOT*SLOTB, LDS_WS=2*NSLOT*SLOTB, LDS_OST=LDS_WS+NW*64*4, LDS_CKF=LDS_OST+NW*4096, LDS_CKP=LDS_CKF+SEQ*4, LDS_BYTES=LDS_CKP+SEQ*4;
constexpr float C2=0.125f*1.4426950408889634f;
__device__ __forceinline__ void glds16(const void*gsrc,unsigned lds_dst){unsigned keep;
  asm volatile("s_mov_b32 %0, m0\n\ts_mov_b32 m0, %2\n\ts_nop 0\n\tglobal_load_lds_dwordx4 %1, off\n\ts_mov_b32 m0, %0":"=&s"(keep):"v"(gsrc),"s"(lds_dst):"memory");}
__device__ __forceinline__ float max3f(float a,float b,float c){float r;asm("v_max3_f32 %0, %1, %2, %3":"=v"(r):"v"(a),"v"(b),"v"(c));return r;}
__device__ __forceinline__ float max2f(float a,float b){float r;asm("v_max_f32_e32 %0, %1, %2":"=v"(r):"v"(a),"v"(b));return r;}
__device__ __forceinline__ float fadd_s(float a,float b){float r;asm("v_add_f32_e32 %0, %1, %2":"=v"(r):"v"(a),"v"(b));return r;}
__device__ __forceinline__ float fsub_s(float a,float b){float r;asm("v_sub_f32_e32 %0, %1, %2":"=v"(r):"v"(a),"v"(b));return r;}
typedef float f32x2_t __attribute__((ext_vector_type(2))); typedef __bf16 bf16x2_t __attribute__((ext_vector_type(2)));
__device__ __forceinline__ unsigned cvtpk_s(float lo,float hi){f32x2_t v={lo,hi};bf16x2_t b=__builtin_convertvector(v,bf16x2_t);return __builtin_bit_cast(unsigned,b);}
#define WAIT_BAR(N) asm volatile("s_waitcnt vmcnt(" #N ") lgkmcnt(0)\n\ts_barrier":::"memory")

__device__ __forceinline__ unsigned f2bf_rne(float f){unsigned u=__float_as_uint(f);return (u+0x7fffu+((u>>16)&1u))>>16;}
__device__ __forceinline__ void qkt(f32x16&p0,f32x16&p1,const char*Kslot,const bf16x8*qr,int r32,int hi,bf16x8 kx0,bf16x8 kx1,bf16x8 qx){
  const char*kb=Kslot+hi*1024+r32*16;
  #pragma unroll
  for(int d0=0;d0<4;++d0){
    const bf16x8 b0=*reinterpret_cast<const bf16x8*>(kb+d0*2048);
    const bf16x8 b1=*reinterpret_cast<const bf16x8*>(kb+d0*2048+512);
    if(d0==0){p0=__builtin_amdgcn_mfma_f32_32x32x16_bf16(b0,qr[0],f32x16{},0,0,0);p1=__builtin_amdgcn_mfma_f32_32x32x16_bf16(b1,qr[0],f32x16{},0,0,0);}
    else{p0=__builtin_amdgcn_mfma_f32_32x32x16_bf16(b0,qr[d0],p0,0,0,0);p1=__builtin_amdgcn_mfma_f32_32x32x16_bf16(b1,qr[d0],p1,0,0,0);}}
  p0=__builtin_amdgcn_mfma_f32_32x32x16_bf16(kx0,qx,p0,0,0,0);p1=__builtin_amdgcn_mfma_f32_32x32x16_bf16(kx1,qx,p1,0,0,0);
}
typedef __attribute__((address_space(3))) const char* lds_cptr;
typedef short v4i16_t __attribute__((ext_vector_type(4)));
__device__ __forceinline__ void kload8(bf16x8*kf,lds_cptr kp){
  kf[0]=*(const __attribute__((address_space(3))) bf16x8*)(kp);      kf[1]=*(const __attribute__((address_space(3))) bf16x8*)(kp+512);
  kf[2]=*(const __attribute__((address_space(3))) bf16x8*)(kp+2048); kf[3]=*(const __attribute__((address_space(3))) bf16x8*)(kp+2560);
  kf[4]=*(const __attribute__((address_space(3))) bf16x8*)(kp+4096); kf[5]=*(const __attribute__((address_space(3))) bf16x8*)(kp+4608);
  kf[6]=*(const __attribute__((address_space(3))) bf16x8*)(kp+6144); kf[7]=*(const __attribute__((address_space(3))) bf16x8*)(kp+6656);
}
__device__ __forceinline__ void kload2(bf16x8*kf,lds_cptr kp,int j){ kf[2*j]=*(const __attribute__((address_space(3))) bf16x8*)(kp+j*2048); kf[2*j+1]=*(const __attribute__((address_space(3))) bf16x8*)(kp+j*2048+512); }
__device__ __forceinline__ s16x4 vtr(lds_cptr p){ return __builtin_bit_cast(s16x4,__builtin_amdgcn_ds_read_tr16_b64_v4i16((__attribute__((address_space(3))) v4i16_t*)p)); }
__device__ __forceinline__ float rowmax(const f32x16&p0,const f32x16&p1){
  float a=max3f(p0[0],p0[1],p1[0]),b=max3f(p0[2],p0[3],p1[1]);a=max3f(a,p1[2],p1[3]);
  #pragma unroll
  for(int r=4;r<16;r+=4){a=max3f(a,p0[r],p0[r+1]);b=max3f(b,p0[r+2],p0[r+3]);a=max3f(a,p1[r],p1[r+1]);b=max3f(b,p1[r+2],p1[r+3]);}
  const float m=max2f(a,b);
  auto rr=__builtin_amdgcn_permlane32_swap(__float_as_uint(m),__float_as_uint(m),false,false);
  return max2f(__uint_as_float(rr[0]),__uint_as_float(rr[1]));
}
__device__ __forceinline__ void pv(f32x16*o,int vb,bf16x8 pa0,bf16x8 pa1,bf16x8 pa2,bf16x8 pa3){
  #pragma unroll
  for(int d0=0;d0<2;++d0){s16x4 lo[4],hi[4];
    #pragma unroll
    for(int ks=0;ks<4;++ks){
      asm volatile("ds_read_b64_tr_b16 %0,%1 offset:%c2":"=&v"(lo[ks]):"v"(vb),"i"(d0*4096+ks*1024):"memory");
      asm volatile("ds_read_b64_tr_b16 %0,%1 offset:%c2":"=&v"(hi[ks]):"v"(vb),"i"(d0*4096+ks*1024+512):"memory");}
    asm volatile("s_waitcnt lgkmcnt(0)":::"memory");SBAR();
    #define PK(k) (bf16x8){lo[k][0],lo[k][1],lo[k][2],lo[k][3],hi[k][0],hi[k][1],hi[k][2],hi[k][3]}
    o[d0]=__builtin_amdgcn_mfma_f32_32x32x16_bf16(pa0,PK(0),o[d0],0,0,0);
    o[d0]=__builtin_amdgcn_mfma_f32_32x32x16_bf16(pa1,PK(1),o[d0],0,0,0);
    o[d0]=__builtin_amdgcn_mfma_f32_32x32x16_bf16(pa2,PK(2),o[d0],0,0,0);
    o[d0]=__builtin_amdgcn_mfma_f32_32x32x16_bf16(pa3,PK(3),o[d0],0,0,0);
    #undef PK
  }
}

#ifndef ATTN_STORE16
#define ATTN_STORE16(p,v) (*(u32x4*)(p)=(v))
#endif
template<int THRL> __device__ __forceinline__ void attn_unit(int b,int h,int qb,const bf16*Q,const bf16*__restrict__ K,const bf16*__restrict__ V,bf16*O,char*shm){
  const int tid=threadIdx.x,lane=tid&63,r32=lane&31,hi=lane>>5; const int wid=__builtin_amdgcn_readfirstlane(tid>>6);
  const long rowbase=(long)b*SEQ; const int q0=qb*QB;
  { const __attribute__((address_space(3))) float* ckf=(const __attribute__((address_space(3))) float*)((__attribute__((address_space(3))) char*)shm+LDS_CKF); __attribute__((address_space(3))) unsigned* ckpw=(__attribute__((address_space(3))) unsigned*)((__attribute__((address_space(3))) char*)shm+LDS_CKP);
    const float c0=ckf[q0];
    for(int k=tid;k<q0+QB;k+=NW*64){ const float x=(ckf[k]-c0)*1.4426950408889634f; const unsigned hb=f2bf_rne(x); const float xh=__uint_as_float(hb<<16); ckpw[k]=hb|(f2bf_rne(x-xh)<<16); }
    asm volatile("s_waitcnt lgkmcnt(0)\n\ts_barrier":::"memory"); }
  const __attribute__((address_space(3))) unsigned* ckp=(const __attribute__((address_space(3))) unsigned*)((__attribute__((address_space(3))) char*)shm+LDS_CKP);
  const bf16*Qw=Q+(rowbase+q0+wid*QBLK)*DM+h*D;
  const bf16*Kh=K+rowbase*DM+h*D,*Vh=V+rowbase*DM+h*D;
  const unsigned lds0=(unsigned)(uintptr_t)shm;
  float*wsf=(float*)(shm+LDS_WS)+wid*64;
  const bf16*ksrc=Kh+(long)lane*DM+wid*8;
  const bf16*vsrc=Vh+(long)(16*(wid&3)+(lane>>2))*DM+(wid>>2)*32+(lane&3)*8;
  const unsigned kdst=lds0+LDS_K+wid*1024, vdst=lds0+LDS_V+wid*1024;
  #define DMA_K(t,slot) glds16(ksrc+(long)(t)*KVBLK*DM,(unsigned)__builtin_amdgcn_readfirstlane(kdst+(slot)))
  #define DMA_V(t,slot) glds16(vsrc+(long)(t)*KVBLK*DM,(unsigned)__builtin_amdgcn_readfirstlane(vdst+(slot)))
  const int vb0=(int)(lds0+LDS_V)+((lane>>4)&1)*32+(lane&3)*8+(4*hi+((lane&15)>>2))*64;
  const char*Kbase=shm+LDS_K; bf16x8 kf[8];
  const lds_cptr shm3=(lds_cptr)shm; const lds_cptr kp0=shm3+LDS_K+hi*1024+r32*16; const lds_cptr vp0=shm3+LDS_V+((lane>>4)&1)*32+(lane&3)*8+(4*hi+((lane&15)>>2))*64;
  const int NT=(q0+QB)/KVBLK;
  DMA_K(0,0);DMA_V(0,0);DMA_K(1,SLOTB);
  bf16x8 qr[4];
  #pragma unroll
  for(int d0=0;d0<4;++d0)qr[d0]=*reinterpret_cast<const bf16x8*>(&Qw[(long)r32*DM+d0*16+hi*8]);
  const unsigned cqw=hi?0u:ckp[q0+wid*QBLK+r32]; bf16x8 qx=__builtin_bit_cast(bf16x8,(u32x4){hi?0u:0xbf80bf80u,cqw,0u,0u});
  #define SETQX() do{ const unsigned hb_=f2bf_rne(mhat); const unsigned mw_=hb_|(f2bf_rne(mhat-__uint_as_float(hb_<<16))<<16); qx=__builtin_bit_cast(bf16x8,(u32x4){hi?0u:0xbf80bf80u,cqw,hi?0u:mw_,0u}); }while(0)
  #define KXW(w) __builtin_bit_cast(bf16x8,(u32x4){(w),0x3f803f80u,0xbf80bf80u,0u})
  #define KX(key) __builtin_bit_cast(bf16x8,(u32x4){ckp[(key)+r32],0x3f803f80u,0xbf80bf80u,0u})
  float mhat=0.f,l_reg=0.f;f32x16 o[2];o[0]=f32x16{};o[1]=f32x16{};
  const int qrel=wid*QBLK+r32;
  #define CMASK(P0,P1,t) do{int jb_=(t)-(NT-4); if(jb_>=0)cmask(P0,P1,jb_,qrel,hi);}while(0)
  bool resc=false;
  #define START(P0,P1) do{ const float rm=rowmax(P0,P1); resc=false; \
    { const float dl=__builtin_ceilf(rm); mhat=fadd_s(mhat,dl); \
      _Pragma("unroll") for(int r=0;r<16;++r){P0[r]=fsub_s(P0[r],dl);P1[r]=fsub_s(P1[r],dl);} \
      SETQX(); } \
    _Pragma("unroll") for(int r=0;r<16;++r)P0[r]=__builtin_amdgcn_exp2f(P0[r]); }while(0)
  #define RESC() do{ if(resc){ asm volatile("s_waitcnt lgkmcnt(0)":::"memory"); \
      _Pragma("unroll") for(int d_=0;d_<2;++d_) _Pragma("unroll") for(int r=0;r<16;++r)o[d_][r]*=wsf[crow(r,hi)]; } }while(0)
  f32x16 pA0,pA1,pB0,pB1;
  int sl_prev=0,sl_cur=0,sl_next=SLOTB;
  #define ROT() do{sl_prev=sl_cur;sl_cur=sl_next;sl_next=(sl_next==(NSLOT-1)*SLOTB)?0:sl_next+SLOTB;}while(0)
  DMA_K(2,2*SLOTB);
  WAIT_BAR(3);
  qkt(pA0,pA1,Kbase,qr,r32,hi,KX(0),KX(32),qx);asm volatile("s_nop 15\n\ts_nop 7":"+v"(pA0),"+v"(pA1));CMASK(pA0,pA1,0);
  START(pA0,pA1);
  _Pragma("unroll") for(int r=0;r<16;++r)pA1[r]=__builtin_amdgcn_exp2f(pA1[r]);
  WAIT_BAR(0);
  DMA_K(3,0);DMA_V(1,SLOTB);
  ROT();
  kload8(kf,kp0+sl_cur);
  unsigned kw0=ckp[KVBLK+r32], kw1=ckp[KVBLK+32+r32];
  WAIT_BAR(2);
  s16x4 vlo[8],vhi[8]; u32x4 pw0,pw1,pw2,pw3;
  #define PKW(P,B) cvtpk_s(P[B],P[B+1])
  #define PAF(k) __builtin_bit_cast(bf16x8,pw##k)
  #define VFR(i) (bf16x8){vlo[i][0],vlo[i][1],vlo[i][2],vlo[i][3],vhi[i][0],vhi[i][1],vhi[i][2],vhi[i][3]}
  #define PIN(x) asm volatile("":"+v"(x))
  #define MX3(a,b,c) __builtin_fmaxf(__builtin_fmaxf((a),(b)),(c))
  #define GAPA(MF,A0,A1,A2,A3,W0,W1,PW) do{ MF; sacc+=A0; sacc+=A1; sacc+=A2; sacc+=A3; PIN(sacc); W0; W1; PIN(PW); SBAR(); }while(0)
  #define EX(v) __builtin_amdgcn_exp2f(v)
  #define GAPB(MF,X,B) do{ MF; X[B]=EX(X[B]); X[B+1]=EX(X[B+1]); X[B+2]=EX(X[B+2]); X[B+3]=EX(X[B+3]); PIN(X); SBAR(); }while(0)
  #define VRD(i) do{ vlo[i]=vtr(vp_+(((i)>>2)*4096+((i)&3)*1024)); vhi[i]=vtr(vp_+(((i)>>2)*4096+((i)&3)*1024+512)); }while(0)
  #define KRD(G,j) do{ if(G){ kload2(kf,kp0+sl_next,j); SBAR(); } }while(0)
  #define STEP(C0,C1,P0,P1,t,GK,GV,GL) do{ SBAR(); \
    C0=__builtin_amdgcn_mfma_f32_32x32x16_bf16(KXW(kw0),qx,f32x16{},0,0,0); C1=__builtin_amdgcn_mfma_f32_32x32x16_bf16(KXW(kw1),qx,f32x16{},0,0,0); SBAR(); \
    const lds_cptr vp_=vp0+sl_prev; \
    VRD(0); SBAR(); float sacc=(P0[0]+P0[1]); \
    GAPA(C0=__builtin_amdgcn_mfma_f32_32x32x16_bf16(kf[0],qr[0],C0,0,0,0), P0[2],P0[3],P0[4],P0[5],     pw0[0]=PKW(P0,0), pw0[1]=PKW(P0,2), pw0); \
    VRD(4); SBAR(); GAPA(C1=__builtin_amdgcn_mfma_f32_32x32x16_bf16(kf[1],qr[0],C1,0,0,0), P0[6],P0[7],P0[8],P0[9],     pw0[2]=PKW(P0,4), pw0[3]=PKW(P0,6), pw0); \
    VRD(1); SBAR(); GAPA(C0=__builtin_amdgcn_mfma_f32_32x32x16_bf16(kf[2],qr[1],C0,0,0,0),   P0[10],P0[11],P0[12],P0[13], pw1[0]=PKW(P0,8), pw1[1]=PKW(P0,10), pw1); \
    VRD(5); SBAR(); GAPA(C1=__builtin_amdgcn_mfma_f32_32x32x16_bf16(kf[3],qr[1],C1,0,0,0),   P0[14],P0[15],P1[0],P1[1],   pw1[2]=PKW(P0,12),pw1[3]=PKW(P0,14), pw1); \
    VRD(2); SBAR(); GAPA(C0=__builtin_amdgcn_mfma_f32_32x32x16_bf16(kf[4],qr[2],C0,0,0,0),   P1[2],P1[3],P1[4],P1[5],     pw2[0]=PKW(P1,0), pw2[1]=PKW(P1,2), pw2); \
    VRD(6); SBAR(); GAPA(C1=__builtin_amdgcn_mfma_f32_32x32x16_bf16(kf[5],qr[2],C1,0,0,0),   P1[6],P1[7],P1[8],P1[9],     pw2[2]=PKW(P1,4), pw2[3]=PKW(P1,6), pw2); \
    VRD(3); SBAR(); GAPA(C0=__builtin_amdgcn_mfma_f32_32x32x16_bf16(kf[6],qr[3],C0,0,0,0),   P1[10],P1[11],P1[12],P1[13], pw3[0]=PKW(P1,8), pw3[1]=PKW(P1,10), pw3); \
    VRD(7); SBAR(); GAPA(C1=__builtin_amdgcn_mfma_f32_32x32x16_bf16(kf[7],qr[3],C1,0,0,0),   P1[14],P1[15],0.f,0.f,       pw3[2]=PKW(P1,12),pw3[3]=PKW(P1,14), pw3); \
    l_reg+=sacc; \
    if(GK){DMA_K((t)+3,sl_cur);} if(GV){DMA_V((t)+1,sl_next);} \
    CMASK(C0,C1,t); \
    { float a=MX3(C0[0],C0[1],C1[0]),b=MX3(C0[2],C0[3],C1[1]); a=MX3(a,C1[2],C1[3]); \
      _Pragma("unroll") for(int r=4;r<16;r+=4){a=MX3(a,C0[r],C0[r+1]);b=MX3(b,C0[r+2],C0[r+3]);a=MX3(a,C1[r],C1[r+1]);b=MX3(b,C1[r+2],C1[r+3]);} \
      float rm=__builtin_fmaxf(a,b); { auto rr=__builtin_amdgcn_permlane32_swap(__float_as_uint(rm),__float_as_uint(rm),false,false); rm=__builtin_fmaxf(__uint_as_float(rr[0]),__uint_as_float(rr[1])); } \
      resc=false; \
      if(__builtin_expect(__any(rm>(float)THRL),0)){ const float dl=__builtin_ceilf(__builtin_fmaxf(rm,0.f)); mhat+=dl; \
        _Pragma("unroll") for(int r=0;r<16;++r){C0[r]-=dl;C1[r]-=dl;} \
        SETQX(); \
        const float f=__builtin_amdgcn_exp2f(-dl); l_reg*=f; if(hi==0)wsf[r32]=f; resc=true; } } \
    SBAR(); \
    GAPB(o[0]=__builtin_amdgcn_mfma_f32_32x32x16_bf16(PAF(0),VFR(0),o[0],0,0,0), C0,0); \
    GAPB(o[1]=__builtin_amdgcn_mfma_f32_32x32x16_bf16(PAF(0),VFR(4),o[1],0,0,0), C0,4); \
    KRD(GL,0); GAPB(o[0]=__builtin_amdgcn_mfma_f32_32x32x16_bf16(PAF(1),VFR(1),o[0],0,0,0), C0,8); \
    KRD(GL,1); GAPB(o[1]=__builtin_amdgcn_mfma_f32_32x32x16_bf16(PAF(1),VFR(5),o[1],0,0,0), C0,12); \
    KRD(GL,2); GAPB(o[0]=__builtin_amdgcn_mfma_f32_32x32x16_bf16(PAF(2),VFR(2),o[0],0,0,0), C1,0); \
    KRD(GL,3); GAPB(o[1]=__builtin_amdgcn_mfma_f32_32x32x16_bf16(PAF(2),VFR(6),o[1],0,0,0), C1,4); \
    if(GL){ kw0=ckp[((t)+1)*KVBLK+r32]; kw1=ckp[((t)+1)*KVBLK+32+r32]; SBAR(); } \
    GAPB(o[0]=__builtin_amdgcn_mfma_f32_32x32x16_bf16(PAF(3),VFR(3),o[0],0,0,0), C1,8); \
    GAPB(o[1]=__builtin_amdgcn_mfma_f32_32x32x16_bf16(PAF(3),VFR(7),o[1],0,0,0), C1,12); \
    }while(0)
  int t=1;
  #undef CMASK
  #define CMASK(P0,P1,t) do{}while(0)
  for(;t+5<NT;t+=2){
    STEP(pB0,pB1,pA0,pA1,t,true,true,true);     WAIT_BAR(2); RESC(); ROT();
    STEP(pA0,pA1,pB0,pB1,t+1,true,true,true);   WAIT_BAR(2); RESC(); ROT();
  }
  #undef CMASK
  #define CMASK(P0,P1,t) do{int jb_=(t)-(NT-4); if(jb_>=0)cmask(P0,P1,jb_,qrel,hi);}while(0)
  #define ENDW(tt) do{ if((tt)+3<NT){WAIT_BAR(2);} else if((tt)+2<NT){WAIT_BAR(1);} else {WAIT_BAR(0);} }while(0)
  for(;t+1<NT;t+=2){
    STEP(pB0,pB1,pA0,pA1,t,(t+3<NT),(t+1<NT),(t+1<NT));       ENDW(t);   RESC(); ROT();
    STEP(pA0,pA1,pB0,pB1,t+1,(t+4<NT),(t+2<NT),(t+2<NT));     ENDW(t+1); RESC(); ROT();
  }
  STEP(pB0,pB1,pA0,pA1,NT-1,false,false,false); RESC();
  { float sacc=pB0[0]+pB0[1]; _Pragma("unroll") for(int r=2;r<16;++r)sacc+=pB0[r]; _Pragma("unroll") for(int r=0;r<16;++r)sacc+=pB1[r]; l_reg+=sacc;
    pw0=(u32x4){PKW(pB0,0),PKW(pB0,2),PKW(pB0,4),PKW(pB0,6)};pw1=(u32x4){PKW(pB0,8),PKW(pB0,10),PKW(pB0,12),PKW(pB0,14)};pw2=(u32x4){PKW(pB1,0),PKW(pB1,2),PKW(pB1,4),PKW(pB1,6)};pw3=(u32x4){PKW(pB1,8),PKW(pB1,10),PKW(pB1,12),PKW(pB1,14)};
    SBAR(); pv(o,vb0+sl_cur,PAF(0),PAF(1),PAF(2),PAF(3)); }
  #undef PKW
  #undef PAF
  #undef VFR
  #undef PIN
  #undef MX3
  #undef GAPA
  #undef GAPB
  #undef EX
  #undef VRD
  #undef KRD
  #undef STEP
  #undef ENDW
  {auto rr=__builtin_amdgcn_permlane32_swap(__float_as_uint(l_reg),__float_as_uint(l_reg),false,false);l_reg=__uint_as_float(rr[0])+__uint_as_float(rr[1]);}
  if(hi==0)wsf[32+r32]=l_reg;asm volatile("s_waitcnt lgkmcnt(0)":::"memory");
  float rli[16];
  #pragma unroll
  for(int r=0;r<16;++r)rli[r]=__builtin_amdgcn_rcpf(wsf[32+crow(r,hi)]);
  bf16*Ow=O+(rowbase+q0+wid*QBLK)*DM+h*D;
  { bf16*stg=(bf16*)(shm+LDS_OST)+wid*2048;
    #pragma unroll
    for(int r=0;r<16;++r){const int orow=crow(r,hi);
      #pragma unroll
      for(int d0=0;d0<2;++d0)stg[orow*64+d0*32+r32]=__float2bfloat16(o[d0][r]*rli[r]);}
    asm volatile("s_waitcnt lgkmcnt(0)":::"memory");
    #pragma unroll
    for(int i=0;i<4;++i){const int row=i*8+(lane>>3),ch=lane&7; const u32x4 v=*(const u32x4*)(stg+row*64+ch*8); ATTN_STORE16(Ow+(long)row*DM+ch*8,v);} }
  asm volatile("s_waitcnt lgkmcnt(0)\n\ts_barrier":::"memory");
  #undef KX
  #undef KXW
  #undef SETQX
  #undef DMA_K
  #undef DMA_V
  #undef CMASK
  #undef START
  #undef RESC
  #undef ROT
}
constexpr int ATTN_LDS_BYTES=LDS_BYTES;
struct AttnTensors { const bf16* Q; const bf16* K; const bf16* V; bf16* O; };
struct AttnUnit { int bh; int qb; };
#undef SBAR
#undef WAIT_BAR
}
constexpr int NWAVES = 8;
constexpr int RING_OFF = 0, RING_BYTES = 131072;
constexpr int LDSCTL_OFF = RING_BYTES, MISC_OFF = LDSCTL_OFF + 320;
constexpr int LDS_BYTES = 147456;
static_assert(MISC_OFF + 128 <= LDS_BYTES, "LDS map");
constexpr int TAB_OFF = MISC_OFF + 128;
static_assert(TAB_OFF + 224 * 4 <= LDS_BYTES, "LDS map");
constexpr int CW_TMO = 0, CW_CODE = 1, CW_BAR = 4096, MAX_BAR_REGIONS = 8;

#define GAS __attribute__((address_space(1)))
#define LAS __attribute__((address_space(3)))
typedef short bf16x8 __attribute__((ext_vector_type(8)));
typedef GAS unsigned gu32;
#define RLX_AGENT __ATOMIC_RELAXED, __HIP_MEMORY_SCOPE_AGENT
#define LDS_WAIT() asm volatile("s_waitcnt lgkmcnt(0)" ::: "memory")
#define VM_WAIT() asm volatile("s_waitcnt vmcnt(0)" ::: "memory")

#define XB_TMO      128
#define XB_XCNT(j)  (256  + 64 * (j))
#define XB_XSUB(j)  (1280 + 64 * (j))
#define XB_XGEN(j)  (2304 + 64 * (j))
#define XB_TOP      3328
#define XB_TOPGEN   3392
#define XCD_BAR_WORDS 3456
#define XB_SPIN_CAP (1u << 18)

__device__ __forceinline__ unsigned xb_ld(unsigned* p)              { return __hip_atomic_load(p, __ATOMIC_RELAXED, __HIP_MEMORY_SCOPE_AGENT); }
__device__ __forceinline__ unsigned xb_add(unsigned* p, unsigned v) { return __hip_atomic_fetch_add(p, v, __ATOMIC_RELAXED, __HIP_MEMORY_SCOPE_AGENT); }
__device__ __forceinline__ unsigned xb_xcc_id() { return (unsigned)__builtin_amdgcn_s_getreg((3 << 11) | 20) & 0xFu; }
#define XB_SPIN(cond, bar) do { unsigned _sp = 0; while (cond) { __builtin_amdgcn_s_sleep(1); \
    if ((++_sp & 255u) == 0u) { if (xb_ld(&(bar)[XB_TMO])) break; if (_sp > XB_SPIN_CAP) { atomicAdd(&(bar)[XB_TMO], 1u); break; } } } } while (0)

struct XcdBarrier {
    unsigned* bar; unsigned x;
    volatile LAS unsigned* st;
};

__device__ __forceinline__ XcdBarrier xcd_barrier_post(unsigned* bar, volatile LAS unsigned* st) {
    XcdBarrier b; b.bar = bar; b.x = xb_xcc_id(); b.st = st;
    if (threadIdx.x == 0) (void)xb_add(&bar[XB_XCNT(b.x)], 1u);
    return b;
}
__device__ __forceinline__ void xcd_barrier_complete(unsigned* bar, unsigned x, unsigned& nloc, unsigned& nx) {
    const unsigned G = gridDim.x * gridDim.y * gridDim.z;
    unsigned sum, cnt, mine, sp = 0u;
    for (;;) {
        sum = 0u; cnt = 0u; mine = 0u;
#pragma unroll
        for (unsigned j = 0; j < 16; ++j) { const unsigned c = xb_ld(&bar[XB_XCNT(j)]); sum += c; cnt += (c > 0u) ? 1u : 0u; mine = (j == x) ? c : mine; }
        if (sum == G) break;
        __builtin_amdgcn_s_sleep(1);
        if ((++sp & 255u) == 0u) { if (xb_ld(&bar[XB_TMO])) break; if (sp > XB_SPIN_CAP) { atomicAdd(&bar[XB_TMO], 1u); break; } }
    }
    nloc = mine > 0u ? mine : 1u; nx = cnt > 0u ? cnt : 1u;
}

__device__ __forceinline__ void xcd_barrier(const XcdBarrier& b) {
    asm volatile("s_waitcnt vmcnt(0)" ::: "memory");
    __syncthreads();
    if (threadIdx.x == 0) {
        unsigned* bar = b.bar;
        __builtin_amdgcn_s_waitcnt(0);
        unsigned nloc = b.st[0], nx = b.st[1];
        if (nloc == 0u) { xcd_barrier_complete(bar, b.x, nloc, nx); b.st[0] = nloc; b.st[1] = nx; }
        const unsigned old = xb_add(&bar[XB_XSUB(b.x)], 1u);
        const unsigned gen = old / nloc;
        if (old + 1u == (gen + 1u) * nloc) {
            __builtin_amdgcn_fence(__ATOMIC_RELEASE, "agent");
            asm volatile("s_waitcnt vmcnt(0)" ::: "memory");
            const unsigned og = xb_add(&bar[XB_TOP], 1u);
            const unsigned tg = og / nx;
            if (og + 1u == (tg + 1u) * nx) xb_add(&bar[XB_TOPGEN], 1u);
            else XB_SPIN(xb_ld(&bar[XB_TOPGEN]) == tg, bar);
            __builtin_amdgcn_fence(__ATOMIC_ACQUIRE, "agent");
            xb_add(&bar[XB_XGEN(b.x)], 1u);
            asm volatile("s_waitcnt vmcnt(0)" ::: "memory");
        } else {
            XB_SPIN(xb_ld(&bar[XB_XGEN(b.x)]) == gen, bar);
            __builtin_amdgcn_fence(__ATOMIC_ACQUIRE, "agent");
            asm volatile("s_waitcnt vmcnt(0)" ::: "memory");
        }
    }
    __syncthreads();
}


struct Args {
    const float* in[25]; float* out; unsigned char* ws; int ph_lo, ph_hi, li, pad;
};
struct Frame {
    LAS unsigned char* lds; volatile LAS unsigned* MISC; gu32* ctl;
    int tid, lane, wave, vcu, G;
};

__device__ __forceinline__ void transpose_item(const float* Wsrc, int ld, bf16* dst, int Kd, LAS float* scr, int lane) {
#pragma unroll 8
    for (int i = 0; i < 32; ++i) { const int kk = 2 * i + (lane >> 5); scr[kk * 33 + (lane & 31)] = Wsrc[(size_t)kk * ld + (lane & 31)]; }
    LDS_WAIT(); asm volatile("" ::: "memory");
    const int c = lane & 7;
#pragma unroll
    for (int j = 0; j < 4; ++j) { const int n = (lane >> 3) + 8 * j; const LAS float* s = scr + (8 * c) * 33 + n;
        u32x4 o; o.x = pk2(s[0 * 33], s[1 * 33]); o.y = pk2(s[2 * 33], s[3 * 33]); o.z = pk2(s[4 * 33], s[5 * 33]); o.w = pk2(s[6 * 33], s[7 * 33]);
        *(GAS u32x4*)(dst + (size_t)n * Kd + 8 * c) = o; }
    LDS_WAIT(); asm volatile("" ::: "memory");
}
constexpr int P0_MODT = 96 * 16;
constexpr int P0_IWIN = 16 * 96, P0_IWOUT = 16 * 32, P0_IEXP = 768;
constexpr int P0_NTASK = P0_MODT + P0_IWIN + P0_IWOUT + NE * P0_IEXP;
__device__ __forceinline__ void p0_prologue(Frame& F, const Args& A) {
    LAS float* scr = (LAS float*)(F.lds + RING_OFF + F.wave * 16384);
    const int gw = F.vcu * NWAVES + F.wave, NGW = F.G * NWAVES, lane = F.lane;
    const float* c = A.in[1]; const float* ada_w = A.in[2]; const float* w_in = A.in[4]; const float* w_out = A.in[13];
    const float* w_gate = A.in[20]; const float* w_up = A.in[21]; const float* w_down = A.in[22];
    float* modp = (float*)(A.ws + WS_MODP);
    bf16* Win = (bf16*)(A.ws + WS_WIN); bf16* Wout = (bf16*)(A.ws + WS_WOUT); bf16* Wgu = (bf16*)(A.ws + WS_WGU); bf16* Wdn = (bf16*)(A.ws + WS_WDN);
    for (int it = gw; it < P0_NTASK; it += NGW) {
        int r = it;
        if (r < P0_MODT) {
            const int cg = r % 96, ks = r / 96;
            int sv[NB]; float acc[NB];
#pragma unroll
            for (int b = 0; b < NB; ++b) { sv[b] = __builtin_bit_cast(int, silu_f(c[b * D + ks * 64 + lane])); acc[b] = 0.f; }
            const float* wp = ada_w + (size_t)(ks * 64) * 6144 + cg * 64 + lane;
#pragma unroll 16
            for (int k = 0; k < 64; ++k) { const float w = wp[(size_t)k * 6144];
#pragma unroll
                for (int b = 0; b < NB; ++b) acc[b] += __builtin_bit_cast(float, __builtin_amdgcn_readlane(sv[b], k)) * w; }
#pragma unroll
            for (int b = 0; b < NB; ++b) modp[(size_t)(ks * NB + b) * 6144 + cg * 64 + lane] = acc[b];
            continue;
        }
        r -= P0_MODT;
        if (r < P0_IWIN) { const int kb = r / 96, nb = r % 96, n0 = 32 * nb, src0 = n0 + (n0 >= 1536 ? 8 : 0);
            transpose_item(w_in + (size_t)(64 * kb) * DIN + src0, DIN, Win + (size_t)n0 * D + 64 * kb, D, scr, lane); continue; }
        r -= P0_IWIN;
        if (r < P0_IWOUT) { const int kb = r / 32, nb = r % 32;
            transpose_item(w_out + (size_t)(64 * kb) * D + 32 * nb, D, Wout + (size_t)(32 * nb) * D + 64 * kb, D, scr, lane); continue; }
        r -= P0_IWOUT;
        const int e = r / P0_IEXP, q = r % P0_IEXP;
        if (q < 512) {
            const int up = q >> 8, qq = q & 255, kb = qq / 16, nb = qq % 16; const float* W = (up ? w_up : w_gate) + (size_t)e * D * DE;
            transpose_item(W + (size_t)(64 * kb) * DE + 32 * nb, DE, Wgu + ((size_t)e * 1024 + 256 * (nb / 4) + 32 * (nb % 4) + 128 * up) * D + 64 * kb, D, scr, lane);
        } else {
            const int qq = q - 512, kb = qq / 32, nb = qq % 32;
            transpose_item(w_down + (size_t)e * DE * D + (size_t)(64 * kb) * D + 32 * nb, D, Wdn + ((size_t)e * 1024 + 32 * nb) * DE + 64 * kb, DE, scr, lane);
        }
    }
}
constexpr int W16P = 1028;
__device__ __forceinline__ void p1_modulate(Frame& F, const Args& A) {
    const float* x = A.in[0]; const float* ada_b = A.in[3]; const float* w_in = A.in[4];
    const float* modp = (const float*)(A.ws + WS_MODP); float* mod = (float*)(A.ws + WS_MOD); float* dtf = (float*)(A.ws + WS_DTF); bf16* U = (bf16*)(A.ws + WS_A);
    LAS float* sh1 = (LAS float*)(F.lds + RING_OFF); LAS float* sc1 = sh1 + 1024; LAS float* W16 = sc1 + 1024;
    const int tid = F.tid, lane = F.lane;
    for (int idx = F.vcu * 512 + tid; idx < NB * 6144; idx += F.G * 512) { const int b = idx / 6144, j = idx % 6144; float s = ada_b[j];
        for (int ks = 0; ks < 16; ++ks) s += modp[(size_t)(ks * NB + b) * 6144 + j];
        mod[idx] = s; }
    for (int e = tid; e < 16 * 1024; e += 512) { const int k = e >> 4, j = e & 15; W16[j * W16P + k] = w_in[(size_t)k * DIN + (j < 8 ? 1536 + j : 3080 + (j - 8))]; }
    for (int rb = F.vcu; rb < M / 64; rb += F.G) {
    const int row0 = rb * 64, bb = row0 / T;
    __syncthreads();
    for (int j = tid; j < 2048; j += 512) { float s = ada_b[j];
        for (int ks = 0; ks < 16; ++ks) s += modp[(size_t)(ks * NB + bb) * 6144 + j];
        if (j < 1024) sh1[j] = s; else sc1[j - 1024] = 1.f + s; }
    LDS_WAIT(); __syncthreads();
    for (int rp = 0; rp < 4; ++rp) {
        const int r0 = row0 + F.wave * 8 + rp * 2;
        f32x4 u0[4], u1[4];
#pragma unroll
        for (int j = 0; j < 4; ++j) { const int cidx = 4 * lane + 256 * j; const f32x4 s = *(const LAS f32x4*)(sc1 + cidx), h = *(const LAS f32x4*)(sh1 + cidx);
            u0[j] = *(const f32x4*)(x + (size_t)r0 * D + cidx) * s + h; u1[j] = *(const f32x4*)(x + (size_t)(r0 + 1) * D + cidx) * s + h;
            u32x2 p0, p1; p0.x = pk2(u0[j][0], u0[j][1]); p0.y = pk2(u0[j][2], u0[j][3]); p1.x = pk2(u1[j][0], u1[j][1]); p1.y = pk2(u1[j][2], u1[j][3]);
            *(u32x2*)(U + (size_t)r0 * D + cidx) = p0; *(u32x2*)(U + (size_t)(r0 + 1) * D + cidx) = p1; }
        float o0 = 0.f, o1 = 0.f;
#pragma unroll 2
        for (int j16 = 0; j16 < 16; ++j16) { float a0 = 0.f, a1 = 0.f;
#pragma unroll
            for (int j = 0; j < 4; ++j) { const f32x4 w = *(const LAS f32x4*)(W16 + j16 * W16P + 4 * lane + 256 * j);
                a0 += (u0[j][0] * w[0] + u0[j][1] * w[1]) + (u0[j][2] * w[2] + u0[j][3] * w[3]); a1 += (u1[j][0] * w[0] + u1[j][1] * w[1]) + (u1[j][2] * w[2] + u1[j][3] * w[3]); }
            a0 = wave_sum(a0); a1 = wave_sum(a1); if (lane == j16) { o0 = a0; o1 = a1; } }
        if (lane < 16) { dtf[(size_t)r0 * 16 + lane] = o0; dtf[(size_t)(r0 + 1) * 16 + lane] = o1; }
    }
    }
}

__global__ void __launch_bounds__(NWAVES * 64, 2) mk_fwd(Args args) {
    extern __shared__ __attribute__((aligned(16))) unsigned char lds[];
    Frame F;
    F.lds = (LAS unsigned char*)lds; F.MISC = (volatile LAS unsigned*)(F.lds + MISC_OFF);
    F.tid = threadIdx.x; F.lane = F.tid & 63; F.wave = __builtin_amdgcn_readfirstlane(F.tid >> 6);
    F.G = gridDim.x; { const int bx = blockIdx.x; F.vcu = (F.G % 8 == 0) ? (bx % 8) * (F.G / 8) + bx / 8 : bx; }
    F.ctl = (gu32*)(args.ws + WS_CTL);
    for (int u = F.tid; u < (LDS_BYTES - LDSCTL_OFF) / 4; u += NWAVES * 64) ((LAS unsigned*)(F.lds + LDSCTL_OFF))[u] = 0u;
    __syncthreads();
    XcdBarrier bar = xcd_barrier_post((unsigned*)(F.ctl + CW_BAR) + args.li * XCD_BAR_WORDS, F.MISC + 8);
    const int lo = args.ph_lo, hi = args.ph_hi;
#define IN(k) (lo <= (k) && (k) < hi)
#define BOTH(k) (IN(k) && IN((k) + 1))
#define GRID_BAR() xcd_barrier(bar)

    if (IN(0)) { p0_prologue(F, args); if (BOTH(0)) GRID_BAR(); }
    if (IN(1)) { p1_modulate(F, args); __syncthreads(); if (BOTH(1)) GRID_BAR(); }
    if (IN(2)) {
        pg8::Gemm g{(const bf16*)(args.ws + WS_A), (const bf16*)(args.ws + WS_WIN), D};
        pg8::StaticOrder S; S.init(M, PW, D, F.G, (int)blockIdx.x);
        pg8::EpiProj E{(bf16*)(args.ws + WS_B), PW, PC_Q, PC_K, QSCALE};
        pg8::gemm_phase<pg8::EpiProj, pg8::StaticOrder, true>(F.lds + RING_OFF, g, S, E);
        if (BOTH(2)) GRID_BAR();
    }
    if (IN(3)) {
        using namespace attn_body;
        char* shm = (char*)lds + RING_OFF;
        const float* dtf = (const float*)(args.ws + WS_DTF); const float* fg_bias = args.in[11];
        const attn_body::bf16* P = (const attn_body::bf16*)(args.ws + WS_B);
        LAS float* ckf = (LAS float*)(F.lds + RING_OFF + LDS_CKF); LAS float* wsum = (LAS float*)(F.lds + RING_OFF + LDS_WS);
        if (F.vcu < NB * NH * 4) {
            const int p = F.vcu; const int bh = p >> 2, s = p & 3, b = bh / NH, h = bh % NH;
            {
                const float fb = fg_bias[h]; float v[4]; float run = 0.f;
#pragma unroll
                for (int i = 0; i < 4; ++i) { const float f = dtf[(size_t)(b * T + F.tid * 4 + i) * 16 + 8 + h] + fb; run += -softplus_f(-f); v[i] = run; }
                float incl = run; int ln = F.lane; asm volatile("" : "+v"(ln));
#pragma unroll
                for (int o = 1; o < 64; o <<= 1) { const float t = __builtin_bit_cast(float, __builtin_amdgcn_ds_bpermute((ln - o) << 2, __builtin_bit_cast(int, incl))); if (ln >= o) incl += t; }
                if (ln == 63) wsum[F.wave] = incl;
                LDS_WAIT(); __syncthreads();
                float off = incl - run;
                for (int w = 0; w < F.wave; ++w) off += wsum[w];
#pragma unroll
                for (int i = 0; i < 4; ++i) ckf[F.tid * 4 + i] = v[i] + off;
                LDS_WAIT(); __syncthreads();
            }
            for (int j = 0; j < 2; ++j) attn_unit<8>(b, h, j ? s : 7 - s, P + PC_Q, P + PC_K, P + PC_V, (attn_body::bf16*)(args.ws + WS_B) + PC_Q, shm);
        }
        __syncthreads();
        if (BOTH(3)) GRID_BAR();
    }
    if (IN(6)) {
        pg8::Gemm g{(const bf16*)(args.ws + WS_A), (const bf16*)(args.ws + WS_WOUT), D};
        pg8::StaticOrder S; S.init(M, D, D, F.G, (int)blockIdx.x);
        pg8::EpiF32 E{args.out, D};
        pg8::gemm_phase<pg8::EpiF32, pg8::StaticOrder, false>(F.lds + RING_OFF, g, S, E);
        if (BOTH(6)) GRID_BAR();
    }
    if (IN(8) || IN(9)) {
        LAS unsigned* tab = (LAS unsigned*)(F.lds + TAB_OFF); LAS unsigned* cnts = tab + 192;
        if (F.tid < NE) cnts[F.tid] = __hip_atomic_load(F.ctl + CW_CNT + F.tid, RLX_AGENT);
        LDS_WAIT(); __syncthreads();
        if (F.tid == 0) { int nt = 0; for (int e = 0; e < NE; ++e) { const int n = (int)cnts[e]; for (int r0 = 0; r0 < n && nt < 160; r0 += 256) tab[nt++] = (unsigned)e | ((unsigned)r0 << 8); } tab[191] = (unsigned)nt; }
        LDS_WAIT(); __syncthreads();
    }
    if (IN(8)) {
        const LAS unsigned* tab = (const LAS unsigned*)(F.lds + TAB_OFF);
        pg8::Gemm g{(const bf16*)(args.ws + WS_B), (const bf16*)(args.ws + WS_WGU), D};
        pg8::MoeOrder S{tab, tab + 192, (int)tab[191], F.G, (int)blockIdx.x, 0, (const int*)(args.ws + WS_LIST)};
        pg8::EpiMoe1 E{(bf16*)(args.ws + WS_B + 32 * MiB), DE};
        pg8::gemm_phase<pg8::EpiMoe1, pg8::MoeOrder, true>(F.lds + RING_OFF, g, S, E);
        if (BOTH(8)) GRID_BAR();
    }
    if (IN(9)) {
        const LAS unsigned* tab = (const LAS unsigned*)(F.lds + TAB_OFF);
        pg8::Gemm g{(const bf16*)(args.ws + WS_B + 32 * MiB), (const bf16*)(args.ws + WS_WDN), DE};
        pg8::MoeOrder S{tab, tab + 192, (int)tab[191], F.G, (int)blockIdx.x, 1, (const int*)(args.ws + WS_LIST)};
        pg8::EpiMoe2 E{(bf16*)(args.ws + WS_A), (long)(WS_YK1 - WS_A), D, (const int*)(args.ws + WS_LIST)};
        pg8::gemm_phase<pg8::EpiMoe2, pg8::MoeOrder, true>(F.lds + RING_OFF, g, S, E);
        if (BOTH(9)) GRID_BAR();
    }
#undef IN
#undef BOTH
}

static void launch_mk(const Args& base, int lo, int hi, int li, int grid, hipStream_t stream) {
    Args a = base; a.ph_lo = lo; a.ph_hi = hi; a.li = li; a.pad = 0;
    hipLaunchKernelGGL(mk_fwd, dim3(grid), dim3(NWAVES * 64), LDS_BYTES, stream, a);
    const hipError_t le = hipPeekAtLastError();
    if (le != hipSuccess) fprintf(stderr, "kernel_launch: launch [%d,%d) failed: %s\n", lo, hi, hipGetErrorName(le));
}
extern "C" void kernel_launch(void* const* d_in, const int* in_sizes, int n_in, void* d_out, int out_size, void* d_ws, size_t ws_size, hipStream_t stream) {
    static int grid = 0;
    if (grid == 0) {
        if (n_in != 25 || in_sizes[0] != M * D || out_size != M * D || ws_size < WS_END) { fprintf(stderr, "kernel_launch: unexpected shapes / workspace (%zu)\n", ws_size); grid = -1; return; }
        int dev = 0, cus = 0;
        if (hipGetDevice(&dev) != hipSuccess || hipDeviceGetAttribute(&cus, hipDeviceAttributeMultiprocessorCount, dev) != hipSuccess) { grid = -1; return; }
        if (hipFuncSetAttribute((const void*)mk_fwd, hipFuncAttributeMaxDynamicSharedMemorySize, LDS_BYTES) != hipSuccess) { fprintf(stderr, "kernel_launch: hipFuncSetAttribute failed\n"); grid = -1; return; }
        (void)hipGetLastError();
        grid = cus;
    }
    if (grid < 0) return;
    const float* x = (const float*)d_in[0];
    const float* conv_w = (const float*)d_in[5]; const float* conv_b = (const float*)d_in[6]; const float* dt_bias = (const float*)d_in[7];
    const float* a_log = (const float*)d_in[8]; const float* d_skip = (const float*)d_in[9]; const float* ssm_ng = (const float*)d_in[10]; const float* fg_bias = (const float*)d_in[11];
    const float* att_ng = (const float*)d_in[12]; const float* w_out = (const float*)d_in[13]; const float* ln1_g = (const float*)d_in[14]; const float* ln1_b = (const float*)d_in[15];
    const float* rgw = (const float*)d_in[16]; const float* rgb = (const float*)d_in[17]; const float* rew = (const float*)d_in[18]; const float* reb = (const float*)d_in[19];
    const float* w_gate = (const float*)d_in[20]; const float* w_up = (const float*)d_in[21]; const float* w_down = (const float*)d_in[22]; const float* ln2_g = (const float*)d_in[23]; const float* ln2_b = (const float*)d_in[24];
    unsigned char* ws = (unsigned char*)d_ws; float* out = (float*)d_out;
    unsigned* ctl = (unsigned*)(ws + WS_CTL); unsigned* cnt = ctl + CW_CNT;
    float* mod = (float*)(ws + WS_MOD); float* dtf = (float*)(ws + WS_DTF); float* ck = (float*)(ws + WS_CK);
    int* toke = (int*)(ws + WS_TOKE); float* tokw = (float*)(ws + WS_TOKW); int* toks = (int*)(ws + WS_TOKS); int* list = (int*)(ws + WS_LIST);
    bf16* proj = (bf16*)(ws + WS_B); bf16* ycat = (bf16*)(ws + WS_A); bf16* u2 = (bf16*)(ws + WS_B); bf16* hmid = (bf16*)(ws + WS_B + 32 * MiB);
    bf16* yk0 = (bf16*)(ws + WS_A); bf16* yk1 = (bf16*)(ws + WS_YK1); float* ypre = (float*)(ws + WS_YK1); float* xact = out;

    if (hipMemsetAsync(ws + WS_CTL, 0, CTL_ZERO_BYTES, stream) != hipSuccess) return;
    Args a{};
    for (int i = 0; i < 25; ++i) a.in[i] = (const float*)d_in[i];
    a.out = out; a.ws = ws;
    launch_mk(a, 0, 3, 0, grid, stream);
    nv::k_conv<<<(M * DXBC) / 256, 256, 0, stream>>>(proj, conv_w, conv_b, xact);
    nv::k_ssd<<<NB * NH, 256, 0, stream>>>(xact, dtf, dt_bias, a_log, d_skip, ypre);
    nv::k_ssm_norm<<<M * 2 / 4, 256, 0, stream>>>(ypre, proj, ssm_ng, ycat);
    launch_mk(a, 3, 4, 3, grid, stream);
    nv::k_attn_norm<<<M / 4, 256, 0, stream>>>(proj, att_ng, ycat);
    launch_mk(a, 6, 7, 1, grid, stream);
    nv::k_ln1_router<<<M / 4, 256, 0, stream>>>(x, out, mod, ln1_g, ln1_b, rgw, rgb, rew, reb, u2, cnt, list, toke, tokw, toks);
    launch_mk(a, 8, 10, 2, grid, stream);
    nv::k_final<<<M / 4, 256, 0, stream>>>(out, mod, yk0, yk1, tokw, ln2_g, ln2_b);
}
```

```cpp
#include <hip/hip_runtime.h>
#include <cstdio>
#include <cstdint>

constexpr int NB = 8, T = 2048, D = 1024, M = NB * T;
constexpr int DSSM = 512, DATT = 512, HD = 64, NH = 8, NG = 2, NST = 128, DXBC = 1024, DIN = 3088;
constexpr int NE = 32, DE = 512, LCAP = 16384;
constexpr int PW = 3072;
constexpr int PC_Z = 0, PC_XS = 512, PC_Q = 1536, PC_K = 2048, PC_V = 2560;
constexpr float ALPHA = 1.189207115002721f;
constexpr float EPS = 1e-5f;
constexpr float LOG2E = 1.4426950408889634f;
constexpr float QSCALE = 0.125f * LOG2E;
constexpr int MAXSLOT = 160 * 256;

constexpr size_t MiB = 1u << 20;
constexpr size_t WS_CTL = 0, CTL_ZERO_BYTES = 1 * MiB;
constexpr size_t WS_WIN = 1 * MiB, WS_WOUT = 7 * MiB, WS_WGU = 9 * MiB, WS_WDN = 73 * MiB;
constexpr size_t WS_A = 105 * MiB;
constexpr size_t WS_B = 137 * MiB;
constexpr size_t WS_YK1 = 233 * MiB;
constexpr size_t WS_MISC = 265 * MiB;
constexpr size_t WS_MOD = WS_MISC;
constexpr size_t WS_DTF = WS_MISC + 1 * MiB;
constexpr size_t WS_CK = WS_MISC + 2 * MiB;
constexpr size_t WS_TOKE = WS_MISC + 3 * MiB;
constexpr size_t WS_TOKW = WS_TOKE + 256 * 1024;
constexpr size_t WS_TOKS = WS_TOKW + 256 * 1024;
constexpr size_t WS_LIST = WS_MISC + 4 * MiB;
constexpr size_t WS_MODP = WS_YK1;
constexpr size_t WS_END = 272 * MiB;
constexpr int CW_CNT = 1024;

typedef unsigned short bf16;
typedef float f32x4 __attribute__((ext_vector_type(4)));
typedef unsigned u32x4 __attribute__((ext_vector_type(4)));
typedef unsigned u32x2 __attribute__((ext_vector_type(2)));

__device__ __forceinline__ unsigned f2bf(float f) { unsigned u = __builtin_bit_cast(unsigned, f); return (u + 0x7fffu + ((u >> 16) & 1u)) >> 16; }
__device__ __forceinline__ float bf2f(unsigned b) { return __builtin_bit_cast(float, (b & 0xffffu) << 16); }
__device__ __forceinline__ unsigned pk2(float lo, float hi) { return f2bf(lo) | (f2bf(hi) << 16); }
__device__ __forceinline__ float silu_f(float x) { return x / (1.f + expf(-x)); }
__device__ __forceinline__ float softplus_f(float x) { return fmaxf(x, 0.f) + log1pf(expf(-fabsf(x))); }
__device__ __forceinline__ float wave_sum(float v) {
#pragma unroll
    for (int o = 1; o < 64; o <<= 1) v += __shfl_xor(v, o);
    return v;
}

namespace nv {
__global__ void __launch_bounds__(256) k_mod(const float* c, const float* ada_w, const float* ada_b, float* mod) {
    const int j = blockIdx.x * 256 + threadIdx.x;
    __shared__ float sc[NB][D];
    for (int i = threadIdx.x; i < NB * D; i += 256) sc[i / D][i % D] = silu_f(c[i]);
    __syncthreads();
    float acc[NB];
#pragma unroll
    for (int b = 0; b < NB; ++b) acc[b] = 0.f;
    for (int k = 0; k < D; ++k) { const float w = ada_w[(size_t)k * 6144 + j];
#pragma unroll
        for (int b = 0; b < NB; ++b) acc[b] += sc[b][k] * w; }
#pragma unroll
    for (int b = 0; b < NB; ++b) mod[b * 6144 + j] = acc[b] + ada_b[j];
}

template <bool DUAL, class Ctx>
__global__ void __launch_bounds__(256) k_gemm(Ctx cx) {
    __shared__ float As[16][68], Bs[16][68], Bs2[DUAL ? 16 : 1][68];
    __shared__ int s_info[4];
    if (!cx.setup(s_info)) return;
    __syncthreads();
    const int tm = blockIdx.y * 64, tn = blockIdx.x * 64, tid = threadIdx.x, tx = tid & 15, ty = tid >> 4;
    const int K = cx.K();
    float acc[4][4], acc2[4][4];
#pragma unroll
    for (int i = 0; i < 4; ++i)
#pragma unroll
        for (int j = 0; j < 4; ++j) { acc[i][j] = 0.f; acc2[i][j] = 0.f; }
    for (int k0 = 0; k0 < K; k0 += 16) {
#pragma unroll
        for (int i = 0; i < 4; ++i) { const int idx = tid + i * 256, r = idx >> 4, kk = idx & 15; As[kk][r] = cx.a(s_info, tm + r, k0 + kk); }
#pragma unroll
        for (int i = 0; i < 4; ++i) { const int idx = tid + i * 256, kk = idx >> 6, n = idx & 63; Bs[kk][n] = cx.b(s_info, k0 + kk, tn + n); if (DUAL) Bs2[kk][n] = cx.b2(s_info, k0 + kk, tn + n); }
        __syncthreads();
#pragma unroll
        for (int kk = 0; kk < 16; ++kk) {
            float a[4], b[4], b2[4];
#pragma unroll
            for (int i = 0; i < 4; ++i) { a[i] = As[kk][ty * 4 + i]; b[i] = Bs[kk][tx * 4 + i]; b2[i] = DUAL ? Bs2[kk][tx * 4 + i] : 0.f; }
#pragma unroll
            for (int i = 0; i < 4; ++i)
#pragma unroll
                for (int j = 0; j < 4; ++j) { acc[i][j] += a[i] * b[j]; if (DUAL) acc2[i][j] += a[i] * b2[j]; }
        }
        __syncthreads();
    }
#pragma unroll
    for (int i = 0; i < 4; ++i)
#pragma unroll
        for (int j = 0; j < 4; ++j) cx.epi(s_info, tm + ty * 4 + i, tn + tx * 4 + j, acc[i][j], acc2[i][j]);
}

struct CxIn {
    const float* x; const float* mod; const float* w; bf16* proj; float* dtf;
    __device__ bool setup(int*) const { return true; }
    __device__ int K() const { return D; }
    __device__ float a(const int*, int m, int k) const { const int b = m / T; return x[(size_t)m * D + k] * (1.f + mod[b * 6144 + D + k]) + mod[b * 6144 + k]; }
    __device__ float b(const int*, int k, int n) const { return n < DIN ? w[(size_t)k * DIN + n] : 0.f; }
    __device__ float b2(const int*, int, int) const { return 0.f; }
    __device__ void epi(const int*, int m, int n, float v, float) const {
        if (n >= DIN) return;
        if (n < 1536) proj[(size_t)m * PW + n] = (bf16)f2bf(v);
        else if (n < 1544) dtf[m * 16 + (n - 1536)] = v;
        else if (n < 3080) { const int c = n - 8; proj[(size_t)m * PW + c] = (bf16)f2bf(c < PC_K ? v * QSCALE : v); }
        else dtf[m * 16 + 8 + (n - 3080)] = v;
    }
};
struct CxOut {
    const bf16* ycat; const float* w; float* h;
    __device__ bool setup(int*) const { return true; }
    __device__ int K() const { return D; }
    __device__ float a(const int*, int m, int k) const { return bf2f(ycat[(size_t)m * D + k]); }
    __device__ float b(const int*, int k, int n) const { return w[(size_t)k * D + n]; }
    __device__ float b2(const int*, int, int) const { return 0.f; }
    __device__ void epi(const int*, int m, int n, float v, float) const { h[(size_t)m * D + n] = v; }
};
__device__ __forceinline__ bool moe_setup(const unsigned* cnt, int* s_info) {
    const int e = blockIdx.z; const int n = (int)cnt[e];
    if ((int)blockIdx.y * 64 >= n) return false;
    if (threadIdx.x == 0) { int base = 0; for (int i = 0; i < e; ++i) base += ((int)cnt[i] + 255) / 256 * 256; s_info[0] = e; s_info[1] = n; s_info[2] = base; }
    return true;
}
struct CxMoe1 {
    const unsigned* cnt; const int* list; const bf16* u2; const float* wg; const float* wu; bf16* hmid;
    __device__ bool setup(int* s) const { return moe_setup(cnt, s); }
    __device__ int K() const { return D; }
    __device__ float a(const int* s, int m, int k) const { if (m >= s[1]) return 0.f; const int tok = list[s[0] * LCAP + m] >> 1; return bf2f(u2[(size_t)tok * D + k]); }
    __device__ float b(const int* s, int k, int n) const { return wg[((size_t)s[0] * D + k) * DE + n]; }
    __device__ float b2(const int* s, int k, int n) const { return wu[((size_t)s[0] * D + k) * DE + n]; }
    __device__ void epi(const int* s, int m, int n, float g, float u) const { if (m >= s[1]) return; hmid[(size_t)(s[2] + m) * DE + n] = (bf16)f2bf(silu_f(g) * u); }
};
struct CxMoe2 {
    const unsigned* cnt; const int* list; const bf16* hmid; const float* wd; bf16* yk0; bf16* yk1;
    __device__ bool setup(int* s) const { return moe_setup(cnt, s); }
    __device__ int K() const { return DE; }
    __device__ float a(const int* s, int m, int k) const { if (m >= s[1]) return 0.f; return bf2f(hmid[(size_t)(s[2] + m) * DE + k]); }
    __device__ float b(const int* s, int k, int n) const { return wd[((size_t)s[0] * DE + k) * D + n]; }
    __device__ float b2(const int*, int, int) const { return 0.f; }
    __device__ void epi(const int* s, int m, int n, float v, float) const { if (m >= s[1]) return; const int a = list[s[0] * LCAP + m]; bf16* y = (a & 1) ? yk1 : yk0; y[(size_t)(a >> 1) * D + n] = (bf16)f2bf(v); }
};

__global__ void k_cumf(const float* dtf, const float* fg_bias, float* ck) {
    const int bh = blockIdx.x * blockDim.x + threadIdx.x; if (bh >= NB * NH) return;
    const int b = bh / NH, h = bh % NH; const float fb = fg_bias[h]; float s = 0.f;
    for (int t = 0; t < T; ++t) { const float f = dtf[(size_t)(b * T + t) * 16 + 8 + h] + fb; s += -softplus_f(-f); ck[(size_t)bh * T + t] = s; }
}
__global__ void __launch_bounds__(256) k_conv(const bf16* proj, const float* cw, const float* cb, float* xact) {
    const size_t i = (size_t)blockIdx.x * 256 + threadIdx.x; const int m = (int)(i / DXBC), ch = (int)(i % DXBC), t = m % T;
    float acc = cb[ch];
#pragma unroll
    for (int j = 0; j < 4; ++j) { const int tt = t - 3 + j; if (tt >= 0) acc += cw[j * DXBC + ch] * bf2f(proj[(size_t)(m - 3 + j) * PW + PC_XS + ch]); }
    xact[i] = silu_f(acc);
}
__global__ void __launch_bounds__(256) k_ssd(const float* xact, const float* dtf, const float* dt_bias, const float* a_log, const float* d_skip, float* ypre) {
    const int b = blockIdx.x / NH, h = blockIdx.x % NH, g = h / 4, p = threadIdx.x >> 2, nq = threadIdx.x & 3;
    const float A = -expf(a_log[h]), Dh = d_skip[h], dtb = dt_bias[h];
    float st[32];
#pragma unroll
    for (int i = 0; i < 32; ++i) st[i] = 0.f;
    for (int t = 0; t < T; ++t) {
        const size_t m = (size_t)b * T + t;
        const float dtv = softplus_f(dtf[m * 16 + h] + dtb), dA = expf(dtv * A);
        const float xv = xact[m * DXBC + h * 64 + p], xd = xv * dtv;
        const f32x4* Bp = (const f32x4*)(xact + m * DXBC + 512 + g * 128 + nq * 32);
        const f32x4* Cp = (const f32x4*)(xact + m * DXBC + 768 + g * 128 + nq * 32);
        float y = 0.f;
#pragma unroll
        for (int i = 0; i < 8; ++i) { const f32x4 bv = Bp[i], cv = Cp[i];
#pragma unroll
            for (int j = 0; j < 4; ++j) { st[i * 4 + j] = dA * st[i * 4 + j] + xd * bv[j]; y += cv[j] * st[i * 4 + j]; } }
        y += __shfl_xor(y, 1); y += __shfl_xor(y, 2);
        if (nq == 0) ypre[m * DSSM + h * 64 + p] = y + Dh * xv;
    }
}
__global__ void __launch_bounds__(256) k_ssm_norm(const float* ypre, const bf16* proj, const float* ng, bf16* ycat) {
    const int w = (blockIdx.x * 256 + threadIdx.x) >> 6, lane = threadIdx.x & 63, m = w >> 1, g = w & 1;
    float v[4]; float ss = 0.f;
#pragma unroll
    for (int j = 0; j < 4; ++j) { const int c = g * 256 + lane * 4 + j; v[j] = ypre[(size_t)m * DSSM + c] * silu_f(bf2f(proj[(size_t)m * PW + PC_Z + c])); ss += v[j] * v[j]; }
    const float r = 1.f / sqrtf(wave_sum(ss) * (1.f / 256.f) + EPS);
#pragma unroll
    for (int j = 0; j < 4; ++j) { const int c = g * 256 + lane * 4 + j; ycat[(size_t)m * D + c] = (bf16)f2bf(v[j] * r * ng[c]); }
}
__global__ void __launch_bounds__(64) k_attn(bf16* proj, const float* ck) {
    __shared__ float Ks[64][64], Vs[64][64], cks[64];
    const int blk = blockIdx.x, qt = blk % 32, bh = blk / 32, b = bh / NH, h = bh % NH, lane = threadIdx.x;
    const int q = qt * 64 + lane; const size_t mq = (size_t)b * T + q;
    float Q[64], O[64];
#pragma unroll
    for (int d = 0; d < 64; ++d) { Q[d] = bf2f(proj[mq * PW + PC_Q + h * 64 + d]); O[d] = 0.f; }
    const float cq = ck[(size_t)bh * T + q];
    float mrun = -INFINITY, lrun = 0.f;
    for (int kt = 0; kt <= qt; ++kt) {
        __syncthreads();
        for (int i = lane; i < 64 * 64; i += 64) { const int r = i >> 6, d = i & 63; const size_t mk = (size_t)b * T + kt * 64 + r;
            Ks[r][d] = bf2f(proj[mk * PW + PC_K + h * 64 + d]); Vs[r][d] = bf2f(proj[mk * PW + PC_V + h * 64 + d]); }
        cks[lane] = ck[(size_t)bh * T + kt * 64 + lane];
        __syncthreads();
        const int jmax = (kt == qt) ? lane : 63;
        for (int j = 0; j <= jmax; ++j) {
            float s = 0.f;
#pragma unroll
            for (int d = 0; d < 64; ++d) s += Q[d] * Ks[j][d];
            s += (cq - cks[j]) * LOG2E;
            const float mn = fmaxf(mrun, s), al = exp2f(mrun - mn), pj = exp2f(s - mn);
            lrun = lrun * al + pj; mrun = mn;
#pragma unroll
            for (int d = 0; d < 64; ++d) O[d] = O[d] * al + pj * Vs[j][d];
        }
    }
    const float il = 1.f / lrun;
#pragma unroll
    for (int d = 0; d < 64; ++d) proj[mq * PW + PC_Q + h * 64 + d] = (bf16)f2bf(O[d] * il);
}
__global__ void __launch_bounds__(256) k_attn_norm(const bf16* proj, const float* ng, bf16* ycat) {
    const int m = (blockIdx.x * 256 + threadIdx.x) >> 6, lane = threadIdx.x & 63;
    float v[8]; float ss = 0.f;
#pragma unroll
    for (int j = 0; j < 8; ++j) { v[j] = bf2f(proj[(size_t)m * PW + PC_Q + lane * 8 + j]); ss += v[j] * v[j]; }
    const float r = 1.f / sqrtf(wave_sum(ss) * (1.f / 512.f) + EPS);
#pragma unroll
    for (int j = 0; j < 8; ++j) ycat[(size_t)m * D + 512 + lane * 8 + j] = (bf16)f2bf(v[j] * r * ng[lane * 8 + j]);
}
__global__ void __launch_bounds__(256) k_ln1_router(const float* x, float* hx1, const float* mod, const float* g1, const float* b1,
                                                    const float* rgw, const float* rgb, const float* rew, const float* reb,
                                                    bf16* u2, unsigned* cnt, int* list, int* toke, float* tokw, int* toks) {
    const int m = (blockIdx.x * 256 + threadIdx.x) >> 6, lane = threadIdx.x & 63, b = m / T;
    const float* mb = mod + b * 6144;
    float v[16]; float s = 0.f;
#pragma unroll
    for (int j = 0; j < 4; ++j) { const int c = 4 * lane + 256 * j; const f32x4 xv = *(const f32x4*)(x + (size_t)m * D + c), hv = *(const f32x4*)(hx1 + (size_t)m * D + c), gt = *(const f32x4*)(mb + 2 * D + c);
#pragma unroll
        for (int i = 0; i < 4; ++i) { v[j * 4 + i] = ALPHA * xv[i] + (1.f + gt[i]) * hv[i]; s += v[j * 4 + i]; } }
    const float mean = wave_sum(s) * (1.f / D); float s2 = 0.f;
#pragma unroll
    for (int i = 0; i < 16; ++i) { v[i] -= mean; s2 += v[i] * v[i]; }
    const float rstd = 1.f / sqrtf(wave_sum(s2) * (1.f / D) + EPS);
    float acc[36];
#pragma unroll
    for (int i = 0; i < 36; ++i) acc[i] = 0.f;
#pragma unroll
    for (int j = 0; j < 4; ++j) { const int c = 4 * lane + 256 * j; const f32x4 gg = *(const f32x4*)(g1 + c), bb = *(const f32x4*)(b1 + c), sc = *(const f32x4*)(mb + 4 * D + c), sh = *(const f32x4*)(mb + 3 * D + c);
        f32x4 x1, uu;
#pragma unroll
        for (int i = 0; i < 4; ++i) { x1[i] = v[j * 4 + i] * rstd * gg[i] + bb[i]; uu[i] = x1[i] * (1.f + sc[i]) + sh[i]; }
        *(f32x4*)(hx1 + (size_t)m * D + c) = x1;
        u32x2 pk; pk.x = pk2(uu[0], uu[1]); pk.y = pk2(uu[2], uu[3]); *(u32x2*)(u2 + (size_t)m * D + c) = pk;
#pragma unroll
        for (int i = 0; i < 4; ++i) { const int k = c + i; const f32x4 wg = *(const f32x4*)(rgw + (size_t)k * 4);
#pragma unroll
            for (int q = 0; q < 4; ++q) acc[q] += uu[i] * wg[q];
#pragma unroll
            for (int q8 = 0; q8 < 8; ++q8) { const f32x4 we = *(const f32x4*)(rew + (size_t)k * 32 + q8 * 4);
#pragma unroll
                for (int q = 0; q < 4; ++q) acc[4 + q8 * 4 + q] += uu[i] * we[q]; } } }
#pragma unroll
    for (int i = 0; i < 36; ++i) acc[i] = wave_sum(acc[i]);
    float lg[4]; float mx = -INFINITY; int gi = 0;
#pragma unroll
    for (int i = 0; i < 4; ++i) { lg[i] = acc[i] + rgb[i]; if (lg[i] > mx) { mx = lg[i]; gi = i; } }
    float se = 0.f;
#pragma unroll
    for (int i = 0; i < 4; ++i) se += expf(lg[i] - mx);
    const float gp = 1.f / se;
    float le[8]; float mxe = -INFINITY;
#pragma unroll
    for (int i = 0; i < 8; ++i) { float t = 0.f;
#pragma unroll
        for (int gq = 0; gq < 4; ++gq) t = (gi == gq) ? acc[4 + gq * 8 + i] + reb[gq * 8 + i] : t;
        le[i] = t; mxe = fmaxf(mxe, t); }
    float pe[8];
#pragma unroll
    for (int i = 0; i < 8; ++i) pe[i] = expf(le[i] - mxe);
    int i1 = 0; float p1 = -1.f;
#pragma unroll
    for (int i = 0; i < 8; ++i) if (pe[i] > p1) { p1 = pe[i]; i1 = i; }
    int i2 = 0; float p2 = -1.f;
#pragma unroll
    for (int i = 0; i < 8; ++i) if (i != i1 && pe[i] > p2) { p2 = pe[i]; i2 = i; }
    const float inv = 1.f / (p1 + p2);
    if (lane == 0) {
        const int e0 = gi * 8 + i1, e1 = gi * 8 + i2;
        const unsigned q0 = atomicAdd(&cnt[e0], 1u), q1 = atomicAdd(&cnt[e1], 1u);
        list[e0 * LCAP + q0] = m * 2; list[e1 * LCAP + q1] = m * 2 + 1;
        toke[m * 2] = e0; toke[m * 2 + 1] = e1; tokw[m * 2] = gp * p1 * inv; tokw[m * 2 + 1] = gp * p2 * inv; toks[m * 2] = (int)q0; toks[m * 2 + 1] = (int)q1;
    }
}
__global__ void __launch_bounds__(256) k_final(float* out, const float* mod, const bf16* yk0, const bf16* yk1, const float* tokw, const float* g2, const float* b2) {
    const int m = (blockIdx.x * 256 + threadIdx.x) >> 6, lane = threadIdx.x & 63, b = m / T;
    const float* mb = mod + b * 6144; const float w0 = tokw[m * 2], w1 = tokw[m * 2 + 1];
    float v[16]; float s = 0.f;
#pragma unroll
    for (int j = 0; j < 4; ++j) { const int c = 4 * lane + 256 * j; const f32x4 xv = *(const f32x4*)(out + (size_t)m * D + c), gt = *(const f32x4*)(mb + 5 * D + c);
        const u32x2 a = *(const u32x2*)(yk0 + (size_t)m * D + c), bq = *(const u32x2*)(yk1 + (size_t)m * D + c);
        const float y0[4] = {bf2f(a.x), bf2f(a.x >> 16), bf2f(a.y), bf2f(a.y >> 16)}, y1[4] = {bf2f(bq.x), bf2f(bq.x >> 16), bf2f(bq.y), bf2f(bq.y >> 16)};
#pragma unroll
        for (int i = 0; i < 4; ++i) { v[j * 4 + i] = ALPHA * xv[i] + (1.f + gt[i]) * (w0 * y0[i] + w1 * y1[i]); s += v[j * 4 + i]; } }
    const float mean = wave_sum(s) * (1.f / D); float s2 = 0.f;
#pragma unroll
    for (int i = 0; i < 16; ++i) { v[i] -= mean; s2 += v[i] * v[i]; }
    const float rstd = 1.f / sqrtf(wave_sum(s2) * (1.f / D) + EPS);
#pragma unroll
    for (int j = 0; j < 4; ++j) { const int c = 4 * lane + 256 * j; const f32x4 gg = *(const f32x4*)(g2 + c), bb = *(const f32x4*)(b2 + c); f32x4 o;
#pragma unroll
        for (int i = 0; i < 4; ++i) o[i] = v[j * 4 + i] * rstd * gg[i] + bb[i];
        *(f32x4*)(out + (size_t)m * D + c) = o; }
}
}
namespace pg8 {
#define PG8_LAS __attribute__((address_space(3)))
typedef unsigned short bf16_t;
typedef short bf16x8 __attribute__((ext_vector_type(8)));
typedef float f32x4 __attribute__((ext_vector_type(4)));
typedef float f32x2 __attribute__((ext_vector_type(2)));
typedef unsigned u32x4 __attribute__((ext_vector_type(4)));
constexpr int BM = 256, BK = 64, HALF = 128, HTB = HALF * BK * 2  , STAGE_BYTES = 8 * HTB, NXCD = 8, WGM = 8;

__host__ __device__ __forceinline__ int lds_byte(int r, int c) { const int st = (r >> 4) * 2 + (c >> 5), rr = r & 15, cc = c & 31, ob = rr * 64 + cc * 2; return st * 1024 + (ob ^ (((ob >> 9) & 1) << 5)); }
__host__ __device__ __forceinline__ void stage_rc(int b, int& R, int& C) { const int st = b / 1024, sb = b % 1024, swz = sb ^ (((sb >> 9) & 1) << 5); R = (st >> 1) * 16 + swz / 64; C = (st & 1) * 32 + (swz % 64) / 2; }
__host__ __device__ __forceinline__ int perm32(int rho) { const int n = rho >> 4, i = rho & 15; return 8 * (i >> 2) + 4 * n + (i & 3); }

struct Unit { int pm, pn; unsigned boff; int x0, x1, x2; };
struct Gemm { const bf16_t* A; const bf16_t* Bt; int K; };

struct StaticOrder {
    int nM, nN, nwg, G, c, K;
    __device__ void init(int M, int N, int K_, int G_, int c_) { nM = M / BM; nN = N / BM; nwg = nM * nN; G = G_; c = c_; K = K_; }
    __device__ bool next(int i, Unit& u) const {
        const long L = (long)i * G + c; if (L >= nwg) return false;
        int wgid = (int)L; { const int q = nwg / NXCD, r = nwg % NXCD, xcd = wgid % NXCD, off = wgid / NXCD; wgid = (xcd < r ? xcd * (q + 1) : r * (q + 1) + (xcd - r) * q) + off; }
        const int nig = WGM * nN, gid = wgid / nig, fm = gid * WGM, gsz = (nM - fm) < WGM ? (nM - fm) : WGM;
        u.pm = fm + ((wgid % nig) % gsz); u.pn = (wgid % nig) / gsz; u.boff = (unsigned)u.pn * (unsigned)(BM * K * 2); u.x0 = u.x1 = u.x2 = 0; return true;
    }
    __device__ __forceinline__ unsigned arow(const Unit& u, int r) const { return (unsigned)(u.pm * BM + r) * (unsigned)(K * 2); }
};

__device__ __forceinline__ unsigned cvt_pk_bf16(float lo, float hi) { unsigned r; asm volatile("v_cvt_pk_bf16_f32 %0, %1, %2" : "=v"(r) : "v"(lo), "v"(hi)); return r; }

struct EpiProj {
    static constexpr bool PERM = true;
    bf16_t* O; int ldc; int q_lo, q_hi; float qs;
    __device__ __forceinline__ void operator()(const f32x4 (&acc)[2][2][4][2], const Unit& u, int wr, int wc, int fr, int fq) const {
        const int row0 = u.pm * BM + wr * 64 + fr, colt = u.pn * BM; const float sc = (colt >= q_lo && colt < q_hi) ? qs : 1.f;
        const int col0 = colt + wc * 32 + 8 * fq;
#pragma unroll
        for (int ai = 0; ai < 2; ++ai)
#pragma unroll
            for (int m = 0; m < 4; ++m) { bf16_t* rowp = O + (size_t)(row0 + ai * HALF + m * 16) * ldc + col0;
#pragma unroll
                for (int bj = 0; bj < 2; ++bj) { const f32x4 v0 = acc[ai][bj][m][0] * sc, v1 = acc[ai][bj][m][1] * sc;
                    u32x4 w; w.x = cvt_pk_bf16(v0[0], v0[1]); w.y = cvt_pk_bf16(v0[2], v0[3]); w.z = cvt_pk_bf16(v1[0], v1[1]); w.w = cvt_pk_bf16(v1[2], v1[3]);
                    *(u32x4*)(rowp + bj * HALF) = w; } }
    }
};
struct EpiF32 {
    static constexpr bool PERM = false;
    float* O; int ldc;
    __device__ __forceinline__ void operator()(const f32x4 (&acc)[2][2][4][2], const Unit& u, int wr, int wc, int fr, int fq) const {
        const int row0 = u.pm * BM + wr * 64 + fr, col0 = u.pn * BM + wc * 32 + 4 * fq;
#pragma unroll
        for (int ai = 0; ai < 2; ++ai)
#pragma unroll
            for (int m = 0; m < 4; ++m) { float* rowp = O + (size_t)(row0 + ai * HALF + m * 16) * ldc + col0;
#pragma unroll
                for (int bj = 0; bj < 2; ++bj)
#pragma unroll
                    for (int n = 0; n < 2; ++n) *(f32x4*)(rowp + bj * HALF + n * 16) = acc[ai][bj][m][n]; }
    }
};

struct EpiMoe1 {
    static constexpr bool PERM = true;
    bf16_t* H; int ldc;
    __device__ __forceinline__ void operator()(const f32x4 (&acc)[2][2][4][2], const Unit& u, int wr, int wc, int fr, int fq) const {
        const int row0 = u.pm * BM + wr * 64 + fr, col0 = u.pn * HALF + wc * 32 + 8 * fq;
#pragma unroll
        for (int ai = 0; ai < 2; ++ai)
#pragma unroll
            for (int m = 0; m < 4; ++m) { float hv[8];
#pragma unroll
                for (int n = 0; n < 2; ++n)
#pragma unroll
                    for (int j = 0; j < 4; ++j) { const float gt = acc[ai][0][m][n][j], up = acc[ai][1][m][n][j]; hv[n * 4 + j] = gt * __builtin_amdgcn_rcpf(1.f + __expf(-gt)) * up; }
                u32x4 w; w.x = cvt_pk_bf16(hv[0], hv[1]); w.y = cvt_pk_bf16(hv[2], hv[3]); w.z = cvt_pk_bf16(hv[4], hv[5]); w.w = cvt_pk_bf16(hv[6], hv[7]);
                *(u32x4*)(H + (size_t)(row0 + ai * HALF + m * 16) * ldc + col0) = w; }
    }
};
struct EpiMoe2 {
    static constexpr bool PERM = true;
    bf16_t* Y0; long ydelta; int ldc; const int* list;
    __device__ __forceinline__ void operator()(const f32x4 (&acc)[2][2][4][2], const Unit& u, int wr, int wc, int fr, int fq) const {
        const int col0 = u.pn * BM + wc * 32 + 8 * fq; const int* lp = list + u.x0 * LCAP + u.x1;
#pragma unroll
        for (int ai = 0; ai < 2; ++ai)
#pragma unroll
            for (int m = 0; m < 4; ++m) { const int r = ai * HALF + wr * 64 + m * 16 + fr;
                if (r < u.x2) { const int a = lp[r]; bf16_t* rowp = (bf16_t*)((char*)Y0 + (long)(a & 1) * ydelta) + (size_t)(a >> 1) * ldc + col0;
#pragma unroll
                    for (int bj = 0; bj < 2; ++bj) { const f32x4 v0 = acc[ai][bj][m][0], v1 = acc[ai][bj][m][1];
                        u32x4 w; w.x = cvt_pk_bf16(v0[0], v0[1]); w.y = cvt_pk_bf16(v0[2], v0[3]); w.z = cvt_pk_bf16(v1[0], v1[1]); w.w = cvt_pk_bf16(v1[2], v1[3]);
                        *(u32x4*)(rowp + bj * HALF) = w; } } }
    }
};
struct MoeOrder {
    const PG8_LAS unsigned* tab; const PG8_LAS unsigned* cnts; int ntiles, G, c, mode; const int* list;
    __device__ bool next(int i, Unit& u) const {
        const int L = i * G + c; if (L >= ntiles * 4) return false;
        const int tile = L >> 2; const unsigned w = tab[tile]; const int e = (int)(w & 0xffu), row0 = (int)(w >> 8), rem = (int)cnts[e] - row0;
        u.pm = tile; u.pn = L & 3; u.x0 = e; u.x1 = row0; u.x2 = rem < BM ? rem : BM;
        u.boff = mode == 0 ? (unsigned)(e * 1024 + u.pn * BM) * 2048u : (unsigned)(e * 1024 + u.pn * BM) * 1024u; return true;
    }
    __device__ __forceinline__ unsigned arow(const Unit& u, int r) const {
        if (mode == 0) { const int rr = r < u.x2 ? r : 0; return (unsigned)(list[u.x0 * LCAP + u.x1 + rr] >> 1) * 2048u; }
        return (unsigned)(u.pm * BM + r) * 1024u;
    }
};

template <class Epi, class Sched, bool ALIGN_EPI>
__device__ __forceinline__ void gemm_phase(PG8_LAS unsigned char* lds, const Gemm g, const Sched& S, const Epi& E) {
    const int tid = threadIdx.x, wid = __builtin_amdgcn_readfirstlane(tid >> 6), lane = tid & 63, wr = wid >> 2, wc = wid & 3, fr = lane & 15, fq = lane >> 4;
    const int K = g.K, nt = K / BK;
    int Rp[2], Cp[2]; unsigned voffB[2];
#pragma unroll
    for (int i = 0; i < 2; ++i) { int R, C; stage_rc(tid * 16 + i * 8192, R, C); Rp[i] = R; Cp[i] = C; const int Rb = Epi::PERM ? ((R & ~31) + perm32(R & 31)) : R; voffB[i] = (unsigned)(Rb * K + C) * 2u; }
    const size_t kstep = (size_t)(BK * 2);
    const size_t hstep = (size_t)HALF * K * 2;
    const unsigned ldsw = (unsigned)wid * 1024u;
    const int aoff = lds_byte(wr * 64 + fr, fq * 8), boff = lds_byte(wc * 32 + fr, fq * 8);
    const char* gA = (const char*)g.A;
#define PG8_SA(b, h) (((b) * 2 + (h)) * HTB)
#define PG8_SB(b, h) ((4 + (b) * 2 + (h)) * HTB)
#define PG8_STAGE(bufoff, gbase, voff) do { _Pragma("unroll") for (int _i = 0; _i < 2; ++_i) \
        __builtin_amdgcn_global_load_lds((const unsigned*)((const char*)(gbase) + (voff)[_i]), (PG8_LAS unsigned*)(lds + (bufoff) + ldsw + _i * 8192), 16, 0, 0); } while (0)
#define PG8_STAGE_A(bufoff, kb, V, h) do { _Pragma("unroll") for (int _i = 0; _i < 2; ++_i) \
        __builtin_amdgcn_global_load_lds((const unsigned*)(gA + (kb) + (V)[h][_i]), (PG8_LAS unsigned*)(lds + (bufoff) + ldsw + _i * 8192), 16, 0, 0); } while (0)
#define PG8_LDA(dst, b, h) do { _Pragma("unroll") for (int m = 0; m < 4; ++m) _Pragma("unroll") for (int k = 0; k < 2; ++k) dst[m][k] = *(const PG8_LAS bf16x8*)(lds + PG8_SA(b, h) + aoff + m * 2048 + k * 1024); } while (0)
#define PG8_LDB(dst, b, h) do { _Pragma("unroll") for (int n = 0; n < 2; ++n) _Pragma("unroll") for (int k = 0; k < 2; ++k) dst[n][k] = *(const PG8_LAS bf16x8*)(lds + PG8_SB(b, h) + boff + n * 2048 + k * 1024); } while (0)
#define PG8_MMA(ai, bj, At, Bt) do { __builtin_amdgcn_s_setprio(1); _Pragma("unroll") for (int m = 0; m < 4; ++m) _Pragma("unroll") for (int n = 0; n < 2; ++n) _Pragma("unroll") for (int k = 0; k < 2; ++k) \
        acc[ai][bj][m][n] = __builtin_amdgcn_mfma_f32_16x16x32_bf16(Bt[n][k], At[m][k], acc[ai][bj][m][n], 0, 0, 0); __builtin_amdgcn_s_setprio(0); } while (0)
#define PG8_WAIT_V(n) asm volatile("s_waitcnt vmcnt(" #n ")" ::: "memory")
#define PG8_WAIT_L(n) asm volatile("s_waitcnt lgkmcnt(" #n ")" ::: "memory")
#define PG8_BAR __builtin_amdgcn_s_barrier()
#define PG8_SCHED __builtin_amdgcn_sched_barrier(0)
    Unit cur, nxt; int ui = 0;
    if (!S.next(0, cur)) return;
    f32x4 acc[2][2][4][2];
#pragma unroll
    for (int a = 0; a < 2; ++a)
#pragma unroll
        for (int b = 0; b < 2; ++b)
#pragma unroll
            for (int m = 0; m < 4; ++m)
#pragma unroll
                for (int n = 0; n < 2; ++n) acc[a][b][m][n] = (f32x4){0.f, 0.f, 0.f, 0.f};
    bf16x8 At[4][2], B0[2][2], B1[2][2];
    unsigned vc[2][2], vn[2][2];
#pragma unroll
    for (int h = 0; h < 2; ++h)
#pragma unroll
        for (int i = 0; i < 2; ++i) vc[h][i] = S.arow(cur, h * HALF + Rp[i]) + (unsigned)(Cp[i] * 2);
    const char* cB = (const char*)g.Bt + cur.boff;
    PG8_STAGE(PG8_SB(0, 0), cB, voffB); PG8_STAGE(PG8_SB(0, 1), cB + hstep, voffB); PG8_STAGE_A(PG8_SA(0, 0), 0, vc, 0); PG8_STAGE_A(PG8_SA(0, 1), 0, vc, 1);
    if (wr == 1) PG8_BAR;
    PG8_WAIT_V(2); PG8_BAR;
    PG8_STAGE(PG8_SB(1, 0), cB + kstep, voffB); PG8_STAGE_A(PG8_SA(1, 0), kstep, vc, 0); PG8_STAGE(PG8_SB(1, 1), cB + hstep + kstep, voffB);
    PG8_WAIT_V(6); PG8_BAR;
    for (;;) {
        const bool has_next = S.next(ui + 1, nxt);
        const char* nB = has_next ? (const char*)g.Bt + nxt.boff : cB;
#pragma unroll
        for (int h = 0; h < 2; ++h)
#pragma unroll
            for (int i = 0; i < 2; ++i) vn[h][i] = has_next ? S.arow(nxt, h * HALF + Rp[i]) + (unsigned)(Cp[i] * 2) : vc[h][i];
        for (int t = 0; t < nt; t += 2) {
            const bool last = (t == nt - 2);
            const size_t k1 = (size_t)(t + 1) * kstep;
            const size_t k2 = last ? 0 : (size_t)(t + 2) * kstep, k3 = k2 + kstep;
            const char* b2 = last ? nB : cB + (size_t)(t + 2) * kstep; const char* b3 = b2 + kstep;
            unsigned v2[2][2];
#pragma unroll
            for (int h = 0; h < 2; ++h)
#pragma unroll
                for (int i = 0; i < 2; ++i) v2[h][i] = last ? vn[h][i] : vc[h][i];
            PG8_LDB(B0, 0, 0); PG8_LDB(B1, 0, 1); PG8_SCHED; PG8_LDA(At, 0, 0); PG8_STAGE_A(PG8_SA(1, 1), k1, vc, 1);
            PG8_WAIT_V(8); PG8_WAIT_L(0); PG8_BAR; PG8_MMA(0, 0, At, B0); PG8_MMA(0, 1, At, B1); PG8_BAR; PG8_SCHED;
            PG8_LDA(At, 0, 1); PG8_STAGE(PG8_SB(0, 0), b2, voffB); PG8_STAGE(PG8_SB(0, 1), b2 + hstep, voffB); PG8_STAGE_A(PG8_SA(0, 0), k2, v2, 0);
            PG8_WAIT_V(8); PG8_WAIT_L(0); PG8_BAR; PG8_MMA(1, 0, At, B0); PG8_MMA(1, 1, At, B1); PG8_BAR; PG8_SCHED;
            PG8_LDB(B0, 1, 0); PG8_LDB(B1, 1, 1); PG8_SCHED; PG8_LDA(At, 1, 0); PG8_STAGE_A(PG8_SA(0, 1), k2, v2, 1);
            PG8_WAIT_V(8); PG8_WAIT_L(0); PG8_BAR; PG8_MMA(0, 0, At, B0); PG8_MMA(0, 1, At, B1); PG8_BAR; PG8_SCHED;
            PG8_LDA(At, 1, 1); PG8_STAGE(PG8_SB(1, 0), b3, voffB); PG8_STAGE(PG8_SB(1, 1), b3 + hstep, voffB); PG8_STAGE_A(PG8_SA(1, 0), k3, v2, 0);
            PG8_WAIT_V(8); PG8_WAIT_L(0); PG8_BAR; PG8_MMA(1, 0, At, B0); PG8_MMA(1, 1, At, B1); PG8_BAR; PG8_SCHED;
        }
        if constexpr (ALIGN_EPI) { if (wr == 0) PG8_BAR; }
        E(acc, cur, wr, wc, fr, fq);
        if (!has_next) break;
#pragma unroll
        for (int a = 0; a < 2; ++a)
#pragma unroll
            for (int b = 0; b < 2; ++b)
#pragma unroll
                for (int m = 0; m < 4; ++m)
#pragma unroll
                    for (int n = 0; n < 2; ++n) acc[a][b][m][n] = (f32x4){0.f, 0.f, 0.f, 0.f};
        cur = nxt; cB = nB; ++ui;
#pragma unroll
        for (int h = 0; h < 2; ++h)
#pragma unroll
            for (int i = 0; i < 2; ++i) vc[h][i] = vn[h][i];
        if constexpr (ALIGN_EPI) { if (wr == 1) PG8_BAR; }
    }
    PG8_WAIT_V(0);
    if constexpr (!ALIGN_EPI) { if (wr == 0) PG8_BAR; }
    PG8_BAR;
#undef PG8_SA
#undef PG8_SB
#undef PG8_STAGE
#undef PG8_STAGE_A
#undef PG8_LDA
#undef PG8_LDB
#undef PG8_MMA
#undef PG8_WAIT_V
#undef PG8_WAIT_L
#undef PG8_BAR
#undef PG8_SCHED
}
}
#include <hip/hip_bf16.h>
#include <cmath>
namespace attn_body {
using bf16=__hip_bfloat16;
using bf16x8=__attribute__((ext_vector_type(8)))short;
using s16x4=__attribute__((ext_vector_type(4)))short;
using f32x16=__attribute__((ext_vector_type(16)))float;
using u32x4=__attribute__((ext_vector_type(4)))unsigned;
constexpr int BATCH=8,NHEAD=8,SEQ=2048,D=64,DM=3072;
constexpr int NW=8,QBLK=32,QB=QBLK*NW,KVBLK=64,NQB=SEQ/QB;
constexpr int ATTN_PITCH=DM, ATTN_UNIT_ROWS=QB;
__device__ __forceinline__ int crow(int r,int hi){return (r&3)+8*(r>>2)+4*hi;}
#define SBAR() __builtin_amdgcn_sched_barrier(0)
__device__ __forceinline__ void cmask(f32x16&p0,f32x16&p1,int jb,int qrel,int hi){
  const float NEG=-INFINITY; int kb=64*jb+4*hi;
  #pragma unroll
  for(int r=0;r<16;++r){int kv=kb+(r&3)+8*(r>>2); if(kv>qrel)p0[r]=NEG; if(kv+32>qrel)p1[r]=NEG;}
}

constexpr int NSLOT=3, SLOTB=8192;
constexpr int LDS_K=0, LDS_V=NSLOT*SLOTB, LDS_WS=2*NSLOT*SLOTB, LDS_OST=LDS_WS+NW*64*4, LDS_CKF=LDS_OST+NW*4096, LDS_CKP=LDS_CKF+SEQ*4, LDS_BYTES=LDS_CKP+SEQ*4;
constexpr float C2=0.125f*1.4426950408889634f;
__device__ __forceinline__ void glds16(const void*gsrc,unsigned lds_dst){unsigned keep;
  asm volatile("s_mov_b32 %0, m0\n\ts_mov_b32 m0, %2\n\ts_nop 0\n\tglobal_load_lds_dwordx4 %1, off\n\ts_mov_b32 m0, %0":"=&s"(keep):"v"(gsrc),"s"(lds_dst):"memory");}
__device__ __forceinline__ float max3f(float a,float b,float c){float r;asm("v_max3_f32 %0, %1, %2, %3":"=v"(r):"v"(a),"v"(b),"v"(c));return r;}
__device__ __forceinline__ float max2f(float a,float b){float r;asm("v_max_f32_e32 %0, %1, %2":"=v"(r):"v"(a),"v"(b));return r;}
__device__ __forceinline__ float fadd_s(float a,float b){float r;asm("v_add_f32_e32 %0, %1, %2":"=v"(r):"v"(a),"v"(b));return r;}
__device__ __forceinline__ float fsub_s(float a,float b){float r;asm("v_sub_f32_e32 %0, %1, %2":"=v"(r):"v"(a),"v"(b));return r;}
typedef float f32x2_t __attribute__((ext_vector_type(2))); typedef __bf16 bf16x2_t __attribute__((ext_vector_type(2)));
__device__ __forceinline__ unsigned cvtpk_s(float lo,float hi){f32x2_t v={lo,hi};bf16x2_t b=__builtin_convertvector(v,bf16x2_t);return __builtin_bit_cast(unsigned,b);}
#define WAIT_BAR(N) asm volatile("s_waitcnt vmcnt(" #N ") lgkmcnt(0)\n\ts_barrier":::"memory")

__device__ __forceinline__ unsigned f2bf_rne(float f){unsigned u=__float_as_uint(f);return (u+0x7fffu+((u>>16)&1u))>>16;}
__device__ __forceinline__ void qkt(f32x16&p0,f32x16&p1,const char*Kslot,const bf16x8*qr,int r32,int hi,bf16x8 kx0,bf16x8 kx1,bf16x8 qx){
  const char*kb=Kslot+hi*1024+r32*16;
  #pragma unroll
  for(int d0=0;d0<4;++d0){
    const bf16x8 b0=*reinterpret_cast<const bf16x8*>(kb+d0*2048);
    const bf16x8 b1=*reinterpret_cast<const bf16x8*>(kb+d0*2048+512);
    if(d0==0){p0=__builtin_amdgcn_mfma_f32_32x32x16_bf16(b0,qr[0],f32x16{},0,0,0);p1=__builtin_amdgcn_mfma_f32_32x32x16_bf16(b1,qr[0],f32x16{},0,0,0);}
    else{p0=__builtin_amdgcn_mfma_f32_32x32x16_bf16(b0,qr[d0],p0,0,0,0);p1=__builtin_amdgcn_mfma_f32_32x32x16_bf16(b1,qr[d0],p1,0,0,0);}}
  p0=__builtin_amdgcn_mfma_f32_32x32x16_bf16(kx0,qx,p0,0,0,0);p1=__builtin_amdgcn_mfma_f32_32x32x16_bf16(kx1,qx,p1,0,0,0);
}
typedef __attribute__((address_space(3))) const char* lds_cptr;
typedef short v4i16_t __attribute__((ext_vector_type(4)));
__device__ __forceinline__ void kload8(bf16x8*kf,lds_cptr kp){
  kf[0]=*(const __attribute__((address_space(3))) bf16x8*)(kp);      kf[1]=*(const __attribute__((address_space(3))) bf16x8*)(kp+512);
  kf[2]=*(const __attribute__((address_space(3))) bf16x8*)(kp+2048); kf[3]=*(const __attribute__((address_space(3))) bf16x8*)(kp+2560);
  kf[4]=*(const __attribute__((address_space(3))) bf16x8*)(kp+4096); kf[5]=*(const __attribute__((address_space(3))) bf16x8*)(kp+4608);
  kf[6]=*(const __attribute__((address_space(3))) bf16x8*)(kp+6144); kf[7]=*(const __attribute__((address_space(3))) bf16x8*)(kp+6656);
}
__device__ __forceinline__ void kload2(bf16x8*kf,lds_cptr kp,int j){ kf[2*j]=*(const __attribute__((address_space(3))) bf16x8*)(kp+j*2048); kf[2*j+1]=*(const __attribute__((address_space(3))) bf16x8*)(kp+j*2048+512); }
__device__ __forceinline__ s16x4 vtr(lds_cptr p){ return __builtin_bit_cast(s16x4,__builtin_amdgcn_ds_read_tr16_b64_v4i16((__attribute__((address_space(3))) v4i16_t*)p)); }
__device__ __forceinline__ float rowmax(const f32x16&p0,const f32x16&p1){
  float a=max3f(p0[0],p0[1],p1[0]),b=max3f(p0[2],p0[3],p1[1]);a=max3f(a,p1[2],p1[3]);
  #pragma unroll
  for(int r=4;r<16;r+=4){a=max3f(a,p0[r],p0[r+1]);b=max3f(b,p0[r+2],p0[r+3]);a=max3f(a,p1[r],p1[r+1]);b=max3f(b,p1[r+2],p1[r+3]);}
  const float m=max2f(a,b);
  auto rr=__builtin_amdgcn_permlane32_swap(__float_as_uint(m),__float_as_uint(m),false,false);
  return max2f(__uint_as_float(rr[0]),__uint_as_float(rr[1]));
}
__device__ __forceinline__ void pv(f32x16*o,int vb,bf16x8 pa0,bf16x8 pa1,bf16x8 pa2,bf16x8 pa3){
  #pragma unroll
  for(int d0=0;d0<2;++d0){s16x4 lo[4],hi[4];
    #pragma unroll
    for(int ks=0;ks<4;++ks){
      asm volatile("ds_read_b64_tr_b16 %0,%1 offset:%c2":"=&v"(lo[ks]):"v"(vb),"i"(d0*4096+ks*1024):"memory");
      asm volatile("ds_read_b64_tr_b16 %0,%1 offset:%c2":"=&v"(hi[ks]):"v"(vb),"i"(d0*4096+ks*1024+512):"memory");}
    asm volatile("s_waitcnt lgkmcnt(0)":::"memory");SBAR();
    #define PK(k) (bf16x8){lo[k][0],lo[k][1],lo[k][2],lo[k][3],hi[k][0],hi[k][1],hi[k][2],hi[k][3]}
    o[d0]=__builtin_amdgcn_mfma_f32_32x32x16_bf16(pa0,PK(0),o[d0],0,0,0);
    o[d0]=__builtin_amdgcn_mfma_f32_32x32x16_bf16(pa1,PK(1),o[d0],0,0,0);
    o[d0]=__builtin_amdgcn_mfma_f32_32x32x16_bf16(pa2,PK(2),o[d0],0,0,0);
    o[d0]=__builtin_amdgcn_mfma_f32_32x32x16_bf16(pa3,PK(3),o[d0],0,0,0);
    #undef PK
  }
}

#ifndef ATTN_STORE16
#define ATTN_STORE16(p,v) (*(u32x4*)(p)=(v))
#endif
template<int THRL> __device__ __forceinline__ void attn_unit(int b,int h,int qb,const bf16*Q,const bf16*__restrict__ K,const bf16*__restrict__ V,bf16*O,char*shm){
  const int tid=threadIdx.x,lane=tid&63,r32=lane&31,hi=lane>>5; const int wid=__builtin_amdgcn_readfirstlane(tid>>6);
  const long rowbase=(long)b*SEQ; const int q0=qb*QB;
  { const __attribute__((address_space(3))) float* ckf=(const __attribute__((address_space(3))) float*)((__attribute__((address_space(3))) char*)shm+LDS_CKF); __attribute__((address_space(3))) unsigned* ckpw=(__attribute__((address_space(3))) unsigned*)((__attribute__((address_space(3))) char*)shm+LDS_CKP);
    const float c0=ckf[q0];
    for(int k=tid;k<q0+QB;k+=NW*64){ const float x=(ckf[k]-c0)*1.4426950408889634f; const unsigned hb=f2bf_rne(x); const float xh=__uint_as_float(hb<<16); ckpw[k]=hb|(f2bf_rne(x-xh)<<16); }
    asm volatile("s_waitcnt lgkmcnt(0)\n\ts_barrier":::"memory"); }
  const __attribute__((address_space(3))) unsigned* ckp=(const __attribute__((address_space(3))) unsigned*)((__attribute__((address_space(3))) char*)shm+LDS_CKP);
  const bf16*Qw=Q+(rowbase+q0+wid*QBLK)*DM+h*D;
  const bf16*Kh=K+rowbase*DM+h*D,*Vh=V+rowbase*DM+h*D;
  const unsigned lds0=(unsigned)(uintptr_t)shm;
  float*wsf=(float*)(shm+LDS_WS)+wid*64;
  const bf16*ksrc=Kh+(long)lane*DM+wid*8;
  const bf16*vsrc=Vh+(long)(16*(wid&3)+(lane>>2))*DM+(wid>>2)*32+(lane&3)*8;
  const unsigned kdst=lds0+LDS_K+wid*1024, vdst=lds0+LDS_V+wid*1024;
  #define DMA_K(t,slot) glds16(ksrc+(long)(t)*KVBLK*DM,(unsigned)__builtin_amdgcn_readfirstlane(kdst+(slot)))
  #define DMA_V(t,slot) glds16(vsrc+(long)(t)*KVBLK*DM,(unsigned)__builtin_amdgcn_readfirstlane(vdst+(slot)))
  const int vb0=(int)(lds0+LDS_V)+((lane>>4)&1)*32+(lane&3)*8+(4*hi+((lane&15)>>2))*64;
  const char*Kbase=shm+LDS_K; bf16x8 kf[8];
  const lds_cptr shm3=(lds_cptr)shm; const lds_cptr kp0=shm3+LDS_K+hi*1024+r32*16; const lds_cptr vp0=shm3+LDS_V+((lane>>4)&1)*32+(lane&3)*8+(4*hi+((lane&15)>>2))*64;
  const int NT=(q0+QB)/KVBLK;
  DMA_K(0,0);DMA_V(0,0);DMA_K(1,SLOTB);
  bf16x8 qr[4];
  #pragma unroll
  for(int d0=0;d0<4;++d0)qr[d0]=*reinterpret_cast<const bf16x8*>(&Qw[(long)r32*DM+d0*16+hi*8]);
  const unsigned cqw=hi?0u:ckp[q0+wid*QBLK+r32]; bf16x8 qx=__builtin_bit_cast(bf16x8,(u32x4){hi?0u:0xbf80bf80u,cqw,0u,0u});
  #define SETQX() do{ const unsigned hb_=f2bf_rne(mhat); const unsigned mw_=hb_|(f2bf_rne(mhat-__uint_as_float(hb_<<16))<<16); qx=__builtin_bit_cast(bf16x8,(u32x4){hi?0u:0xbf80bf80u,cqw,hi?0u:mw_,0u}); }while(0)
  #define KXW(w) __builtin_bit_cast(bf16x8,(u32x4){(w),0x3f803f80u,0xbf80bf80u,0u})
  #define KX(key) __builtin_bit_cast(bf16x8,(u32x4){ckp[(key)+r32],0x3f803f80u,0xbf80bf80u,0u})
  float mhat=0.f,l_reg=0.f;f32x16 o[2];o[0]=f32x16{};o[1]=f32x16{};
  const int qrel=wid*QBLK+r32;
  #define CMASK(P0,P1,t) do{int jb_=(t)-(NT-4); if(jb_>=0)cmask(P0,P1,jb_,qrel,hi);}while(0)
  bool resc=false;
  #define START(P0,P1) do{ const float rm=rowmax(P0,P1); resc=false; \
    { const float dl=__builtin_ceilf(rm); mhat=fadd_s(mhat,dl); \
      _Pragma("unroll") for(int r=0;r<16;++r){P0[r]=fsub_s(P0[r],dl);P1[r]=fsub_s(P1[r],dl);} \
      SETQX(); } \
    _Pragma("unroll") for(int r=0;r<16;++r)P0[r]=__builtin_amdgcn_exp2f(P0[r]); }while(0)
  #define RESC() do{ if(resc){ asm volatile("s_waitcnt lgkmcnt(0)":::"memory"); \
      _Pragma("unroll") for(int d_=0;d_<2;++d_) _Pragma("unroll") for(int r=0;r<16;++r)o[d_][r]*=wsf[crow(r,hi)]; } }while(0)
  f32x16 pA0,pA1,pB0,pB1;
  int sl_prev=0,sl_cur=0,sl_next=SLOTB;
  #define ROT() do{sl_prev=sl_cur;sl_cur=sl_next;sl_next=(sl_next==(NSLOT-1)*SLOTB)?0:sl_next+SLOTB;}while(0)
  DMA_K(2,2*SLOTB);
  WAIT_BAR(3);
  qkt(pA0,pA1,Kbase,qr,r32,hi,KX(0),KX(32),qx);asm volatile("s_nop 15\n\ts_nop 7":"+v"(pA0),"+v"(pA1));CMASK(pA0,pA1,0);
  START(pA0,pA1);
  _Pragma("unroll") for(int r=0;r<16;++r)pA1[r]=__builtin_amdgcn_exp2f(pA1[r]);
  WAIT_BAR(0);
  DMA_K(3,0);DMA_V(1,SLOTB);
  ROT();
  kload8(kf,kp0+sl_cur);
  unsigned kw0=ckp[KVBLK+r32], kw1=ckp[KVBLK+32+r32];
  WAIT_BAR(2);
  s16x4 vlo[8],vhi[8]; u32x4 pw0,pw1,pw2,pw3;
  #define PKW(P,B) cvtpk_s(P[B],P[B+1])
  #define PAF(k) __builtin_bit_cast(bf16x8,pw##k)
  #define VFR(i) (bf16x8){vlo[i][0],vlo[i][1],vlo[i][2],vlo[i][3],vhi[i][0],vhi[i][1],vhi[i][2],vhi[i][3]}
  #define PIN(x) asm volatile("":"+v"(x))
  #define MX3(a,b,c) __builtin_fmaxf(__builtin_fmaxf((a),(b)),(c))
  #define GAPA(MF,A0,A1,A2,A3,W0,W1,PW) do{ MF; sacc+=A0; sacc+=A1; sacc+=A2; sacc+=A3; PIN(sacc); W0; W1; PIN(PW); SBAR(); }while(0)
  #define EX(v) __builtin_amdgcn_exp2f(v)
  #define GAPB(MF,X,B) do{ MF; X[B]=EX(X[B]); X[B+1]=EX(X[B+1]); X[B+2]=EX(X[B+2]); X[B+3]=EX(X[B+3]); PIN(X); SBAR(); }while(0)
  #define VRD(i) do{ vlo[i]=vtr(vp_+(((i)>>2)*4096+((i)&3)*1024)); vhi[i]=vtr(vp_+(((i)>>2)*4096+((i)&3)*1024+512)); }while(0)
  #define KRD(G,j) do{ if(G){ kload2(kf,kp0+sl_next,j); SBAR(); } }while(0)
  #define STEP(C0,C1,P0,P1,t,GK,GV,GL) do{ SBAR(); \
    C0=__builtin_amdgcn_mfma_f32_32x32x16_bf16(KXW(kw0),qx,f32x16{},0,0,0); C1=__builtin_amdgcn_mfma_f32_32x32x16_bf16(KXW(kw1),qx,f32x16{},0,0,0); SBAR(); \
    const lds_cptr vp_=vp0+sl_prev; \
    VRD(0); SBAR(); float sacc=(P0[0]+P0[1]); \
    GAPA(C0=__builtin_amdgcn_mfma_f32_32x32x16_bf16(kf[0],qr[0],C0,0,0,0), P0[2],P0[3],P0[4],P0[5],     pw0[0]=PKW(P0,0), pw0[1]=PKW(P0,2), pw0); \
    VRD(4); SBAR(); GAPA(C1=__builtin_amdgcn_mfma_f32_32x32x16_bf16(kf[1],qr[0],C1,0,0,0), P0[6],P0[7],P0[8],P0[9],     pw0[2]=PKW(P0,4), pw0[3]=PKW(P0,6), pw0); \
    VRD(1); SBAR(); GAPA(C0=__builtin_amdgcn_mfma_f32_32x32x16_bf16(kf[2],qr[1],C0,0,0,0),   P0[10],P0[11],P0[12],P0[13], pw1[0]=PKW(P0,8), pw1[1]=PKW(P0,10), pw1); \
    VRD(5); SBAR(); GAPA(C1=__builtin_amdgcn_mfma_f32_32x32x16_bf16(kf[3],qr[1],C1,0,0,0),   P0[14],P0[15],P1[0],P1[1],   pw1[2]=PKW(P0,12),pw1[3]=PKW(P0,14), pw1); \
    VRD(2); SBAR(); GAPA(C0=__builtin_amdgcn_mfma_f32_32x32x16_bf16(kf[4],qr[2],C0,0,0,0),   P1[2],P1[3],P1[4],P1[5],     pw2[0]=PKW(P1,0), pw2[1]=PKW(P1,2), pw2); \
    VRD(6); SBAR(); GAPA(C1=__builtin_amdgcn_mfma_f32_32x32x16_bf16(kf[5],qr[2],C1,0,0,0),   P1[6],P1[7],P1[8],P1[9],     pw2[2]=PKW(P1,4), pw2[3]=PKW(P1,6), pw2); \
    VRD(3); SBAR(); GAPA(C0=__builtin_amdgcn_mfma_f32_32x32x16_bf16(kf[6],qr[3],C0,0,0,0),   P1[10],P1[11],P1[12],P1[13], pw3[0]=PKW(P1,8), pw3[1]=PKW(P1,10), pw3); \
    VRD(7); SBAR(); GAPA(C1=__builtin_amdgcn_mfma_f32_32x32x16_bf16(kf[7],qr[3],C1,0,0,0),   P1[14],P1[15],0.f,0.f,       pw3[2]=PKW(P1,12),pw3[3]=PKW(P1,14), pw3); \
    l_reg+=sacc; \
    if(GK){DMA_K((t)+3,sl_cur);} if(GV){DMA_V((t)+1,sl_next);} \
    CMASK(C0,C1,t); \
    { float a=MX3(C0[0],C0[1],C1[0]),b=MX3(C0[2],C0[3],C1[1]); a=MX3(a,C1[2],C1[3]); \
      _Pragma("unroll") for(int r=4;r<16;r+=4){a=MX3(a,C0[r],C0[r+1]);b=MX3(b,C0[r+2],C0[r+3]);a=MX3(a,C1[r],C1[r+1]);b=MX3(b,C1[r+2],C1[r+3]);} \
      float rm=__builtin_fmaxf(a,b); { auto rr=__builtin_amdgcn_permlane32_swap(__float_as_uint(rm),__float_as_uint(rm),false,false); rm=__builtin_fmaxf(__uint_as_float(rr[0]),__uint_as_float(rr[1])); } \
      resc=false; \
      if(__builtin_expect(__any(rm>(float)THRL),0)){ const float dl=__builtin_ceilf(__builtin_fmaxf(rm,0.f)); mhat+=dl; \
        _Pragma("unroll") for(int r=0;r<16;++r){C0[r]-=dl;C1[r]-=dl;} \
        SETQX(); \
        const float f=__builtin_amdgcn_exp2f(-dl); l_reg*=f; if(hi==0)wsf[r32]=f; resc=true; } } \
    SBAR(); \
    GAPB(o[0]=__builtin_amdgcn_mfma_f32_32x32x16_bf16(PAF(0),VFR(0),o[0],0,0,0), C0,0); \
    GAPB(o[1]=__builtin_amdgcn_mfma_f32_32x32x16_bf16(PAF(0),VFR(4),o[1],0,0,0), C0,4); \
    KRD(GL,0); GAPB(o[0]=__builtin_amdgcn_mfma_f32_32x32x16_bf16(PAF(1),VFR(1),o[0],0,0,0), C0,8); \
    KRD(GL,1); GAPB(o[1]=__builtin_amdgcn_mfma_f32_32x32x16_bf16(PAF(1),VFR(5),o[1],0,0,0), C0,12); \
    KRD(GL,2); GAPB(o[0]=__builtin_amdgcn_mfma_f32_32x32x16_bf16(PAF(2),VFR(2),o[0],0,0,0), C1,0); \
    KRD(GL,3); GAPB(o[1]=__builtin_amdgcn_mfma_f32_32x32x16_bf16(PAF(2),VFR(6),o[1],0,0,0), C1,4); \
    if(GL){ kw0=ckp[((t)+1)*KVBLK+r32]; kw1=ckp[((t)+1)*KVBLK+32+r32]; SBAR(); } \
    GAPB(o[0]=__builtin_amdgcn_mfma_f32_32x32x16_bf16(PAF(3),VFR(3),o[0],0,0,0), C1,8); \
    GAPB(o[1]=__builtin_amdgcn_mfma_f32_32x32x16_bf16(PAF(3),VFR(7),o[1],0,0,0), C1,12); \
    }while(0)
  int t=1;
  #undef CMASK
  #define CMASK(P0,P1,t) do{}while(0)
  for(;t+5<NT;t+=2){
    STEP(pB0,pB1,pA0,pA1,t,true,true,true);     WAIT_BAR(2); RESC(); ROT();
    STEP(pA0,pA1,pB0,pB1,t+1,true,true,true);   WAIT_BAR(2); RESC(); ROT();
  }
  #undef CMASK
  #define CMASK(P0,P1,t) do{int jb_=(t)-(NT-4); if(jb_>=0)cmask(P0,P1,jb_,qrel,hi);}while(0)
  #define ENDW(tt) do{ if((tt)+3<NT){WAIT_BAR(2);} else if((tt)+2<NT){WAIT_BAR(1);} else {WAIT_BAR(0);} }while(0)
  for(;t+1<NT;t+=2){
    STEP(pB0,pB1,pA0,pA1,t,(t+3<NT),(t+1<NT),(t+1<NT));       ENDW(t);   RESC(); ROT();
    STEP(pA0,pA1,pB0,pB1,t+1,(t+4<NT),(t+2<NT),(t+2<NT));     ENDW(t+1); RESC(); ROT();
  }
  STEP(pB0,pB1,pA0,pA1,NT-1,false,false,false); RESC();
  { float sacc=pB0[0]+pB0[1]; _Pragma("unroll") for(int r=2;r<16;++r)sacc+=pB0[r]; _Pragma("unroll") for(int r=0;r<16;++r)sacc+=pB1[r]; l_reg+=sacc;
    pw0=(u32x4){PKW(pB0,0),PKW(pB0,2),PKW(pB0,4),PKW(pB0,6)};pw1=(u32x4){PKW(pB0,8),PKW(pB0,10),PKW(pB0,12),PKW(pB0,14)};pw2=(u32x4){PKW(pB1,0),PKW(pB1,2),PKW(pB1,4),PKW(pB1,6)};pw3=(u32x4){PKW(pB1,8),PKW(pB1,10),PKW(pB1,12),PKW(pB1,14)};
    SBAR(); pv(o,vb0+sl_cur,PAF(0),PAF(1),PAF(2),PAF(3)); }
  #undef PKW
  #undef PAF
  #undef VFR
  #undef PIN
  #undef MX3
  #undef GAPA
  #undef GAPB
  #undef EX
  #undef VRD
  #undef KRD
  #undef STEP
  #undef ENDW
  {auto rr=__builtin_amdgcn_permlane32_swap(__float_as_uint(l_reg),__float_as_uint(l_reg),false,false);l_reg=__uint_as_float(rr[0])+__uint_as_float(rr[1]);}
  if(hi==0)wsf[32+r32]=l_reg;asm volatile("s_waitcnt lgkmcnt(0)":::"memory");
  float rli[16];
  #pragma unroll
  for(int r=0;r<16;++r)rli[r]=__builtin_amdgcn_rcpf(wsf[32+crow(r,hi)]);
  bf16*Ow=O+(rowbase+q0+wid*QBLK)*DM+h*D;
  { bf16*stg=(bf16*)(shm+LDS_OST)+wid*2048;
    #pragma unroll
    for(int r=0;r<16;++r){const int orow=crow(r,hi);
      #pragma unroll
      for(int d0=0;d0<2;++d0)stg[orow*64+d0*32+r32]=__float2bfloat16(o[d0][r]*rli[r]);}
    asm volatile("s_waitcnt lgkmcnt(0)":::"memory");
    #pragma unroll
    for(int i=0;i<4;++i){const int row=i*8+(lane>>3),ch=lane&7; const u32x4 v=*(const u32x4*)(stg+row*64+ch*8); ATTN_STORE16(Ow+(long)row*DM+ch*8,v);} }
  asm volatile("s_waitcnt lgkmcnt(0)\n\ts_barrier":::"memory");
  #undef KX
  #undef KXW
  #undef SETQX
  #undef DMA_K
  #undef DMA_V
  #undef CMASK
  #undef START
  #undef RESC
  #undef ROT
}
constexpr int ATTN_LDS_BYTES=LDS_BYTES;
struct AttnTensors { const bf16* Q; const bf16* K; const bf16* V; bf16* O; };
struct AttnUnit { int bh; int qb; };
#undef SBAR
#undef WAIT_BAR
}
constexpr int NWAVES = 8;
constexpr int RING_OFF = 0, RING_BYTES = 131072;
constexpr int LDSCTL_OFF = RING_BYTES, MISC_OFF = LDSCTL_OFF + 320;
constexpr int LDS_BYTES = 147456;
static_assert(MISC_OFF + 128 <= LDS_BYTES, "LDS map");
constexpr int TAB_OFF = MISC_OFF + 128;
static_assert(TAB_OFF + 224 * 4 <= LDS_BYTES, "LDS map");
constexpr int CW_TMO = 0, CW_CODE = 1, CW_BAR = 4096, MAX_BAR_REGIONS = 8;

#define GAS __attribute__((address_space(1)))
#define LAS __attribute__((address_space(3)))
typedef short bf16x8 __attribute__((ext_vector_type(8)));
typedef GAS unsigned gu32;
#define RLX_AGENT __ATOMIC_RELAXED, __HIP_MEMORY_SCOPE_AGENT
#define LDS_WAIT() asm volatile("s_waitcnt lgkmcnt(0)" ::: "memory")
#define VM_WAIT() asm volatile("s_waitcnt vmcnt(0)" ::: "memory")

#define XB_TMO      128
#define XB_XCNT(j)  (256  + 64 * (j))
#define XB_XSUB(j)  (1280 + 64 * (j))
#define XB_XGEN(j)  (2304 + 64 * (j))
#define XB_TOP      3328
#define XB_TOPGEN   3392
#define XCD_BAR_WORDS 3456
#define XB_SPIN_CAP (1u << 18)

__device__ __forceinline__ unsigned xb_ld(unsigned* p)              { return __hip_atomic_load(p, __ATOMIC_RELAXED, __HIP_MEMORY_SCOPE_AGENT); }
__device__ __forceinline__ unsigned xb_add(unsigned* p, unsigned v) { return __hip_atomic_fetch_add(p, v, __ATOMIC_RELAXED, __HIP_MEMORY_SCOPE_AGENT); }
__device__ __forceinline__ unsigned xb_xcc_id() { return (unsigned)__builtin_amdgcn_s_getreg((3 << 11) | 20) & 0xFu; }
#define XB_SPIN(cond, bar) do { unsigned _sp = 0; while (cond) { __builtin_amdgcn_s_sleep(1); \
    if ((++_sp & 255u) == 0u) { if (xb_ld(&(bar)[XB_TMO])) break; if (_sp > XB_SPIN_CAP) { atomicAdd(&(bar)[XB_TMO], 1u); break; } } } } while (0)

struct XcdBarrier {
    unsigned* bar; unsigned x;
    volatile LAS unsigned* st;
};

__device__ __forceinline__ XcdBarrier xcd_barrier_post(unsigned* bar, volatile LAS unsigned* st) {
    XcdBarrier b; b.bar = bar; b.x = xb_xcc_id(); b.st = st;
    if (threadIdx.x == 0) (void)xb_add(&bar[XB_XCNT(b.x)], 1u);
    return b;
}
__device__ __forceinline__ void xcd_barrier_complete(unsigned* bar, unsigned x, unsigned& nloc, unsigned& nx) {
    const unsigned G = gridDim.x * gridDim.y * gridDim.z;
    unsigned sum, cnt, mine, sp = 0u;
    for (;;) {
        sum = 0u; cnt = 0u; mine = 0u;
#pragma unroll
        for (unsigned j = 0; j < 16; ++j) { const unsigned c = xb_ld(&bar[XB_XCNT(j)]); sum += c; cnt += (c > 0u) ? 1u : 0u; mine = (j == x) ? c : mine; }
        if (sum == G) break;
        __builtin_amdgcn_s_sleep(1);
        if ((++sp & 255u) == 0u) { if (xb_ld(&bar[XB_TMO])) break; if (sp > XB_SPIN_CAP) { atomicAdd(&bar[XB_TMO], 1u); break; } }
    }
    nloc = mine > 0u ? mine : 1u; nx = cnt > 0u ? cnt : 1u;
}

__device__ __forceinline__ void xcd_barrier(const XcdBarrier& b) {
    asm volatile("s_waitcnt vmcnt(0)" ::: "memory");
    __syncthreads();
    if (threadIdx.x == 0) {
        unsigned* bar = b.bar;
        __builtin_amdgcn_s_waitcnt(0);
        unsigned nloc = b.st[0], nx = b.st[1];
        if (nloc == 0u) { xcd_barrier_complete(bar, b.x, nloc, nx); b.st[0] = nloc; b.st[1] = nx; }
        const unsigned old = xb_add(&bar[XB_XSUB(b.x)], 1u);
        const unsigned gen = old / nloc;
        if (old + 1u == (gen + 1u) * nloc) {
            __builtin_amdgcn_fence(__ATOMIC_RELEASE, "agent");
            asm volatile("s_waitcnt vmcnt(0)" ::: "memory");
            const unsigned og = xb_add(&bar[XB_TOP], 1u);
            const unsigned tg = og / nx;
            if (og + 1u == (tg + 1u) * nx) xb_add(&bar[XB_TOPGEN], 1u);
            else XB_SPIN(xb_ld(&bar[XB_TOPGEN]) == tg, bar);
            __builtin_amdgcn_fence(__ATOMIC_ACQUIRE, "agent");
            xb_add(&bar[XB_XGEN(b.x)], 1u);
            asm volatile("s_waitcnt vmcnt(0)" ::: "memory");
        } else {
            XB_SPIN(xb_ld(&bar[XB_XGEN(b.x)]) == gen, bar);
            __builtin_amdgcn_fence(__ATOMIC_ACQUIRE, "agent");
            asm volatile("s_waitcnt vmcnt(0)" ::: "memory");
        }
    }
    __syncthreads();
}


struct Args {
    const float* in[25]; float* out; unsigned char* ws; int ph_lo, ph_hi, li, pad;
};
struct Frame {
    LAS unsigned char* lds; volatile LAS unsigned* MISC; gu32* ctl;
    int tid, lane, wave, vcu, G;
};

__device__ __forceinline__ void transpose_item(const float* Wsrc, int ld, bf16* dst, int Kd, LAS float* scr, int lane) {
#pragma unroll 8
    for (int i = 0; i < 32; ++i) { const int kk = 2 * i + (lane >> 5); scr[kk * 33 + (lane & 31)] = Wsrc[(size_t)kk * ld + (lane & 31)]; }
    LDS_WAIT(); asm volatile("" ::: "memory");
    const int c = lane & 7;
#pragma unroll
    for (int j = 0; j < 4; ++j) { const int n = (lane >> 3) + 8 * j; const LAS float* s = scr + (8 * c) * 33 + n;
        u32x4 o; o.x = pk2(s[0 * 33], s[1 * 33]); o.y = pk2(s[2 * 33], s[3 * 33]); o.z = pk2(s[4 * 33], s[5 * 33]); o.w = pk2(s[6 * 33], s[7 * 33]);
        *(GAS u32x4*)(dst + (size_t)n * Kd + 8 * c) = o; }
    LDS_WAIT(); asm volatile("" ::: "memory");
}
constexpr int P0_MODT = 96 * 16;
constexpr int P0_IWIN = 16 * 96, P0_IWOUT = 16 * 32, P0_IEXP = 768;
constexpr int P0_NTASK = P0_MODT + P0_IWIN + P0_IWOUT + NE * P0_IEXP;
__device__ __forceinline__ void p0_prologue(Frame& F, const Args& A) {
    LAS float* scr = (LAS float*)(F.lds + RING_OFF + F.wave * 16384);
    const int gw = F.vcu * NWAVES + F.wave, NGW = F.G * NWAVES, lane = F.lane;
    const float* c = A.in[1]; const float* ada_w = A.in[2]; const float* w_in = A.in[4]; const float* w_out = A.in[13];
    const float* w_gate = A.in[20]; const float* w_up = A.in[21]; const float* w_down = A.in[22];
    float* modp = (float*)(A.ws + WS_MODP);
    bf16* Win = (bf16*)(A.ws + WS_WIN); bf16* Wout = (bf16*)(A.ws + WS_WOUT); bf16* Wgu = (bf16*)(A.ws + WS_WGU); bf16* Wdn = (bf16*)(A.ws + WS_WDN);
    for (int it = gw; it < P0_NTASK; it += NGW) {
        int r = it;
        if (r < P0_MODT) {
            const int cg = r % 96, ks = r / 96;
            int sv[NB]; float acc[NB];
#pragma unroll
            for (int b = 0; b < NB; ++b) { sv[b] = __builtin_bit_cast(int, silu_f(c[b * D + ks * 64 + lane])); acc[b] = 0.f; }
            const float* wp = ada_w + (size_t)(ks * 64) * 6144 + cg * 64 + lane;
#pragma unroll 16
            for (int k = 0; k < 64; ++k) { const float w = wp[(size_t)k * 6144];
#pragma unroll
                for (int b = 0; b < NB; ++b) acc[b] += __builtin_bit_cast(float, __builtin_amdgcn_readlane(sv[b], k)) * w; }
#pragma unroll
            for (int b = 0; b < NB; ++b) modp[(size_t)(ks * NB + b) * 6144 + cg * 64 + lane] = acc[b];
            continue;
        }
        r -= P0_MODT;
        if (r < P0_IWIN) { const int kb = r / 96, nb = r % 96, n0 = 32 * nb, src0 = n0 + (n0 >= 1536 ? 8 : 0);
            transpose_item(w_in + (size_t)(64 * kb) * DIN + src0, DIN, Win + (size_t)n0 * D + 64 * kb, D, scr, lane); continue; }
        r -= P0_IWIN;
        if (r < P0_IWOUT) { const int kb = r / 32, nb = r % 32;
            transpose_item(w_out + (size_t)(64 * kb) * D + 32 * nb, D, Wout + (size_t)(32 * nb) * D + 64 * kb, D, scr, lane); continue; }
        r -= P0_IWOUT;
        const int e = r / P0_IEXP, q = r % P0_IEXP;
        if (q < 512) {
            const int up = q >> 8, qq = q & 255, kb = qq / 16, nb = qq % 16; const float* W = (up ? w_up : w_gate) + (size_t)e * D * DE;
            transpose_item(W + (size_t)(64 * kb) * DE + 32 * nb, DE, Wgu + ((size_t)e * 1024 + 256 * (nb / 4) + 32 * (nb % 4) + 128 * up) * D + 64 * kb, D, scr, lane);
        } else {
            const int qq = q - 512, kb = qq / 32, nb = qq % 32;
            transpose_item(w_down + (size_t)e * DE * D + (size_t)(64 * kb) * D + 32 * nb, D, Wdn + ((size_t)e * 1024 + 32 * nb) * DE + 64 * kb, DE, scr, lane);
        }
    }
}
constexpr int W16P = 1028;
__device__ __forceinline__ void p1_modulate(Frame& F, const Args& A) {
    const float* x = A.in[0]; const float* ada_b = A.in[3]; const float* w_in = A.in[4];
    const float* modp = (const float*)(A.ws + WS_MODP); float* mod = (float*)(A.ws + WS_MOD); float* dtf = (float*)(A.ws + WS_DTF); bf16* U = (bf16*)(A.ws + WS_A);
    LAS float* sh1 = (LAS float*)(F.lds + RING_OFF); LAS float* sc1 = sh1 + 1024; LAS float* W16 = sc1 + 1024;
    const int tid = F.tid, lane = F.lane;
    for (int idx = F.vcu * 512 + tid; idx < NB * 6144; idx += F.G * 512) { const int b = idx / 6144, j = idx % 6144; float s = ada_b[j];
        for (int ks = 0; ks < 16; ++ks) s += modp[(size_t)(ks * NB + b) * 6144 + j];
        mod[idx] = s; }
    for (int e = tid; e < 16 * 1024; e += 512) { const int k = e >> 4, j = e & 15; W16[j * W16P + k] = w_in[(size_t)k * DIN + (j < 8 ? 1536 + j : 3080 + (j - 8))]; }
    for (int rb = F.vcu; rb < M / 64; rb += F.G) {
    const int row0 = rb * 64, bb = row0 / T;
    __syncthreads();
    for (int j = tid; j < 2048; j += 512) { float s = ada_b[j];
        for (int ks = 0; ks < 16; ++ks) s += modp[(size_t)(ks * NB + bb) * 6144 + j];
        if (j < 1024) sh1[j] = s; else sc1[j - 1024] = 1.f + s; }
    LDS_WAIT(); __syncthreads();
    for (int rp = 0; rp < 4; ++rp) {
        const int r0 = row0 + F.wave * 8 + rp * 2;
        f32x4 u0[4], u1[4];
#pragma unroll
        for (int j = 0; j < 4; ++j) { const int cidx = 4 * lane + 256 * j; const f32x4 s = *(const LAS f32x4*)(sc1 + cidx), h = *(const LAS f32x4*)(sh1 + cidx);
            u0[j] = *(const f32x4*)(x + (size_t)r0 * D + cidx) * s + h; u1[j] = *(const f32x4*)(x + (size_t)(r0 + 1) * D + cidx) * s + h;
            u32x2 p0, p1; p0.x = pk2(u0[j][0], u0[j][1]); p0.y = pk2(u0[j][2], u0[j][3]); p1.x = pk2(u1[j][0], u1[j][1]); p1.y = pk2(u1[j][2], u1[j][3]);
            *(u32x2*)(U + (size_t)r0 * D + cidx) = p0; *(u32x2*)(U + (size_t)(r0 + 1) * D + cidx) = p1; }
        float o0 = 0.f, o1 = 0.f;
#pragma unroll 2
        for (int j16 = 0; j16 < 16; ++j16) { float a0 = 0.f, a1 = 0.f;
#pragma unroll
            for (int j = 0; j < 4; ++j) { const f32x4 w = *(const LAS f32x4*)(W16 + j16 * W16P + 4 * lane + 256 * j);
                a0 += (u0[j][0] * w[0] + u0[j][1] * w[1]) + (u0[j][2] * w[2] + u0[j][3] * w[3]); a1 += (u1[j][0] * w[0] + u1[j][1] * w[1]) + (u1[j][2] * w[2] + u1[j][3] * w[3]); }
            a0 = wave_sum(a0); a1 = wave_sum(a1); if (lane == j16) { o0 = a0; o1 = a1; } }
        if (lane < 16) { dtf[(size_t)r0 * 16 + lane] = o0; dtf[(size_t)(r0 + 1) * 16 + lane] = o1; }
    }
    }
}

__device__ __forceinline__ void p_conv(Frame& F, const Args& A, float* xact) {
    const bf16* proj = (const bf16*)(A.ws + WS_B); const float* cw = A.in[5]; const float* cb = A.in[6];
    const int gt = F.vcu * 512 + F.tid, NT = F.G * 512;
    for (int i = gt; i < M * (DXBC / 4); i += NT) { const int m = i >> 8, c4 = (i & 255) * 4, t = m % T;
        f32x4 acc = *(const f32x4*)(cb + c4);
#pragma unroll
        for (int j = 0; j < 4; ++j) { const int tt = t - 3 + j; if (tt >= 0) { const u32x2 r = *(const u32x2*)(proj + (size_t)(m - 3 + j) * PW + PC_XS + c4); const f32x4 w = *(const f32x4*)(cw + j * DXBC + c4);
            acc[0] += w[0] * bf2f(r.x); acc[1] += w[1] * bf2f(r.x >> 16); acc[2] += w[2] * bf2f(r.y); acc[3] += w[3] * bf2f(r.y >> 16); } }
        f32x4 o; o[0] = silu_f(acc[0]); o[1] = silu_f(acc[1]); o[2] = silu_f(acc[2]); o[3] = silu_f(acc[3]);
        *(f32x4*)(xact + (size_t)m * DXBC + c4) = o; }
}
__device__ __forceinline__ void p_ssd_seq(Frame& F, const Args& A, const float* xact, float* ypre, int bh) {
    const float* dtf = (const float*)(A.ws + WS_DTF);
    const int b = bh / NH, h = bh % NH, g = h / 4, p = F.tid >> 3, nq = F.tid & 7;
    const float Ah = -expf(A.in[8][h]), Dh = A.in[9][h], dtb = A.in[7][h];
    float st[16];
#pragma unroll
    for (int i = 0; i < 16; ++i) st[i] = 0.f;
    for (int t = 0; t < T; ++t) {
        const size_t m = (size_t)b * T + t;
        const float dtv = softplus_f(dtf[m * 16 + h] + dtb), dA = expf(dtv * Ah);
        const float xv = xact[m * DXBC + h * 64 + p], xd = xv * dtv;
        const f32x4* Bp = (const f32x4*)(xact + m * DXBC + 512 + g * 128 + nq * 16);
        const f32x4* Cp = (const f32x4*)(xact + m * DXBC + 768 + g * 128 + nq * 16);
        float y = 0.f;
#pragma unroll
        for (int i = 0; i < 4; ++i) { const f32x4 bv = Bp[i], cv = Cp[i];
#pragma unroll
            for (int j = 0; j < 4; ++j) { st[i * 4 + j] = dA * st[i * 4 + j] + xd * bv[j]; y += cv[j] * st[i * 4 + j]; } }
        y += __shfl_xor(y, 1); y += __shfl_xor(y, 2); y += __shfl_xor(y, 4);
        if (nq == 0) ypre[m * DSSM + h * 64 + p] = y + Dh * xv;
    }
}
__device__ __forceinline__ void p_attn_norm(Frame& F, const Args& A) {
    const bf16* proj = (const bf16*)(A.ws + WS_B); bf16* ycat = (bf16*)(A.ws + WS_A); const float* ng = A.in[12];
    const int gw = F.vcu * NWAVES + F.wave, NGW = F.G * NWAVES, lane = F.lane;
    const f32x4 g0 = *(const f32x4*)(ng + lane * 8), g1 = *(const f32x4*)(ng + lane * 8 + 4);
    for (int m = gw; m < M; m += NGW) {
        const u32x4 r = *(const u32x4*)(proj + (size_t)m * PW + PC_Q + lane * 8);
        float v[8] = {bf2f(r.x), bf2f(r.x >> 16), bf2f(r.y), bf2f(r.y >> 16), bf2f(r.z), bf2f(r.z >> 16), bf2f(r.w), bf2f(r.w >> 16)}; float ss = 0.f;
#pragma unroll
        for (int j = 0; j < 8; ++j) ss += v[j] * v[j];
        const float rs = 1.f / sqrtf(wave_sum(ss) * (1.f / 512.f) + EPS);
        u32x4 o; o.x = pk2(v[0] * rs * g0[0], v[1] * rs * g0[1]); o.y = pk2(v[2] * rs * g0[2], v[3] * rs * g0[3]); o.z = pk2(v[4] * rs * g1[0], v[5] * rs * g1[1]); o.w = pk2(v[6] * rs * g1[2], v[7] * rs * g1[3]);
        *(u32x4*)(ycat + (size_t)m * D + 512 + lane * 8) = o; }
}
__device__ __forceinline__ void p_ssm_norm(Frame& F, const Args& A, const float* ypre) {
    const bf16* proj = (const bf16*)(A.ws + WS_B); bf16* ycat = (bf16*)(A.ws + WS_A); const float* ng = A.in[10];
    const int gw = F.vcu * NWAVES + F.wave, NGW = F.G * NWAVES, lane = F.lane;
    for (int w = gw; w < M * 2; w += NGW) { const int m = w >> 1, g = w & 1, c = g * 256 + lane * 4;
        const f32x4 y = *(const f32x4*)(ypre + (size_t)m * DSSM + c), gg = *(const f32x4*)(ng + c); const u32x2 z = *(const u32x2*)(proj + (size_t)m * PW + PC_Z + c);
        float v[4] = {y[0] * silu_f(bf2f(z.x)), y[1] * silu_f(bf2f(z.x >> 16)), y[2] * silu_f(bf2f(z.y)), y[3] * silu_f(bf2f(z.y >> 16))};
        const float rs = 1.f / sqrtf(wave_sum((v[0] * v[0] + v[1] * v[1]) + (v[2] * v[2] + v[3] * v[3])) * (1.f / 256.f) + EPS);
        u32x2 o; o.x = pk2(v[0] * rs * gg[0], v[1] * rs * gg[1]); o.y = pk2(v[2] * rs * gg[2], v[3] * rs * gg[3]);
        *(u32x2*)(ycat + (size_t)m * D + c) = o; }
}
__device__ __forceinline__ void p_ln1_router(Frame& F, const Args& A) {
    const float* x = A.in[0]; float* hx1 = A.out; const float* mod = (const float*)(A.ws + WS_MOD); const float* g1 = A.in[14]; const float* b1 = A.in[15];
    const float* rgw = A.in[16]; const float* rgb = A.in[17]; const float* rew = A.in[18]; const float* reb = A.in[19];
    bf16* u2 = (bf16*)(A.ws + WS_B); unsigned* cnt = (unsigned*)(A.ws + WS_CTL) + CW_CNT; int* list = (int*)(A.ws + WS_LIST); float* tokw = (float*)(A.ws + WS_TOKW);
    const int lane = F.lane; LAS f32x4* ub = (LAS f32x4*)(F.lds + RING_OFF + F.wave * 16384);
    const int gw = F.vcu * NWAVES + F.wave, NGW = F.G * NWAVES;
    for (int m0 = gw * 4; m0 < M; m0 += NGW * 4) {
        const float* mb = mod + (m0 / T) * 6144;
        float u[4][16]; float gl[4][4];
#pragma unroll
        for (int r = 0; r < 4; ++r) { const int m = m0 + r;
            float v[16]; float s = 0.f;
#pragma unroll
            for (int j = 0; j < 4; ++j) { const int c = 4 * lane + 256 * j; const f32x4 xv = *(const f32x4*)(x + (size_t)m * D + c), hv = *(const f32x4*)(hx1 + (size_t)m * D + c), gt = *(const f32x4*)(mb + 2 * D + c);
#pragma unroll
                for (int i = 0; i < 4; ++i) { v[j * 4 + i] = ALPHA * xv[i] + (1.f + gt[i]) * hv[i]; s += v[j * 4 + i]; } }
            const float mean = wave_sum(s) * (1.f / D); float s2 = 0.f;
#pragma unroll
            for (int i = 0; i < 16; ++i) { v[i] -= mean; s2 += v[i] * v[i]; }
            const float rstd = 1.f / sqrtf(wave_sum(s2) * (1.f / D) + EPS);
            float ga[4] = {0.f, 0.f, 0.f, 0.f};
#pragma unroll
            for (int j = 0; j < 4; ++j) { const int c = 4 * lane + 256 * j; const f32x4 gg = *(const f32x4*)(g1 + c), bb = *(const f32x4*)(b1 + c), sc = *(const f32x4*)(mb + 4 * D + c), sh = *(const f32x4*)(mb + 3 * D + c);
                f32x4 x1;
#pragma unroll
                for (int i = 0; i < 4; ++i) { x1[i] = v[j * 4 + i] * rstd * gg[i] + bb[i]; u[r][j * 4 + i] = x1[i] * (1.f + sc[i]) + sh[i]; }
                *(f32x4*)(hx1 + (size_t)m * D + c) = x1;
                u32x2 pk; pk.x = pk2(u[r][j * 4], u[r][j * 4 + 1]); pk.y = pk2(u[r][j * 4 + 2], u[r][j * 4 + 3]); *(u32x2*)(u2 + (size_t)m * D + c) = pk;
#pragma unroll
                for (int i = 0; i < 4; ++i) { const f32x4 wg = *(const f32x4*)(rgw + (size_t)(c + i) * 4);
#pragma unroll
                    for (int q = 0; q < 4; ++q) ga[q] += u[r][j * 4 + i] * wg[q]; } }
#pragma unroll
            for (int q = 0; q < 4; ++q) gl[r][q] = wave_sum(ga[q]) + rgb[q];
        }
#pragma unroll
        for (int j = 0; j < 4; ++j)
#pragma unroll
            for (int i = 0; i < 4; ++i) ub[i * 256 + j * 64 + lane] = (f32x4){u[0][j * 4 + i], u[1][j * 4 + i], u[2][j * 4 + i], u[3][j * 4 + i]};
        LDS_WAIT(); asm volatile("" ::: "memory");
        f32x4 acc = {0.f, 0.f, 0.f, 0.f};
        { const int jx = lane & 31, half = lane >> 5;
          for (int i2 = 0; i2 < 2; ++i2) { const int i = half * 2 + i2;
            for (int jj = 0; jj < 4; ++jj) { const float* wp = rew + (size_t)(256 * jj + i) * 32 + jx; const LAS f32x4* up = ub + i * 256 + jj * 64;
#pragma unroll 8
                for (int l = 0; l < 64; ++l) { const float w = wp[(size_t)l * 128]; const f32x4 uv = up[l]; acc[0] += w * uv[0]; acc[1] += w * uv[1]; acc[2] += w * uv[2]; acc[3] += w * uv[3]; } } } }
#pragma unroll
        for (int r = 0; r < 4; ++r) acc[r] += __shfl_xor(acc[r], 32);
        LDS_WAIT(); asm volatile("" ::: "memory");
#pragma unroll
        for (int r = 0; r < 4; ++r) { const int m = m0 + r;
            float mx = gl[r][0]; int gi = 0;
#pragma unroll
            for (int i = 1; i < 4; ++i) if (gl[r][i] > mx) { mx = gl[r][i]; gi = i; }
            float se = 0.f;
#pragma unroll
            for (int i = 0; i < 4; ++i) se += expf(gl[r][i] - mx);
            const float gp = 1.f / se;
            const float mine = acc[r] + reb[lane & 31];
            float pe[8]; float mxe = -INFINITY;
#pragma unroll
            for (int i = 0; i < 8; ++i) { pe[i] = __shfl(mine, gi * 8 + i); mxe = fmaxf(mxe, pe[i]); }
#pragma unroll
            for (int i = 0; i < 8; ++i) pe[i] = expf(pe[i] - mxe);
            int i1 = 0; float p1 = -1.f;
#pragma unroll
            for (int i = 0; i < 8; ++i) if (pe[i] > p1) { p1 = pe[i]; i1 = i; }
            int i2 = 0; float p2 = -1.f;
#pragma unroll
            for (int i = 0; i < 8; ++i) if (i != i1 && pe[i] > p2) { p2 = pe[i]; i2 = i; }
            const float inv = 1.f / (p1 + p2);
            if (lane == 0) {
                const int e0 = gi * 8 + i1, e1 = gi * 8 + i2;
                const unsigned q0 = atomicAdd(&cnt[e0], 1u), q1 = atomicAdd(&cnt[e1], 1u);
                list[e0 * LCAP + q0] = m * 2; list[e1 * LCAP + q1] = m * 2 + 1;
                tokw[m * 2] = gp * p1 * inv; tokw[m * 2 + 1] = gp * p2 * inv;
            }
        }
    }
}
__device__ __forceinline__ void p_final(Frame& F, const Args& A) {
    float* out = A.out; const float* mod = (const float*)(A.ws + WS_MOD); const bf16* yk0 = (const bf16*)(A.ws + WS_A); const bf16* yk1 = (const bf16*)(A.ws + WS_YK1);
    const float* tokw = (const float*)(A.ws + WS_TOKW); const float* g2 = A.in[23]; const float* b2 = A.in[24];
    const int gw = F.vcu * NWAVES + F.wave, NGW = F.G * NWAVES, lane = F.lane;
    for (int m = gw; m < M; m += NGW) {
        const float* mb = mod + (m / T) * 6144; const float w0 = tokw[m * 2], w1 = tokw[m * 2 + 1];
        float v[16]; float s = 0.f;
#pragma unroll
        for (int j = 0; j < 4; ++j) { const int c = 4 * lane + 256 * j; const f32x4 xv = *(const f32x4*)(out + (size_t)m * D + c), gt = *(const f32x4*)(mb + 5 * D + c);
            const u32x2 a = *(const u32x2*)(yk0 + (size_t)m * D + c), bq = *(const u32x2*)(yk1 + (size_t)m * D + c);
            const float y0[4] = {bf2f(a.x), bf2f(a.x >> 16), bf2f(a.y), bf2f(a.y >> 16)}, y1[4] = {bf2f(bq.x), bf2f(bq.x >> 16), bf2f(bq.y), bf2f(bq.y >> 16)};
#pragma unroll
            for (int i = 0; i < 4; ++i) { v[j * 4 + i] = ALPHA * xv[i] + (1.f + gt[i]) * (w0 * y0[i] + w1 * y1[i]); s += v[j * 4 + i]; } }
        const float mean = wave_sum(s) * (1.f / D); float s2 = 0.f;
#pragma unroll
        for (int i = 0; i < 16; ++i) { v[i] -= mean; s2 += v[i] * v[i]; }
        const float rstd = 1.f / sqrtf(wave_sum(s2) * (1.f / D) + EPS);
#pragma unroll
        for (int j = 0; j < 4; ++j) { const int c = 4 * lane + 256 * j; const f32x4 gg = *(const f32x4*)(g2 + c), bb = *(const f32x4*)(b2 + c); f32x4 o;
#pragma unroll
            for (int i = 0; i < 4; ++i) o[i] = v[j * 4 + i] * rstd * gg[i] + bb[i];
            *(f32x4*)(out + (size_t)m * D + c) = o; }
    }
}

__global__ void __launch_bounds__(NWAVES * 64, 2) mk_fwd(Args args) {
    extern __shared__ __attribute__((aligned(16))) unsigned char lds[];
    Frame F;
    F.lds = (LAS unsigned char*)lds; F.MISC = (volatile LAS unsigned*)(F.lds + MISC_OFF);
    F.tid = threadIdx.x; F.lane = F.tid & 63; F.wave = __builtin_amdgcn_readfirstlane(F.tid >> 6);
    F.G = gridDim.x; { const int bx = blockIdx.x; F.vcu = (F.G % 8 == 0) ? (bx % 8) * (F.G / 8) + bx / 8 : bx; }
    F.ctl = (gu32*)(args.ws + WS_CTL);
    for (int u = F.tid; u < (LDS_BYTES - LDSCTL_OFF) / 4; u += NWAVES * 64) ((LAS unsigned*)(F.lds + LDSCTL_OFF))[u] = 0u;
    __syncthreads();
    XcdBarrier bar = xcd_barrier_post((unsigned*)(F.ctl + CW_BAR) + args.li * XCD_BAR_WORDS, F.MISC + 8);
    const int lo = args.ph_lo, hi = args.ph_hi;
#define IN(k) (lo <= (k) && (k) < hi)
#define BOTH(k) (IN(k) && IN((k) + 1))
#define GRID_BAR() xcd_barrier(bar)

    if (IN(0)) { p0_prologue(F, args); if (BOTH(0)) GRID_BAR(); }
    if (IN(1)) { p1_modulate(F, args); __syncthreads(); if (BOTH(1)) GRID_BAR(); }
    if (IN(2)) {
        pg8::Gemm g{(const bf16*)(args.ws + WS_A), (const bf16*)(args.ws + WS_WIN), D};
        pg8::StaticOrder S; S.init(M, PW, D, F.G, (int)blockIdx.x);
        pg8::EpiProj E{(bf16*)(args.ws + WS_B), PW, PC_Q, PC_K, QSCALE};
        pg8::gemm_phase<pg8::EpiProj, pg8::StaticOrder, true>(F.lds + RING_OFF, g, S, E);
        if (BOTH(2)) GRID_BAR();
    }
    if (IN(3)) {
        using namespace attn_body;
        char* shm = (char*)lds + RING_OFF;
        const float* dtf = (const float*)(args.ws + WS_DTF); const float* fg_bias = args.in[11];
        const attn_body::bf16* P = (const attn_body::bf16*)(args.ws + WS_B);
        LAS float* ckf = (LAS float*)(F.lds + RING_OFF + LDS_CKF); LAS float* wsum = (LAS float*)(F.lds + RING_OFF + LDS_WS);
        if (F.vcu < NB * NH * 4) {
            const int p = F.vcu; const int bh = p >> 2, s = p & 3, b = bh / NH, h = bh % NH;
            {
                const float fb = fg_bias[h]; float v[4]; float run = 0.f;
#pragma unroll
                for (int i = 0; i < 4; ++i) { const float f = dtf[(size_t)(b * T + F.tid * 4 + i) * 16 + 8 + h] + fb; run += -softplus_f(-f); v[i] = run; }
                float incl = run; int ln = F.lane; asm volatile("" : "+v"(ln));
#pragma unroll
                for (int o = 1; o < 64; o <<= 1) { const float t = __builtin_bit_cast(float, __builtin_amdgcn_ds_bpermute((ln - o) << 2, __builtin_bit_cast(int, incl))); if (ln >= o) incl += t; }
                if (ln == 63) wsum[F.wave] = incl;
                LDS_WAIT(); __syncthreads();
                float off = incl - run;
                for (int w = 0; w < F.wave; ++w) off += wsum[w];
#pragma unroll
                for (int i = 0; i < 4; ++i) ckf[F.tid * 4 + i] = v[i] + off;
                LDS_WAIT(); __syncthreads();
            }
            for (int j = 0; j < 2; ++j) attn_unit<8>(b, h, j ? s : 7 - s, P + PC_Q, P + PC_K, P + PC_V, (attn_body::bf16*)(args.ws + WS_B) + PC_Q, shm);
        }
        p_conv(F, args, args.out);
        __syncthreads();
        if (BOTH(3)) GRID_BAR();
    }
    if (IN(4)) {
        if (F.vcu < NB * NH) p_ssd_seq(F, args, args.out, (float*)(args.ws + WS_YK1), F.vcu);
        else { Frame F2 = F; F2.vcu = F.vcu - NB * NH; F2.G = F.G - NB * NH; p_attn_norm(F2, args); }
        if (BOTH(4)) GRID_BAR();
    }
    if (IN(5)) { p_ssm_norm(F, args, (const float*)(args.ws + WS_YK1)); if (BOTH(5)) GRID_BAR(); }
    if (IN(6)) {
        pg8::Gemm g{(const bf16*)(args.ws + WS_A), (const bf16*)(args.ws + WS_WOUT), D};
        pg8::StaticOrder S; S.init(M, D, D, F.G, (int)blockIdx.x);
        pg8::EpiF32 E{args.out, D};
        pg8::gemm_phase<pg8::EpiF32, pg8::StaticOrder, false>(F.lds + RING_OFF, g, S, E);
        if (BOTH(6)) GRID_BAR();
    }
    if (IN(7)) { p_ln1_router(F, args); if (BOTH(7)) GRID_BAR(); }
    if (IN(8) || IN(9)) {
        LAS unsigned* tab = (LAS unsigned*)(F.lds + TAB_OFF); LAS unsigned* cnts = tab + 192;
        if (F.tid < NE) cnts[F.tid] = __hip_atomic_load(F.ctl + CW_CNT + F.tid, RLX_AGENT);
        LDS_WAIT(); __syncthreads();
        if (F.tid == 0) { int nt = 0; for (int e = 0; e < NE; ++e) { const int n = (int)cnts[e]; for (int r0 = 0; r0 < n && nt < 160; r0 += 256) tab[nt++] = (unsigned)e | ((unsigned)r0 << 8); } tab[191] = (unsigned)nt; }
        LDS_WAIT(); __syncthreads();
    }
    if (IN(8)) {
        const LAS unsigned* tab = (const LAS unsigned*)(F.lds + TAB_OFF);
        pg8::Gemm g{(const bf16*)(args.ws + WS_B), (const bf16*)(args.ws + WS_WGU), D};
        pg8::MoeOrder S{tab, tab + 192, (int)tab[191], F.G, (int)blockIdx.x, 0, (const int*)(args.ws + WS_LIST)};
        pg8::EpiMoe1 E{(bf16*)(args.ws + WS_B + 32 * MiB), DE};
        pg8::gemm_phase<pg8::EpiMoe1, pg8::MoeOrder, true>(F.lds + RING_OFF, g, S, E);
        if (BOTH(8)) GRID_BAR();
    }
    if (IN(9)) {
        const LAS unsigned* tab = (const LAS unsigned*)(F.lds + TAB_OFF);
        pg8::Gemm g{(const bf16*)(args.ws + WS_B + 32 * MiB), (const bf16*)(args.ws + WS_WDN), DE};
        pg8::MoeOrder S{tab, tab + 192, (int)tab[191], F.G, (int)blockIdx.x, 1, (const int*)(args.ws + WS_LIST)};
        pg8::EpiMoe2 E{(bf16*)(args.ws + WS_A), (long)(WS_YK1 - WS_A), D, (const int*)(args.ws + WS_LIST)};
        pg8::gemm_phase<pg8::EpiMoe2, pg8::MoeOrder, true>(F.lds + RING_OFF, g, S, E);
        if (BOTH(9)) GRID_BAR();
    }
    if (IN(10)) { p_final(F, args); }
#undef IN
#undef BOTH
}

static void launch_mk(const Args& base, int lo, int hi, int li, int grid, hipStream_t stream) {
    Args a = base; a.ph_lo = lo; a.ph_hi = hi; a.li = li; a.pad = 0;
    hipLaunchKernelGGL(mk_fwd, dim3(grid), dim3(NWAVES * 64), LDS_BYTES, stream, a);
    const hipError_t le = hipPeekAtLastError();
    if (le != hipSuccess) fprintf(stderr, "kernel_launch: launch [%d,%d) failed: %s\n", lo, hi, hipGetErrorName(le));
}
extern "C" void kernel_launch(void* const* d_in, const int* in_sizes, int n_in, void* d_out, int out_size, void* d_ws, size_t ws_size, hipStream_t stream) {
    static int grid = 0;
    if (grid == 0) {
        if (n_in != 25 || in_sizes[0] != M * D || out_size != M * D || ws_size < WS_END) { fprintf(stderr, "kernel_launch: unexpected shapes / workspace (%zu)\n", ws_size); grid = -1; return; }
        int dev = 0, cus = 0;
        if (hipGetDevice(&dev) != hipSuccess || hipDeviceGetAttribute(&cus, hipDeviceAttributeMultiprocessorCount, dev) != hipSuccess) { grid = -1; return; }
        if (hipFuncSetAttribute((const void*)mk_fwd, hipFuncAttributeMaxDynamicSharedMemorySize, LDS_BYTES) != hipSuccess) { fprintf(stderr, "kernel_launch: hipFuncSetAttribute failed\n"); grid = -1; return; }
        (void)hipGetLastError();
        grid = cus;
    }
    if (grid < 0) return;
    const float* x = (const float*)d_in[0];
    const float* conv_w = (const float*)d_in[5]; const float* conv_b = (const float*)d_in[6]; const float* dt_bias = (const float*)d_in[7];
    const float* a_log = (const float*)d_in[8]; const float* d_skip = (const float*)d_in[9]; const float* ssm_ng = (const float*)d_in[10]; const float* fg_bias = (const float*)d_in[11];
    const float* att_ng = (const float*)d_in[12]; const float* w_out = (const float*)d_in[13]; const float* ln1_g = (const float*)d_in[14]; const float* ln1_b = (const float*)d_in[15];
    const float* rgw = (const float*)d_in[16]; const float* rgb = (const float*)d_in[17]; const float* rew = (const float*)d_in[18]; const float* reb = (const float*)d_in[19];
    const float* w_gate = (const float*)d_in[20]; const float* w_up = (const float*)d_in[21]; const float* w_down = (const float*)d_in[22]; const float* ln2_g = (const float*)d_in[23]; const float* ln2_b = (const float*)d_in[24];
    unsigned char* ws = (unsigned char*)d_ws; float* out = (float*)d_out;
    unsigned* ctl = (unsigned*)(ws + WS_CTL); unsigned* cnt = ctl + CW_CNT;
    float* mod = (float*)(ws + WS_MOD); float* dtf = (float*)(ws + WS_DTF); float* ck = (float*)(ws + WS_CK);
    int* toke = (int*)(ws + WS_TOKE); float* tokw = (float*)(ws + WS_TOKW); int* toks = (int*)(ws + WS_TOKS); int* list = (int*)(ws + WS_LIST);
    bf16* proj = (bf16*)(ws + WS_B); bf16* ycat = (bf16*)(ws + WS_A); bf16* u2 = (bf16*)(ws + WS_B); bf16* hmid = (bf16*)(ws + WS_B + 32 * MiB);
    bf16* yk0 = (bf16*)(ws + WS_A); bf16* yk1 = (bf16*)(ws + WS_YK1); float* ypre = (float*)(ws + WS_YK1); float* xact = out;

    if (hipMemsetAsync(ws + WS_CTL, 0, CTL_ZERO_BYTES, stream) != hipSuccess) return;
    Args a{};
    for (int i = 0; i < 25; ++i) a.in[i] = (const float*)d_in[i];
    a.out = out; a.ws = ws;
    launch_mk(a, 0, 11, 0, grid, stream);
}
```

```cpp
#include <hip/hip_runtime.h>
#include <cstdio>
#include <cstdint>

constexpr int NB = 8, T = 2048, D = 1024, M = NB * T;
constexpr int DSSM = 512, DATT = 512, HD = 64, NH = 8, NG = 2, NST = 128, DXBC = 1024, DIN = 3088;
constexpr int NE = 32, DE = 512, LCAP = 16384;
constexpr int PW = 3072;
constexpr int PC_Z = 0, PC_XS = 512, PC_Q = 1536, PC_K = 2048, PC_V = 2560;
constexpr float ALPHA = 1.189207115002721f;
constexpr float EPS = 1e-5f;
constexpr float LOG2E = 1.4426950408889634f;
constexpr float QSCALE = 0.125f * LOG2E;
constexpr int MAXSLOT = 160 * 256;

constexpr size_t MiB = 1u << 20;
constexpr size_t WS_CTL = 0, CTL_ZERO_BYTES = 1 * MiB;
constexpr size_t WS_WIN = 1 * MiB, WS_WOUT = 7 * MiB, WS_WGU = 9 * MiB, WS_WDN = 73 * MiB;
constexpr size_t WS_A = 105 * MiB;
constexpr size_t WS_B = 137 * MiB;
constexpr size_t WS_YK1 = 233 * MiB;
constexpr size_t WS_MISC = 265 * MiB;
constexpr size_t WS_MOD = WS_MISC;
constexpr size_t WS_DTF = WS_MISC + 1 * MiB;
constexpr size_t WS_CK = WS_MISC + 2 * MiB;
constexpr size_t WS_TOKE = WS_MISC + 3 * MiB;
constexpr size_t WS_TOKW = WS_TOKE + 256 * 1024;
constexpr size_t WS_TOKS = WS_TOKW + 256 * 1024;
constexpr size_t WS_LIST = WS_MISC + 4 * MiB;
constexpr size_t WS_MODP = WS_YK1;
constexpr size_t WS_END = 272 * MiB;
constexpr int CW_CNT = 1024;

typedef unsigned short bf16;
typedef float f32x4 __attribute__((ext_vector_type(4)));
typedef unsigned u32x4 __attribute__((ext_vector_type(4)));
typedef unsigned u32x2 __attribute__((ext_vector_type(2)));

__device__ __forceinline__ unsigned f2bf(float f) { unsigned u = __builtin_bit_cast(unsigned, f); return (u + 0x7fffu + ((u >> 16) & 1u)) >> 16; }
__device__ __forceinline__ float bf2f(unsigned b) { return __builtin_bit_cast(float, (b & 0xffffu) << 16); }
__device__ __forceinline__ unsigned pk2(float lo, float hi) { return f2bf(lo) | (f2bf(hi) << 16); }
__device__ __forceinline__ float silu_f(float x) { return x / (1.f + expf(-x)); }
__device__ __forceinline__ float softplus_f(float x) { return fmaxf(x, 0.f) + log1pf(expf(-fabsf(x))); }
__device__ __forceinline__ float wave_sum(float v) {
#pragma unroll
    for (int o = 1; o < 64; o <<= 1) v += __shfl_xor(v, o);
    return v;
}

namespace nv {
__global__ void __launch_bounds__(256) k_mod(const float* c, const float* ada_w, const float* ada_b, float* mod) {
    const int j = blockIdx.x * 256 + threadIdx.x;
    __shared__ float sc[NB][D];
    for (int i = threadIdx.x; i < NB * D; i += 256) sc[i / D][i % D] = silu_f(c[i]);
    __syncthreads();
    float acc[NB];
#pragma unroll
    for (int b = 0; b < NB; ++b) acc[b] = 0.f;
    for (int k = 0; k < D; ++k) { const float w = ada_w[(size_t)k * 6144 + j];
#pragma unroll
        for (int b = 0; b < NB; ++b) acc[b] += sc[b][k] * w; }
#pragma unroll
    for (int b = 0; b < NB; ++b) mod[b * 6144 + j] = acc[b] + ada_b[j];
}

template <bool DUAL, class Ctx>
__global__ void __launch_bounds__(256) k_gemm(Ctx cx) {
    __shared__ float As[16][68], Bs[16][68], Bs2[DUAL ? 16 : 1][68];
    __shared__ int s_info[4];
    if (!cx.setup(s_info)) return;
    __syncthreads();
    const int tm = blockIdx.y * 64, tn = blockIdx.x * 64, tid = threadIdx.x, tx = tid & 15, ty = tid >> 4;
    const int K = cx.K();
    float acc[4][4], acc2[4][4];
#pragma unroll
    for (int i = 0; i < 4; ++i)
#pragma unroll
        for (int j = 0; j < 4; ++j) { acc[i][j] = 0.f; acc2[i][j] = 0.f; }
    for (int k0 = 0; k0 < K; k0 += 16) {
#pragma unroll
        for (int i = 0; i < 4; ++i) { const int idx = tid + i * 256, r = idx >> 4, kk = idx & 15; As[kk][r] = cx.a(s_info, tm + r, k0 + kk); }
#pragma unroll
        for (int i = 0; i < 4; ++i) { const int idx = tid + i * 256, kk = idx >> 6, n = idx & 63; Bs[kk][n] = cx.b(s_info, k0 + kk, tn + n); if (DUAL) Bs2[kk][n] = cx.b2(s_info, k0 + kk, tn + n); }
        __syncthreads();
#pragma unroll
        for (int kk = 0; kk < 16; ++kk) {
            float a[4], b[4], b2[4];
#pragma unroll
            for (int i = 0; i < 4; ++i) { a[i] = As[kk][ty * 4 + i]; b[i] = Bs[kk][tx * 4 + i]; b2[i] = DUAL ? Bs2[kk][tx * 4 + i] : 0.f; }
#pragma unroll
            for (int i = 0; i < 4; ++i)
#pragma unroll
                for (int j = 0; j < 4; ++j) { acc[i][j] += a[i] * b[j]; if (DUAL) acc2[i][j] += a[i] * b2[j]; }
        }
        __syncthreads();
    }
#pragma unroll
    for (int i = 0; i < 4; ++i)
#pragma unroll
        for (int j = 0; j < 4; ++j) cx.epi(s_info, tm + ty * 4 + i, tn + tx * 4 + j, acc[i][j], acc2[i][j]);
}

struct CxIn {
    const float* x; const float* mod; const float* w; bf16* proj; float* dtf;
    __device__ bool setup(int*) const { return true; }
    __device__ int K() const { return D; }
    __device__ float a(const int*, int m, int k) const { const int b = m / T; return x[(size_t)m * D + k] * (1.f + mod[b * 6144 + D + k]) + mod[b * 6144 + k]; }
    __device__ float b(const int*, int k, int n) const { return n < DIN ? w[(size_t)k * DIN + n] : 0.f; }
    __device__ float b2(const int*, int, int) const { return 0.f; }
    __device__ void epi(const int*, int m, int n, float v, float) const {
        if (n >= DIN) return;
        if (n < 1536) proj[(size_t)m * PW + n] = (bf16)f2bf(v);
        else if (n < 1544) dtf[m * 16 + (n - 1536)] = v;
        else if (n < 3080) { const int c = n - 8; proj[(size_t)m * PW + c] = (bf16)f2bf(c < PC_K ? v * QSCALE : v); }
        else dtf[m * 16 + 8 + (n - 3080)] = v;
    }
};
struct CxOut {
    const bf16* ycat; const float* w; float* h;
    __device__ bool setup(int*) const { return true; }
    __device__ int K() const { return D; }
    __device__ float a(const int*, int m, int k) const { return bf2f(ycat[(size_t)m * D + k]); }
    __device__ float b(const int*, int k, int n) const { return w[(size_t)k * D + n]; }
    __device__ float b2(const int*, int, int) const { return 0.f; }
    __device__ void epi(const int*, int m, int n, float v, float) const { h[(size_t)m * D + n] = v; }
};
__device__ __forceinline__ bool moe_setup(const unsigned* cnt, int* s_info) {
    const int e = blockIdx.z; const int n = (int)cnt[e];
    if ((int)blockIdx.y * 64 >= n) return false;
    if (threadIdx.x == 0) { int base = 0; for (int i = 0; i < e; ++i) base += ((int)cnt[i] + 255) / 256 * 256; s_info[0] = e; s_info[1] = n; s_info[2] = base; }
    return true;
}
struct CxMoe1 {
    const unsigned* cnt; const int* list; const bf16* u2; const float* wg; const float* wu; bf16* hmid;
    __device__ bool setup(int* s) const { return moe_setup(cnt, s); }
    __device__ int K() const { return D; }
    __device__ float a(const int* s, int m, int k) const { if (m >= s[1]) return 0.f; const int tok = list[s[0] * LCAP + m] >> 1; return bf2f(u2[(size_t)tok * D + k]); }
    __device__ float b(const int* s, int k, int n) const { return wg[((size_t)s[0] * D + k) * DE + n]; }
    __device__ float b2(const int* s, int k, int n) const { return wu[((size_t)s[0] * D + k) * DE + n]; }
    __device__ void epi(const int* s, int m, int n, float g, float u) const { if (m >= s[1]) return; hmid[(size_t)(s[2] + m) * DE + n] = (bf16)f2bf(silu_f(g) * u); }
};
struct CxMoe2 {
    const unsigned* cnt; const int* list; const bf16* hmid; const float* wd; bf16* yk0; bf16* yk1;
    __device__ bool setup(int* s) const { return moe_setup(cnt, s); }
    __device__ int K() const { return DE; }
    __device__ float a(const int* s, int m, int k) const { if (m >= s[1]) return 0.f; return bf2f(hmid[(size_t)(s[2] + m) * DE + k]); }
    __device__ float b(const int* s, int k, int n) const { return wd[((size_t)s[0] * DE + k) * D + n]; }
    __device__ float b2(const int*, int, int) const { return 0.f; }
    __device__ void epi(const int* s, int m, int n, float v, float) const { if (m >= s[1]) return; const int a = list[s[0] * LCAP + m]; bf16* y = (a & 1) ? yk1 : yk0; y[(size_t)(a >> 1) * D + n] = (bf16)f2bf(v); }
};

__global__ void k_cumf(const float* dtf, const float* fg_bias, float* ck) {
    const int bh = blockIdx.x * blockDim.x + threadIdx.x; if (bh >= NB * NH) return;
    const int b = bh / NH, h = bh % NH; const float fb = fg_bias[h]; float s = 0.f;
    for (int t = 0; t < T; ++t) { const float f = dtf[(size_t)(b * T + t) * 16 + 8 + h] + fb; s += -softplus_f(-f); ck[(size_t)bh * T + t] = s; }
}
__global__ void __launch_bounds__(256) k_conv(const bf16* proj, const float* cw, const float* cb, float* xact) {
    const size_t i = (size_t)blockIdx.x * 256 + threadIdx.x; const int m = (int)(i / DXBC), ch = (int)(i % DXBC), t = m % T;
    float acc = cb[ch];
#pragma unroll
    for (int j = 0; j < 4; ++j) { const int tt = t - 3 + j; if (tt >= 0) acc += cw[j * DXBC + ch] * bf2f(proj[(size_t)(m - 3 + j) * PW + PC_XS + ch]); }
    xact[i] = silu_f(acc);
}
__global__ void __launch_bounds__(256) k_ssd(const float* xact, const float* dtf, const float* dt_bias, const float* a_log, const float* d_skip, float* ypre) {
    const int b = blockIdx.x / NH, h = blockIdx.x % NH, g = h / 4, p = threadIdx.x >> 2, nq = threadIdx.x & 3;
    const float A = -expf(a_log[h]), Dh = d_skip[h], dtb = dt_bias[h];
    float st[32];
#pragma unroll
    for (int i = 0; i < 32; ++i) st[i] = 0.f;
    for (int t = 0; t < T; ++t) {
        const size_t m = (size_t)b * T + t;
        const float dtv = softplus_f(dtf[m * 16 + h] + dtb), dA = expf(dtv * A);
        const float xv = xact[m * DXBC + h * 64 + p], xd = xv * dtv;
        const f32x4* Bp = (const f32x4*)(xact + m * DXBC + 512 + g * 128 + nq * 32);
        const f32x4* Cp = (const f32x4*)(xact + m * DXBC + 768 + g * 128 + nq * 32);
        float y = 0.f;
#pragma unroll
        for (int i = 0; i < 8; ++i) { const f32x4 bv = Bp[i], cv = Cp[i];
#pragma unroll
            for (int j = 0; j < 4; ++j) { st[i * 4 + j] = dA * st[i * 4 + j] + xd * bv[j]; y += cv[j] * st[i * 4 + j]; } }
        y += __shfl_xor(y, 1); y += __shfl_xor(y, 2);
        if (nq == 0) ypre[m * DSSM + h * 64 + p] = y + Dh * xv;
    }
}
__global__ void __launch_bounds__(256) k_ssm_norm(const float* ypre, const bf16* proj, const float* ng, bf16* ycat) {
    const int w = (blockIdx.x * 256 + threadIdx.x) >> 6, lane = threadIdx.x & 63, m = w >> 1, g = w & 1;
    float v[4]; float ss = 0.f;
#pragma unroll
    for (int j = 0; j < 4; ++j) { const int c = g * 256 + lane * 4 + j; v[j] = ypre[(size_t)m * DSSM + c] * silu_f(bf2f(proj[(size_t)m * PW + PC_Z + c])); ss += v[j] * v[j]; }
    const float r = 1.f / sqrtf(wave_sum(ss) * (1.f / 256.f) + EPS);
#pragma unroll
    for (int j = 0; j < 4; ++j) { const int c = g * 256 + lane * 4 + j; ycat[(size_t)m * D + c] = (bf16)f2bf(v[j] * r * ng[c]); }
}
__global__ void __launch_bounds__(64) k_attn(bf16* proj, const float* ck) {
    __shared__ float Ks[64][64], Vs[64][64], cks[64];
    const int blk = blockIdx.x, qt = blk % 32, bh = blk / 32, b = bh / NH, h = bh % NH, lane = threadIdx.x;
    const int q = qt * 64 + lane; const size_t mq = (size_t)b * T + q;
    float Q[64], O[64];
#pragma unroll
    for (int d = 0; d < 64; ++d) { Q[d] = bf2f(proj[mq * PW + PC_Q + h * 64 + d]); O[d] = 0.f; }
    const float cq = ck[(size_t)bh * T + q];
    float mrun = -INFINITY, lrun = 0.f;
    for (int kt = 0; kt <= qt; ++kt) {
        __syncthreads();
        for (int i = lane; i < 64 * 64; i += 64) { const int r = i >> 6, d = i & 63; const size_t mk = (size_t)b * T + kt * 64 + r;
            Ks[r][d] = bf2f(proj[mk * PW + PC_K + h * 64 + d]); Vs[r][d] = bf2f(proj[mk * PW + PC_V + h * 64 + d]); }
        cks[lane] = ck[(size_t)bh * T + kt * 64 + lane];
        __syncthreads();
        const int jmax = (kt == qt) ? lane : 63;
        for (int j = 0; j <= jmax; ++j) {
            float s = 0.f;
#pragma unroll
            for (int d = 0; d < 64; ++d) s += Q[d] * Ks[j][d];
            s += (cq - cks[j]) * LOG2E;
            const float mn = fmaxf(mrun, s), al = exp2f(mrun - mn), pj = exp2f(s - mn);
            lrun = lrun * al + pj; mrun = mn;
#pragma unroll
            for (int d = 0; d < 64; ++d) O[d] = O[d] * al + pj * Vs[j][d];
        }
    }
    const float il = 1.f / lrun;
#pragma unroll
    for (int d = 0; d < 64; ++d) proj[mq * PW + PC_Q + h * 64 + d] = (bf16)f2bf(O[d] * il);
}
__global__ void __launch_bounds__(256) k_attn_norm(const bf16* proj, const float* ng, bf16* ycat) {
    const int m = (blockIdx.x * 256 + threadIdx.x) >> 6, lane = threadIdx.x & 63;
    float v[8]; float ss = 0.f;
#pragma unroll
    for (int j = 0; j < 8; ++j) { v[j] = bf2f(proj[(size_t)m * PW + PC_Q + lane * 8 + j]); ss += v[j] * v[j]; }
    const float r = 1.f / sqrtf(wave_sum(ss) * (1.f / 512.f) + EPS);
#pragma unroll
    for (int j = 0; j < 8; ++j) ycat[(size_t)m * D + 512 + lane * 8 + j] = (bf16)f2bf(v[j] * r * ng[lane * 8 + j]);
}
__global__ void __launch_bounds__(256) k_ln1_router(const float* x, float* hx1, const float* mod, const float* g1, const float* b1,
                                                    const float* rgw, const float* rgb, const float* rew, const float* reb,
                                                    bf16* u2, unsigned* cnt, int* list, int* toke, float* tokw, int* toks) {
    const int m = (blockIdx.x * 256 + threadIdx.x) >> 6, lane = threadIdx.x & 63, b = m / T;
    const float* mb = mod + b * 6144;
    float v[16]; float s = 0.f;
#pragma unroll
    for (int j = 0; j < 4; ++j) { const int c = 4 * lane + 256 * j; const f32x4 xv = *(const f32x4*)(x + (size_t)m * D + c), hv = *(const f32x4*)(hx1 + (size_t)m * D + c), gt = *(const f32x4*)(mb + 2 * D + c);
#pragma unroll
        for (int i = 0; i < 4; ++i) { v[j * 4 + i] = ALPHA * xv[i] + (1.f + gt[i]) * hv[i]; s += v[j * 4 + i]; } }
    const float mean = wave_sum(s) * (1.f / D); float s2 = 0.f;
#pragma unroll
    for (int i = 0; i < 16; ++i) { v[i] -= mean; s2 += v[i] * v[i]; }
    const float rstd = 1.f / sqrtf(wave_sum(s2) * (1.f / D) + EPS);
    float acc[36];
#pragma unroll
    for (int i = 0; i < 36; ++i) acc[i] = 0.f;
#pragma unroll
    for (int j = 0; j < 4; ++j) { const int c = 4 * lane + 256 * j; const f32x4 gg = *(const f32x4*)(g1 + c), bb = *(const f32x4*)(b1 + c), sc = *(const f32x4*)(mb + 4 * D + c), sh = *(const f32x4*)(mb + 3 * D + c);
        f32x4 x1, uu;
#pragma unroll
        for (int i = 0; i < 4; ++i) { x1[i] = v[j * 4 + i] * rstd * gg[i] + bb[i]; uu[i] = x1[i] * (1.f + sc[i]) + sh[i]; }
        *(f32x4*)(hx1 + (size_t)m * D + c) = x1;
        u32x2 pk; pk.x = pk2(uu[0], uu[1]); pk.y = pk2(uu[2], uu[3]); *(u32x2*)(u2 + (size_t)m * D + c) = pk;
#pragma unroll
        for (int i = 0; i < 4; ++i) { const int k = c + i; const f32x4 wg = *(const f32x4*)(rgw + (size_t)k * 4);
#pragma unroll
            for (int q = 0; q < 4; ++q) acc[q] += uu[i] * wg[q];
#pragma unroll
            for (int q8 = 0; q8 < 8; ++q8) { const f32x4 we = *(const f32x4*)(rew + (size_t)k * 32 + q8 * 4);
#pragma unroll
                for (int q = 0; q < 4; ++q) acc[4 + q8 * 4 + q] += uu[i] * we[q]; } } }
#pragma unroll
    for (int i = 0; i < 36; ++i) acc[i] = wave_sum(acc[i]);
    float lg[4]; float mx = -INFINITY; int gi = 0;
#pragma unroll
    for (int i = 0; i < 4; ++i) { lg[i] = acc[i] + rgb[i]; if (lg[i] > mx) { mx = lg[i]; gi = i; } }
    float se = 0.f;
#pragma unroll
    for (int i = 0; i < 4; ++i) se += expf(lg[i] - mx);
    const float gp = 1.f / se;
    float le[8]; float mxe = -INFINITY;
#pragma unroll
    for (int i = 0; i < 8; ++i) { float t = 0.f;
#pragma unroll
        for (int gq = 0; gq < 4; ++gq) t = (gi == gq) ? acc[4 + gq * 8 + i] + reb[gq * 8 + i] : t;
        le[i] = t; mxe = fmaxf(mxe, t); }
    float pe[8];
#pragma unroll
    for (int i = 0; i < 8; ++i) pe[i] = expf(le[i] - mxe);
    int i1 = 0; float p1 = -1.f;
#pragma unroll
    for (int i = 0; i < 8; ++i) if (pe[i] > p1) { p1 = pe[i]; i1 = i; }
    int i2 = 0; float p2 = -1.f;
#pragma unroll
    for (int i = 0; i < 8; ++i) if (i != i1 && pe[i] > p2) { p2 = pe[i]; i2 = i; }
    const float inv = 1.f / (p1 + p2);
    if (lane == 0) {
        const int e0 = gi * 8 + i1, e1 = gi * 8 + i2;
        const unsigned q0 = atomicAdd(&cnt[e0], 1u), q1 = atomicAdd(&cnt[e1], 1u);
        list[e0 * LCAP + q0] = m * 2; list[e1 * LCAP + q1] = m * 2 + 1;
        toke[m * 2] = e0; toke[m * 2 + 1] = e1; tokw[m * 2] = gp * p1 * inv; tokw[m * 2 + 1] = gp * p2 * inv; toks[m * 2] = (int)q0; toks[m * 2 + 1] = (int)q1;
    }
}
__global__ void __launch_bounds__(256) k_final(float* out, const float* mod, const bf16* yk0, const bf16* yk1, const float* tokw, const float* g2, const float* b2) {
    const int m = (blockIdx.x * 256 + threadIdx.x) >> 6, lane = threadIdx.x & 63, b = m / T;
    const float* mb = mod + b * 6144; const float w0 = tokw[m * 2], w1 = tokw[m * 2 + 1];
    float v[16]; float s = 0.f;
#pragma unroll
    for (int j = 0; j < 4; ++j) { const int c = 4 * lane + 256 * j; const f32x4 xv = *(const f32x4*)(out + (size_t)m * D + c), gt = *(const f32x4*)(mb + 5 * D + c);
        const u32x2 a = *(const u32x2*)(yk0 + (size_t)m * D + c), bq = *(const u32x2*)(yk1 + (size_t)m * D + c);
        const float y0[4] = {bf2f(a.x), bf2f(a.x >> 16), bf2f(a.y), bf2f(a.y >> 16)}, y1[4] = {bf2f(bq.x), bf2f(bq.x >> 16), bf2f(bq.y), bf2f(bq.y >> 16)};
#pragma unroll
        for (int i = 0; i < 4; ++i) { v[j * 4 + i] = ALPHA * xv[i] + (1.f + gt[i]) * (w0 * y0[i] + w1 * y1[i]); s += v[j * 4 + i]; } }
    const float mean = wave_sum(s) * (1.f / D); float s2 = 0.f;
#pragma unroll
    for (int i = 0; i < 16; ++i) { v[i] -= mean; s2 += v[i] * v[i]; }
    const float rstd = 1.f / sqrtf(wave_sum(s2) * (1.f / D) + EPS);
#pragma unroll
    for (int j = 0; j < 4; ++j) { const int c = 4 * lane + 256 * j; const f32x4 gg = *(const f32x4*)(g2 + c), bb = *(const f32x4*)(b2 + c); f32x4 o;
#pragma unroll
        for (int i = 0; i < 4; ++i) o[i] = v[j * 4 + i] * rstd * gg[i] + bb[i];
        *(f32x4*)(out + (size_t)m * D + c) = o; }
}
}
namespace pg8 {
#define PG8_LAS __attribute__((address_space(3)))
typedef unsigned short bf16_t;
typedef short bf16x8 __attribute__((ext_vector_type(8)));
typedef float f32x4 __attribute__((ext_vector_type(4)));
typedef float f32x2 __attribute__((ext_vector_type(2)));
typedef unsigned u32x4 __attribute__((ext_vector_type(4)));
constexpr int BM = 256, BK = 64, HALF = 128, HTB = HALF * BK * 2  , STAGE_BYTES = 8 * HTB, NXCD = 8, WGM = 8;

__host__ __device__ __forceinline__ int lds_byte(int r, int c) { const int st = (r >> 4) * 2 + (c >> 5), rr = r & 15, cc = c & 31, ob = rr * 64 + cc * 2; return st * 1024 + (ob ^ (((ob >> 9) & 1) << 5)); }
__host__ __device__ __forceinline__ void stage_rc(int b, int& R, int& C) { const int st = b / 1024, sb = b % 1024, swz = sb ^ (((sb >> 9) & 1) << 5); R = (st >> 1) * 16 + swz / 64; C = (st & 1) * 32 + (swz % 64) / 2; }
__host__ __device__ __forceinline__ int perm32(int rho) { const int n = rho >> 4, i = rho & 15; return 8 * (i >> 2) + 4 * n + (i & 3); }

struct Unit { int pm, pn; unsigned boff; int x0, x1, x2; };
struct Gemm { const bf16_t* A; const bf16_t* Bt; int K; };

struct StaticOrder {
    int nM, nN, nwg, G, c, K;
    __device__ void init(int M, int N, int K_, int G_, int c_) { nM = M / BM; nN = N / BM; nwg = nM * nN; G = G_; c = c_; K = K_; }
    __device__ bool next(int i, Unit& u) const {
        const long L = (long)i * G + c; if (L >= nwg) return false;
        int wgid = (int)L; { const int q = nwg / NXCD, r = nwg % NXCD, xcd = wgid % NXCD, off = wgid / NXCD; wgid = (xcd < r ? xcd * (q + 1) : r * (q + 1) + (xcd - r) * q) + off; }
        const int nig = WGM * nN, gid = wgid / nig, fm = gid * WGM, gsz = (nM - fm) < WGM ? (nM - fm) : WGM;
        u.pm = fm + ((wgid % nig) % gsz); u.pn = (wgid % nig) / gsz; u.boff = (unsigned)u.pn * (unsigned)(BM * K * 2); u.x0 = u.x1 = u.x2 = 0; return true;
    }
    __device__ __forceinline__ unsigned arow(const Unit& u, int r) const { return (unsigned)(u.pm * BM + r) * (unsigned)(K * 2); }
};

__device__ __forceinline__ unsigned cvt_pk_bf16(float lo, float hi) { unsigned r; asm volatile("v_cvt_pk_bf16_f32 %0, %1, %2" : "=v"(r) : "v"(lo), "v"(hi)); return r; }

struct EpiProj {
    static constexpr bool PERM = true;
    bf16_t* O; int ldc; int q_lo, q_hi; float qs;
    __device__ __forceinline__ void operator()(const f32x4 (&acc)[2][2][4][2], const Unit& u, int wr, int wc, int fr, int fq) const {
        const int row0 = u.pm * BM + wr * 64 + fr, colt = u.pn * BM; const float sc = (colt >= q_lo && colt < q_hi) ? qs : 1.f;
        const int col0 = colt + wc * 32 + 8 * fq;
#pragma unroll
        for (int ai = 0; ai < 2; ++ai)
#pragma unroll
            for (int m = 0; m < 4; ++m) { bf16_t* rowp = O + (size_t)(row0 + ai * HALF + m * 16) * ldc + col0;
#pragma unroll
                for (int bj = 0; bj < 2; ++bj) { const f32x4 v0 = acc[ai][bj][m][0] * sc, v1 = acc[ai][bj][m][1] * sc;
                    u32x4 w; w.x = cvt_pk_bf16(v0[0], v0[1]); w.y = cvt_pk_bf16(v0[2], v0[3]); w.z = cvt_pk_bf16(v1[0], v1[1]); w.w = cvt_pk_bf16(v1[2], v1[3]);
                    *(u32x4*)(rowp + bj * HALF) = w; } }
    }
};
struct EpiF32 {
    static constexpr bool PERM = false;
    float* O; int ldc;
    __device__ __forceinline__ void operator()(const f32x4 (&acc)[2][2][4][2], const Unit& u, int wr, int wc, int fr, int fq) const {
        const int row0 = u.pm * BM + wr * 64 + fr, col0 = u.pn * BM + wc * 32 + 4 * fq;
#pragma unroll
        for (int ai = 0; ai < 2; ++ai)
#pragma unroll
            for (int m = 0; m < 4; ++m) { float* rowp = O + (size_t)(row0 + ai * HALF + m * 16) * ldc + col0;
#pragma unroll
                for (int bj = 0; bj < 2; ++bj)
#pragma unroll
                    for (int n = 0; n < 2; ++n) *(f32x4*)(rowp + bj * HALF + n * 16) = acc[ai][bj][m][n]; }
    }
};

struct EpiMoe1 {
    static constexpr bool PERM = true;
    bf16_t* H; int ldc;
    __device__ __forceinline__ void operator()(const f32x4 (&acc)[2][2][4][2], const Unit& u, int wr, int wc, int fr, int fq) const {
        const int row0 = u.pm * BM + wr * 64 + fr, col0 = u.pn * HALF + wc * 32 + 8 * fq;
#pragma unroll
        for (int ai = 0; ai < 2; ++ai)
#pragma unroll
            for (int m = 0; m < 4; ++m) { float hv[8];
#pragma unroll
                for (int n = 0; n < 2; ++n)
#pragma unroll
                    for (int j = 0; j < 4; ++j) { const float gt = acc[ai][0][m][n][j], up = acc[ai][1][m][n][j]; hv[n * 4 + j] = gt * __builtin_amdgcn_rcpf(1.f + __expf(-gt)) * up; }
                u32x4 w; w.x = cvt_pk_bf16(hv[0], hv[1]); w.y = cvt_pk_bf16(hv[2], hv[3]); w.z = cvt_pk_bf16(hv[4], hv[5]); w.w = cvt_pk_bf16(hv[6], hv[7]);
                *(u32x4*)(H + (size_t)(row0 + ai * HALF + m * 16) * ldc + col0) = w; }
    }
};
struct EpiMoe2 {
    static constexpr bool PERM = true;
    bf16_t* Y0; long ydelta; int ldc; const int* list;
    __device__ __forceinline__ void operator()(const f32x4 (&acc)[2][2][4][2], const Unit& u, int wr, int wc, int fr, int fq) const {
        const int col0 = u.pn * BM + wc * 32 + 8 * fq; const int* lp = list + u.x0 * LCAP + u.x1;
#pragma unroll
        for (int ai = 0; ai < 2; ++ai)
#pragma unroll
            for (int m = 0; m < 4; ++m) { const int r = ai * HALF + wr * 64 + m * 16 + fr;
                if (r < u.x2) { const int a = lp[r]; bf16_t* rowp = (bf16_t*)((char*)Y0 + (long)(a & 1) * ydelta) + (size_t)(a >> 1) * ldc + col0;
#pragma unroll
                    for (int bj = 0; bj < 2; ++bj) { const f32x4 v0 = acc[ai][bj][m][0], v1 = acc[ai][bj][m][1];
                        u32x4 w; w.x = cvt_pk_bf16(v0[0], v0[1]); w.y = cvt_pk_bf16(v0[2], v0[3]); w.z = cvt_pk_bf16(v1[0], v1[1]); w.w = cvt_pk_bf16(v1[2], v1[3]);
                        *(u32x4*)(rowp + bj * HALF) = w; } } }
    }
};
struct MoeOrder {
    const PG8_LAS unsigned* tab; const PG8_LAS unsigned* cnts; int ntiles, G, c, mode; const int* list;
    __device__ bool next(int i, Unit& u) const {
        const int L = i * G + c; if (L >= ntiles * 4) return false;
        const int tile = L >> 2; const unsigned w = tab[tile]; const int e = (int)(w & 0xffu), row0 = (int)(w >> 8), rem = (int)cnts[e] - row0;
        u.pm = tile; u.pn = L & 3; u.x0 = e; u.x1 = row0; u.x2 = rem < BM ? rem : BM;
        u.boff = mode == 0 ? (unsigned)(e * 1024 + u.pn * BM) * 2048u : (unsigned)(e * 1024 + u.pn * BM) * 1024u; return true;
    }
    __device__ __forceinline__ unsigned arow(const Unit& u, int r) const {
        if (mode == 0) { const int rr = r < u.x2 ? r : 0; return (unsigned)(list[u.x0 * LCAP + u.x1 + rr] >> 1) * 2048u; }
        return (unsigned)(u.pm * BM + r) * 1024u;
    }
};

template <class Epi, class Sched, bool ALIGN_EPI>
__device__ __forceinline__ void gemm_phase(PG8_LAS unsigned char* lds, const Gemm g, const Sched& S, const Epi& E) {
    int tid_ = threadIdx.x; asm volatile("" : "+v"(tid_));
    const int tid = tid_, wid = __builtin_amdgcn_readfirstlane(tid >> 6), lane = tid & 63, wr = wid >> 2, wc = wid & 3, fr = lane & 15, fq = lane >> 4;
    const int K = g.K, nt = K / BK;
    int Rp[2], Cp[2]; unsigned voffB[2];
#pragma unroll
    for (int i = 0; i < 2; ++i) { int R, C; stage_rc(tid * 16 + i * 8192, R, C); Rp[i] = R; Cp[i] = C; const int Rb = Epi::PERM ? ((R & ~31) + perm32(R & 31)) : R; voffB[i] = (unsigned)(Rb * K + C) * 2u; }
    const size_t kstep = (size_t)(BK * 2);
    const size_t hstep = (size_t)HALF * K * 2;
    const unsigned ldsw = (unsigned)wid * 1024u;
    const int aoff = lds_byte(wr * 64 + fr, fq * 8), boff = lds_byte(wc * 32 + fr, fq * 8);
    const char* gA = (const char*)g.A;
#define PG8_SA(b, h) (((b) * 2 + (h)) * HTB)
#define PG8_SB(b, h) ((4 + (b) * 2 + (h)) * HTB)
#define PG8_STAGE(bufoff, gbase, voff) do { _Pragma("unroll") for (int _i = 0; _i < 2; ++_i) \
        __builtin_amdgcn_global_load_lds((const unsigned*)((const char*)(gbase) + (voff)[_i]), (PG8_LAS unsigned*)(lds + (bufoff) + ldsw + _i * 8192), 16, 0, 0); } while (0)
#define PG8_STAGE_A(bufoff, kb, V, h) do { _Pragma("unroll") for (int _i = 0; _i < 2; ++_i) \
        __builtin_amdgcn_global_load_lds((const unsigned*)(gA + (kb) + (V)[h][_i]), (PG8_LAS unsigned*)(lds + (bufoff) + ldsw + _i * 8192), 16, 0, 0); } while (0)
#define PG8_LDA(dst, b, h) do { _Pragma("unroll") for (int m = 0; m < 4; ++m) _Pragma("unroll") for (int k = 0; k < 2; ++k) dst[m][k] = *(const PG8_LAS bf16x8*)(lds + PG8_SA(b, h) + aoff + m * 2048 + k * 1024); } while (0)
#define PG8_LDB(dst, b, h) do { _Pragma("unroll") for (int n = 0; n < 2; ++n) _Pragma("unroll") for (int k = 0; k < 2; ++k) dst[n][k] = *(const PG8_LAS bf16x8*)(lds + PG8_SB(b, h) + boff + n * 2048 + k * 1024); } while (0)
#define PG8_MMA(ai, bj, At, Bt) do { __builtin_amdgcn_s_setprio(1); _Pragma("unroll") for (int m = 0; m < 4; ++m) _Pragma("unroll") for (int n = 0; n < 2; ++n) _Pragma("unroll") for (int k = 0; k < 2; ++k) \
        acc[ai][bj][m][n] = __builtin_amdgcn_mfma_f32_16x16x32_bf16(Bt[n][k], At[m][k], acc[ai][bj][m][n], 0, 0, 0); __builtin_amdgcn_s_setprio(0); } while (0)
#define PG8_WAIT_V(n) asm volatile("s_waitcnt vmcnt(" #n ")" ::: "memory")
#define PG8_WAIT_L(n) asm volatile("s_waitcnt lgkmcnt(" #n ")" ::: "memory")
#define PG8_BAR __builtin_amdgcn_s_barrier()
#define PG8_SCHED __builtin_amdgcn_sched_barrier(0)
    Unit cur, nxt; int ui = 0;
    if (!S.next(0, cur)) return;
    f32x4 acc[2][2][4][2];
#pragma unroll
    for (int a = 0; a < 2; ++a)
#pragma unroll
        for (int b = 0; b < 2; ++b)
#pragma unroll
            for (int m = 0; m < 4; ++m)
#pragma unroll
                for (int n = 0; n < 2; ++n) acc[a][b][m][n] = (f32x4){0.f, 0.f, 0.f, 0.f};
    bf16x8 At[4][2], B0[2][2], B1[2][2];
    unsigned vc[2][2], vn[2][2];
#pragma unroll
    for (int h = 0; h < 2; ++h)
#pragma unroll
        for (int i = 0; i < 2; ++i) vc[h][i] = S.arow(cur, h * HALF + Rp[i]) + (unsigned)(Cp[i] * 2);
    const char* cB = (const char*)g.Bt + cur.boff;
    PG8_STAGE(PG8_SB(0, 0), cB, voffB); PG8_STAGE(PG8_SB(0, 1), cB + hstep, voffB); PG8_STAGE_A(PG8_SA(0, 0), 0, vc, 0); PG8_STAGE_A(PG8_SA(0, 1), 0, vc, 1);
    if (wr == 1) PG8_BAR;
    PG8_WAIT_V(2); PG8_BAR;
    PG8_STAGE(PG8_SB(1, 0), cB + kstep, voffB); PG8_STAGE_A(PG8_SA(1, 0), kstep, vc, 0); PG8_STAGE(PG8_SB(1, 1), cB + hstep + kstep, voffB);
    PG8_WAIT_V(6); PG8_BAR;
    for (;;) {
        const bool has_next = S.next(ui + 1, nxt);
        const char* nB = has_next ? (const char*)g.Bt + nxt.boff : cB;
#pragma unroll
        for (int h = 0; h < 2; ++h)
#pragma unroll
            for (int i = 0; i < 2; ++i) vn[h][i] = has_next ? S.arow(nxt, h * HALF + Rp[i]) + (unsigned)(Cp[i] * 2) : vc[h][i];
        for (int t = 0; t < nt; t += 2) {
            const bool last = (t == nt - 2);
            const size_t k1 = (size_t)(t + 1) * kstep;
            const size_t k2 = last ? 0 : (size_t)(t + 2) * kstep, k3 = k2 + kstep;
            const char* b2 = last ? nB : cB + (size_t)(t + 2) * kstep; const char* b3 = b2 + kstep;
            unsigned v2[2][2];
#pragma unroll
            for (int h = 0; h < 2; ++h)
#pragma unroll
                for (int i = 0; i < 2; ++i) v2[h][i] = last ? vn[h][i] : vc[h][i];
            PG8_LDB(B0, 0, 0); PG8_LDB(B1, 0, 1); PG8_SCHED; PG8_LDA(At, 0, 0); PG8_STAGE_A(PG8_SA(1, 1), k1, vc, 1);
            PG8_WAIT_V(8); PG8_WAIT_L(0); PG8_BAR; PG8_MMA(0, 0, At, B0); PG8_MMA(0, 1, At, B1); PG8_BAR; PG8_SCHED;
            PG8_LDA(At, 0, 1); PG8_STAGE(PG8_SB(0, 0), b2, voffB); PG8_STAGE(PG8_SB(0, 1), b2 + hstep, voffB); PG8_STAGE_A(PG8_SA(0, 0), k2, v2, 0);
            PG8_WAIT_V(8); PG8_WAIT_L(0); PG8_BAR; PG8_MMA(1, 0, At, B0); PG8_MMA(1, 1, At, B1); PG8_BAR; PG8_SCHED;
            PG8_LDB(B0, 1, 0); PG8_LDB(B1, 1, 1); PG8_SCHED; PG8_LDA(At, 1, 0); PG8_STAGE_A(PG8_SA(0, 1), k2, v2, 1);
            PG8_WAIT_V(8); PG8_WAIT_L(0); PG8_BAR; PG8_MMA(0, 0, At, B0); PG8_MMA(0, 1, At, B1); PG8_BAR; PG8_SCHED;
            PG8_LDA(At, 1, 1); PG8_STAGE(PG8_SB(1, 0), b3, voffB); PG8_STAGE(PG8_SB(1, 1), b3 + hstep, voffB); PG8_STAGE_A(PG8_SA(1, 0), k3, v2, 0);
            PG8_WAIT_V(8); PG8_WAIT_L(0); PG8_BAR; PG8_MMA(1, 0, At, B0); PG8_MMA(1, 1, At, B1); PG8_BAR; PG8_SCHED;
        }
        if constexpr (ALIGN_EPI) { if (wr == 0) PG8_BAR; }
        E(acc, cur, wr, wc, fr, fq);
        if (!has_next) break;
#pragma unroll
        for (int a = 0; a < 2; ++a)
#pragma unroll
            for (int b = 0; b < 2; ++b)
#pragma unroll
                for (int m = 0; m < 4; ++m)
#pragma unroll
                    for (int n = 0; n < 2; ++n) acc[a][b][m][n] = (f32x4){0.f, 0.f, 0.f, 0.f};
        cur = nxt; cB = nB; ++ui;
#pragma unroll
        for (int h = 0; h < 2; ++h)
#pragma unroll
            for (int i = 0; i < 2; ++i) vc[h][i] = vn[h][i];
        if constexpr (ALIGN_EPI) { if (wr == 1) PG8_BAR; }
    }
    PG8_WAIT_V(0);
    if constexpr (!ALIGN_EPI) { if (wr == 0) PG8_BAR; }
    PG8_BAR;
#undef PG8_SA
#undef PG8_SB
#undef PG8_STAGE
#undef PG8_STAGE_A
#undef PG8_LDA
#undef PG8_LDB
#undef PG8_MMA
#undef PG8_WAIT_V
#undef PG8_WAIT_L
#undef PG8_BAR
#undef PG8_SCHED
}
}
#include <hip/hip_bf16.h>
#include <cmath>
namespace attn_body {
using bf16=__hip_bfloat16;
using bf16x8=__attribute__((ext_vector_type(8)))short;
using s16x4=__attribute__((ext_vector_type(4)))short;
using f32x16=__attribute__((ext_vector_type(16)))float;
using u32x4=__attribute__((ext_vector_type(4)))unsigned;
constexpr int BATCH=8,NHEAD=8,SEQ=2048,D=64,DM=3072;
constexpr int NW=8,QBLK=32,QB=QBLK*NW,KVBLK=64,NQB=SEQ/QB;
constexpr int ATTN_PITCH=DM, ATTN_UNIT_ROWS=QB;
__device__ __forceinline__ int crow(int r,int hi){return (r&3)+8*(r>>2)+4*hi;}
#define SBAR() __builtin_amdgcn_sched_barrier(0)
__device__ __forceinline__ void cmask(f32x16&p0,f32x16&p1,int jb,int qrel,int hi){
  const float NEG=-INFINITY; int kb=64*jb+4*hi;
  #pragma unroll
  for(int r=0;r<16;++r){int kv=kb+(r&3)+8*(r>>2); if(kv>qrel)p0[r]=NEG; if(kv+32>qrel)p1[r]=NEG;}
}

constexpr int NSLOT=3, SLOTB=8192;
constexpr int LDS_K=0, LDS_V=NSLOT*SLOTB, LDS_WS=2*NSLOT*SLOTB, LDS_OST=LDS_WS+NW*64*4, LDS_CKF=LDS_OST+NW*4096, LDS_CKP=LDS_CKF+SEQ*4, LDS_BYTES=LDS_CKP+SEQ*4;
constexpr float C2=0.125f*1.4426950408889634f;
__device__ __forceinline__ void glds16(const void*gsrc,unsigned lds_dst){unsigned keep;
  asm volatile("s_mov_b32 %0, m0\n\ts_mov_b32 m0, %2\n\ts_nop 0\n\tglobal_load_lds_dwordx4 %1, off\n\ts_mov_b32 m0, %0":"=&s"(keep):"v"(gsrc),"s"(lds_dst):"memory");}
__device__ __forceinline__ float max3f(float a,float b,float c){float r;asm("v_max3_f32 %0, %1, %2, %3":"=v"(r):"v"(a),"v"(b),"v"(c));return r;}
__device__ __forceinline__ float max2f(float a,float b){float r;asm("v_max_f32_e32 %0, %1, %2":"=v"(r):"v"(a),"v"(b));return r;}
__device__ __forceinline__ float fadd_s(float a,float b){float r;asm("v_add_f32_e32 %0, %1, %2":"=v"(r):"v"(a),"v"(b));return r;}
__device__ __forceinline__ float fsub_s(float a,float b){float r;asm("v_sub_f32_e32 %0, %1, %2":"=v"(r):"v"(a),"v"(b));return r;}
typedef float f32x2_t __attribute__((ext_vector_type(2))); typedef __bf16 bf16x2_t __attribute__((ext_vector_type(2)));
__device__ __forceinline__ unsigned cvtpk_s(float lo,float hi){f32x2_t v={lo,hi};bf16x2_t b=__builtin_convertvector(v,bf16x2_t);return __builtin_bit_cast(unsigned,b);}
#define WAIT_BAR(N) asm volatile("s_waitcnt vmcnt(" #N ") lgkmcnt(0)\n\ts_barrier":::"memory")

__device__ __forceinline__ unsigned f2bf_rne(float f){unsigned u=__float_as_uint(f);return (u+0x7fffu+((u>>16)&1u))>>16;}
__device__ __forceinline__ void qkt(f32x16&p0,f32x16&p1,const char*Kslot,const bf16x8*qr,int r32,int hi,bf16x8 kx0,bf16x8 kx1,bf16x8 qx){
  const char*kb=Kslot+hi*1024+r32*16;
  #pragma unroll
  for(int d0=0;d0<4;++d0){
    const bf16x8 b0=*reinterpret_cast<const bf16x8*>(kb+d0*2048);
    const bf16x8 b1=*reinterpret_cast<const bf16x8*>(kb+d0*2048+512);
    if(d0==0){p0=__builtin_amdgcn_mfma_f32_32x32x16_bf16(b0,qr[0],f32x16{},0,0,0);p1=__builtin_amdgcn_mfma_f32_32x32x16_bf16(b1,qr[0],f32x16{},0,0,0);}
    else{p0=__builtin_amdgcn_mfma_f32_32x32x16_bf16(b0,qr[d0],p0,0,0,0);p1=__builtin_amdgcn_mfma_f32_32x32x16_bf16(b1,qr[d0],p1,0,0,0);}}
  p0=__builtin_amdgcn_mfma_f32_32x32x16_bf16(kx0,qx,p0,0,0,0);p1=__builtin_amdgcn_mfma_f32_32x32x16_bf16(kx1,qx,p1,0,0,0);
}
typedef __attribute__((address_space(3))) const char* lds_cptr;
typedef short v4i16_t __attribute__((ext_vector_type(4)));
__device__ __forceinline__ void kload8(bf16x8*kf,lds_cptr kp){
  kf[0]=*(const __attribute__((address_space(3))) bf16x8*)(kp);      kf[1]=*(const __attribute__((address_space(3))) bf16x8*)(kp+512);
  kf[2]=*(const __attribute__((address_space(3))) bf16x8*)(kp+2048); kf[3]=*(const __attribute__((address_space(3))) bf16x8*)(kp+2560);
  kf[4]=*(const __attribute__((address_space(3))) bf16x8*)(kp+4096); kf[5]=*(const __attribute__((address_space(3))) bf16x8*)(kp+4608);
  kf[6]=*(const __attribute__((address_space(3))) bf16x8*)(kp+6144); kf[7]=*(const __attribute__((address_space(3))) bf16x8*)(kp+6656);
}
__device__ __forceinline__ void kload2(bf16x8*kf,lds_cptr kp,int j){ kf[2*j]=*(const __attribute__((address_space(3))) bf16x8*)(kp+j*2048); kf[2*j+1]=*(const __attribute__((address_space(3))) bf16x8*)(kp+j*2048+512); }
__device__ __forceinline__ s16x4 vtr(lds_cptr p){ return __builtin_bit_cast(s16x4,__builtin_amdgcn_ds_read_tr16_b64_v4i16((__attribute__((address_space(3))) v4i16_t*)p)); }
__device__ __forceinline__ float rowmax(const f32x16&p0,const f32x16&p1){
  float a=max3f(p0[0],p0[1],p1[0]),b=max3f(p0[2],p0[3],p1[1]);a=max3f(a,p1[2],p1[3]);
  #pragma unroll
  for(int r=4;r<16;r+=4){a=max3f(a,p0[r],p0[r+1]);b=max3f(b,p0[r+2],p0[r+3]);a=max3f(a,p1[r],p1[r+1]);b=max3f(b,p1[r+2],p1[r+3]);}
  const float m=max2f(a,b);
  auto rr=__builtin_amdgcn_permlane32_swap(__float_as_uint(m),__float_as_uint(m),false,false);
  return max2f(__uint_as_float(rr[0]),__uint_as_float(rr[1]));
}
__device__ __forceinline__ void pv(f32x16*o,int vb,bf16x8 pa0,bf16x8 pa1,bf16x8 pa2,bf16x8 pa3){
  #pragma unroll
  for(int d0=0;d0<2;++d0){s16x4 lo[4],hi[4];
    #pragma unroll
    for(int ks=0;ks<4;++ks){
      asm volatile("ds_read_b64_tr_b16 %0,%1 offset:%c2":"=&v"(lo[ks]):"v"(vb),"i"(d0*4096+ks*1024):"memory");
      asm volatile("ds_read_b64_tr_b16 %0,%1 offset:%c2":"=&v"(hi[ks]):"v"(vb),"i"(d0*4096+ks*1024+512):"memory");}
    asm volatile("s_waitcnt lgkmcnt(0)":::"memory");SBAR();
    #define PK(k) (bf16x8){lo[k][0],lo[k][1],lo[k][2],lo[k][3],hi[k][0],hi[k][1],hi[k][2],hi[k][3]}
    o[d0]=__builtin_amdgcn_mfma_f32_32x32x16_bf16(pa0,PK(0),o[d0],0,0,0);
    o[d0]=__builtin_amdgcn_mfma_f32_32x32x16_bf16(pa1,PK(1),o[d0],0,0,0);
    o[d0]=__builtin_amdgcn_mfma_f32_32x32x16_bf16(pa2,PK(2),o[d0],0,0,0);
    o[d0]=__builtin_amdgcn_mfma_f32_32x32x16_bf16(pa3,PK(3),o[d0],0,0,0);
    #undef PK
  }
}

#ifndef ATTN_STORE16
#define ATTN_STORE16(p,v) (*(u32x4*)(p)=(v))
#endif
template<int THRL> __device__ __forceinline__ void attn_unit(int b,int h,int qb,const bf16*Q,const bf16*__restrict__ K,const bf16*__restrict__ V,bf16*O,char*shm){
  int tid_=threadIdx.x; asm volatile("":"+v"(tid_)); const int tid=tid_,lane=tid&63,r32=lane&31,hi=lane>>5; const int wid=__builtin_amdgcn_readfirstlane(tid>>6);
  const long rowbase=(long)b*SEQ; const int q0=qb*QB;
  { const __attribute__((address_space(3))) float* ckf=(const __attribute__((address_space(3))) float*)((__attribute__((address_space(3))) char*)shm+LDS_CKF); __attribute__((address_space(3))) unsigned* ckpw=(__attribute__((address_space(3))) unsigned*)((__attribute__((address_space(3))) char*)shm+LDS_CKP);
    const float c0=ckf[q0];
    for(int k=tid;k<q0+QB;k+=NW*64){ const float x=(ckf[k]-c0)*1.4426950408889634f; const unsigned hb=f2bf_rne(x); const float xh=__uint_as_float(hb<<16); ckpw[k]=hb|(f2bf_rne(x-xh)<<16); }
    asm volatile("s_waitcnt lgkmcnt(0)\n\ts_barrier":::"memory"); }
  const __attribute__((address_space(3))) unsigned* ckp=(const __attribute__((address_space(3))) unsigned*)((__attribute__((address_space(3))) char*)shm+LDS_CKP);
  const bf16*Qw=Q+(rowbase+q0+wid*QBLK)*DM+h*D;
  const bf16*Kh=K+rowbase*DM+h*D,*Vh=V+rowbase*DM+h*D;
  const unsigned lds0=(unsigned)(uintptr_t)shm;
  float*wsf=(float*)(shm+LDS_WS)+wid*64;
  const bf16*ksrc=Kh+(long)lane*DM+wid*8;
  const bf16*vsrc=Vh+(long)(16*(wid&3)+(lane>>2))*DM+(wid>>2)*32+(lane&3)*8;
  const unsigned kdst=lds0+LDS_K+wid*1024, vdst=lds0+LDS_V+wid*1024;
  #define DMA_K(t,slot) glds16(ksrc+(long)(t)*KVBLK*DM,(unsigned)__builtin_amdgcn_readfirstlane(kdst+(slot)))
  #define DMA_V(t,slot) glds16(vsrc+(long)(t)*KVBLK*DM,(unsigned)__builtin_amdgcn_readfirstlane(vdst+(slot)))
  const int vb0=(int)(lds0+LDS_V)+((lane>>4)&1)*32+(lane&3)*8+(4*hi+((lane&15)>>2))*64;
  const char*Kbase=shm+LDS_K; bf16x8 kf[8];
  const lds_cptr shm3=(lds_cptr)shm; const lds_cptr kp0=shm3+LDS_K+hi*1024+r32*16; const lds_cptr vp0=shm3+LDS_V+((lane>>4)&1)*32+(lane&3)*8+(4*hi+((lane&15)>>2))*64;
  const int NT=(q0+QB)/KVBLK;
  DMA_K(0,0);DMA_V(0,0);DMA_K(1,SLOTB);
  bf16x8 qr[4];
  #pragma unroll
  for(int d0=0;d0<4;++d0)qr[d0]=*reinterpret_cast<const bf16x8*>(&Qw[(long)r32*DM+d0*16+hi*8]);
  const unsigned cqw=hi?0u:ckp[q0+wid*QBLK+r32]; bf16x8 qx=__builtin_bit_cast(bf16x8,(u32x4){hi?0u:0xbf80bf80u,cqw,0u,0u});
  #define SETQX() do{ const unsigned hb_=f2bf_rne(mhat); const unsigned mw_=hb_|(f2bf_rne(mhat-__uint_as_float(hb_<<16))<<16); qx=__builtin_bit_cast(bf16x8,(u32x4){hi?0u:0xbf80bf80u,cqw,hi?0u:mw_,0u}); }while(0)
  #define KXW(w) __builtin_bit_cast(bf16x8,(u32x4){(w),0x3f803f80u,0xbf80bf80u,0u})
  #define KX(key) __builtin_bit_cast(bf16x8,(u32x4){ckp[(key)+r32],0x3f803f80u,0xbf80bf80u,0u})
  float mhat=0.f,l_reg=0.f;f32x16 o[2];o[0]=f32x16{};o[1]=f32x16{};
  const int qrel=wid*QBLK+r32;
  #define CMASK(P0,P1,t) do{int jb_=(t)-(NT-4); if(jb_>=0)cmask(P0,P1,jb_,qrel,hi);}while(0)
  bool resc=false;
  #define START(P0,P1) do{ const float rm=rowmax(P0,P1); resc=false; \
    { const float dl=__builtin_ceilf(rm); mhat=fadd_s(mhat,dl); \
      _Pragma("unroll") for(int r=0;r<16;++r){P0[r]=fsub_s(P0[r],dl);P1[r]=fsub_s(P1[r],dl);} \
      SETQX(); } \
    _Pragma("unroll") for(int r=0;r<16;++r)P0[r]=__builtin_amdgcn_exp2f(P0[r]); }while(0)
  #define RESC() do{ if(resc){ asm volatile("s_waitcnt lgkmcnt(0)":::"memory"); \
      _Pragma("unroll") for(int d_=0;d_<2;++d_) _Pragma("unroll") for(int r=0;r<16;++r)o[d_][r]*=wsf[crow(r,hi)]; } }while(0)
  f32x16 pA0,pA1,pB0,pB1;
  int sl_prev=0,sl_cur=0,sl_next=SLOTB;
  #define ROT() do{sl_prev=sl_cur;sl_cur=sl_next;sl_next=(sl_next==(NSLOT-1)*SLOTB)?0:sl_next+SLOTB;}while(0)
  DMA_K(2,2*SLOTB);
  WAIT_BAR(3);
  qkt(pA0,pA1,Kbase,qr,r32,hi,KX(0),KX(32),qx);asm volatile("s_nop 15\n\ts_nop 7":"+v"(pA0),"+v"(pA1));CMASK(pA0,pA1,0);
  START(pA0,pA1);
  _Pragma("unroll") for(int r=0;r<16;++r)pA1[r]=__builtin_amdgcn_exp2f(pA1[r]);
  WAIT_BAR(0);
  DMA_K(3,0);DMA_V(1,SLOTB);
  ROT();
  kload8(kf,kp0+sl_cur);
  unsigned kw0=ckp[KVBLK+r32], kw1=ckp[KVBLK+32+r32];
  WAIT_BAR(2);
  s16x4 vlo[8],vhi[8]; u32x4 pw0,pw1,pw2,pw3;
  #define PKW(P,B) cvtpk_s(P[B],P[B+1])
  #define PAF(k) __builtin_bit_cast(bf16x8,pw##k)
  #define VFR(i) (bf16x8){vlo[i][0],vlo[i][1],vlo[i][2],vlo[i][3],vhi[i][0],vhi[i][1],vhi[i][2],vhi[i][3]}
  #define PIN(x) asm volatile("":"+v"(x))
  #define MX3(a,b,c) __builtin_fmaxf(__builtin_fmaxf((a),(b)),(c))
  #define GAPA(MF,A0,A1,A2,A3,W0,W1,PW) do{ MF; sacc+=A0; sacc+=A1; sacc+=A2; sacc+=A3; PIN(sacc); W0; W1; PIN(PW); SBAR(); }while(0)
  #define EX(v) __builtin_amdgcn_exp2f(v)
  #define GAPB(MF,X,B) do{ MF; X[B]=EX(X[B]); X[B+1]=EX(X[B+1]); X[B+2]=EX(X[B+2]); X[B+3]=EX(X[B+3]); PIN(X); SBAR(); }while(0)
  #define VRD(i) do{ vlo[i]=vtr(vp_+(((i)>>2)*4096+((i)&3)*1024)); vhi[i]=vtr(vp_+(((i)>>2)*4096+((i)&3)*1024+512)); }while(0)
  #define KRD(G,j) do{ if(G){ kload2(kf,kp0+sl_next,j); SBAR(); } }while(0)
  #define STEP(C0,C1,P0,P1,t,GK,GV,GL) do{ SBAR(); \
    C0=__builtin_amdgcn_mfma_f32_32x32x16_bf16(KXW(kw0),qx,f32x16{},0,0,0); C1=__builtin_amdgcn_mfma_f32_32x32x16_bf16(KXW(kw1),qx,f32x16{},0,0,0); SBAR(); \
    const lds_cptr vp_=vp0+sl_prev; \
    VRD(0); SBAR(); float sacc=(P0[0]+P0[1]); \
    GAPA(C0=__builtin_amdgcn_mfma_f32_32x32x16_bf16(kf[0],qr[0],C0,0,0,0), P0[2],P0[3],P0[4],P0[5],     pw0[0]=PKW(P0,0), pw0[1]=PKW(P0,2), pw0); \
    VRD(4); SBAR(); GAPA(C1=__builtin_amdgcn_mfma_f32_32x32x16_bf16(kf[1],qr[0],C1,0,0,0), P0[6],P0[7],P0[8],P0[9],     pw0[2]=PKW(P0,4), pw0[3]=PKW(P0,6), pw0); \
    VRD(1); SBAR(); GAPA(C0=__builtin_amdgcn_mfma_f32_32x32x16_bf16(kf[2],qr[1],C0,0,0,0),   P0[10],P0[11],P0[12],P0[13], pw1[0]=PKW(P0,8), pw1[1]=PKW(P0,10), pw1); \
    VRD(5); SBAR(); GAPA(C1=__builtin_amdgcn_mfma_f32_32x32x16_bf16(kf[3],qr[1],C1,0,0,0),   P0[14],P0[15],P1[0],P1[1],   pw1[2]=PKW(P0,12),pw1[3]=PKW(P0,14), pw1); \
    VRD(2); SBAR(); GAPA(C0=__builtin_amdgcn_mfma_f32_32x32x16_bf16(kf[4],qr[2],C0,0,0,0),   P1[2],P1[3],P1[4],P1[5],     pw2[0]=PKW(P1,0), pw2[1]=PKW(P1,2), pw2); \
    VRD(6); SBAR(); GAPA(C1=__builtin_amdgcn_mfma_f32_32x32x16_bf16(kf[5],qr[2],C1,0,0,0),   P1[6],P1[7],P1[8],P1[9],     pw2[2]=PKW(P1,4), pw2[3]=PKW(P1,6), pw2); \
    VRD(3); SBAR(); GAPA(C0=__builtin_amdgcn_mfma_f32_32x32x16_bf16(kf[6],qr[3],C0,0,0,0),   P1[10],P1[11],P1[12],P1[13], pw3[0]=PKW(P1,8), pw3[1]=PKW(P1,10), pw3); \
    VRD(7); SBAR(); GAPA(C1=__builtin_amdgcn_mfma_f32_32x32x16_bf16(kf[7],qr[3],C1,0,0,0),   P1[14],P1[15],0.f,0.f,       pw3[2]=PKW(P1,12),pw3[3]=PKW(P1,14), pw3); \
    l_reg+=sacc; \
    if(GK){DMA_K((t)+3,sl_cur);} if(GV){DMA_V((t)+1,sl_next);} \
    CMASK(C0,C1,t); \
    { float a=MX3(C0[0],C0[1],C1[0]),b=MX3(C0[2],C0[3],C1[1]); a=MX3(a,C1[2],C1[3]); \
      _Pragma("unroll") for(int r=4;r<16;r+=4){a=MX3(a,C0[r],C0[r+1]);b=MX3(b,C0[r+2],C0[r+3]);a=MX3(a,C1[r],C1[r+1]);b=MX3(b,C1[r+2],C1[r+3]);} \
      float rm=__builtin_fmaxf(a,b); { auto rr=__builtin_amdgcn_permlane32_swap(__float_as_uint(rm),__float_as_uint(rm),false,false); rm=__builtin_fmaxf(__uint_as_float(rr[0]),__uint_as_float(rr[1])); } \
      resc=false; \
      if(__builtin_expect(__any(rm>(float)THRL),0)){ const float dl=__builtin_ceilf(__builtin_fmaxf(rm,0.f)); mhat+=dl; \
        _Pragma("unroll") for(int r=0;r<16;++r){C0[r]-=dl;C1[r]-=dl;} \
        SETQX(); \
        const float f=__builtin_amdgcn_exp2f(-dl); l_reg*=f; if(hi==0)wsf[r32]=f; resc=true; } } \
    SBAR(); \
    GAPB(o[0]=__builtin_amdgcn_mfma_f32_32x32x16_bf16(PAF(0),VFR(0),o[0],0,0,0), C0,0); \
    GAPB(o[1]=__builtin_amdgcn_mfma_f32_32x32x16_bf16(PAF(0),VFR(4),o[1],0,0,0), C0,4); \
    KRD(GL,0); GAPB(o[0]=__builtin_amdgcn_mfma_f32_32x32x16_bf16(PAF(1),VFR(1),o[0],0,0,0), C0,8); \
    KRD(GL,1); GAPB(o[1]=__builtin_amdgcn_mfma_f32_32x32x16_bf16(PAF(1),VFR(5),o[1],0,0,0), C0,12); \
    KRD(GL,2); GAPB(o[0]=__builtin_amdgcn_mfma_f32_32x32x16_bf16(PAF(2),VFR(2),o[0],0,0,0), C1,0); \
    KRD(GL,3); GAPB(o[1]=__builtin_amdgcn_mfma_f32_32x32x16_bf16(PAF(2),VFR(6),o[1],0,0,0), C1,4); \
    if(GL){ kw0=ckp[((t)+1)*KVBLK+r32]; kw1=ckp[((t)+1)*KVBLK+32+r32]; SBAR(); } \
    GAPB(o[0]=__builtin_amdgcn_mfma_f32_32x32x16_bf16(PAF(3),VFR(3),o[0],0,0,0), C1,8); \
    GAPB(o[1]=__builtin_amdgcn_mfma_f32_32x32x16_bf16(PAF(3),VFR(7),o[1],0,0,0), C1,12); \
    }while(0)
  int t=1;
  #undef CMASK
  #define CMASK(P0,P1,t) do{}while(0)
  for(;t+5<NT;t+=2){
    STEP(pB0,pB1,pA0,pA1,t,true,true,true);     WAIT_BAR(2); RESC(); ROT();
    STEP(pA0,pA1,pB0,pB1,t+1,true,true,true);   WAIT_BAR(2); RESC(); ROT();
  }
  #undef CMASK
  #define CMASK(P0,P1,t) do{int jb_=(t)-(NT-4); if(jb_>=0)cmask(P0,P1,jb_,qrel,hi);}while(0)
  #define ENDW(tt) do{ if((tt)+3<NT){WAIT_BAR(2);} else if((tt)+2<NT){WAIT_BAR(1);} else {WAIT_BAR(0);} }while(0)
  for(;t+1<NT;t+=2){
    STEP(pB0,pB1,pA0,pA1,t,(t+3<NT),(t+1<NT),(t+1<NT));       ENDW(t);   RESC(); ROT();
    STEP(pA0,pA1,pB0,pB1,t+1,(t+4<NT),(t+2<NT),(t+2<NT));     ENDW(t+1); RESC(); ROT();
  }
  STEP(pB0,pB1,pA0,pA1,NT-1,false,false,false); RESC();
  { float sacc=pB0[0]+pB0[1]; _Pragma("unroll") for(int r=2;r<16;++r)sacc+=pB0[r]; _Pragma("unroll") for(int r=0;r<16;++r)sacc+=pB1[r]; l_reg+=sacc;
    pw0=(u32x4){PKW(pB0,0),PKW(pB0,2),PKW(pB0,4),PKW(pB0,6)};pw1=(u32x4){PKW(pB0,8),PKW(pB0,10),PKW(pB0,12),PKW(pB0,14)};pw2=(u32x4){PKW(pB1,0),PKW(pB1,2),PKW(pB1,4),PKW(pB1,6)};pw3=(u32x4){PKW(pB1,8),PKW(pB1,10),PKW(pB1,12),PKW(pB1,14)};
    SBAR(); pv(o,vb0+sl_cur,PAF(0),PAF(1),PAF(2),PAF(3)); }
  #undef PKW
  #undef PAF
  #undef VFR
  #undef PIN
  #undef MX3
  #undef GAPA
  #undef GAPB
  #undef EX
  #undef VRD
  #undef KRD
  #undef STEP
  #undef ENDW
  {auto rr=__builtin_amdgcn_permlane32_swap(__float_as_uint(l_reg),__float_as_uint(l_reg),false,false);l_reg=__uint_as_float(rr[0])+__uint_as_float(rr[1]);}
  if(hi==0)wsf[32+r32]=l_reg;asm volatile("s_waitcnt lgkmcnt(0)":::"memory");
  float rli[16];
  #pragma unroll
  for(int r=0;r<16;++r)rli[r]=__builtin_amdgcn_rcpf(wsf[32+crow(r,hi)]);
  bf16*Ow=O+(rowbase+q0+wid*QBLK)*DM+h*D;
  { bf16*stg=(bf16*)(shm+LDS_OST)+wid*2048;
    #pragma unroll
    for(int r=0;r<16;++r){const int orow=crow(r,hi);
      #pragma unroll
      for(int d0=0;d0<2;++d0)stg[orow*64+d0*32+r32]=__float2bfloat16(o[d0][r]*rli[r]);}
    asm volatile("s_waitcnt lgkmcnt(0)":::"memory");
    #pragma unroll
    for(int i=0;i<4;++i){const int row=i*8+(lane>>3),ch=lane&7; const u32x4 v=*(const u32x4*)(stg+row*64+ch*8); ATTN_STORE16(Ow+(long)row*DM+ch*8,v);} }
  asm volatile("s_waitcnt lgkmcnt(0)\n\ts_barrier":::"memory");
  #undef KX
  #undef KXW
  #undef SETQX
  #undef DMA_K
  #undef DMA_V
  #undef CMASK
  #undef START
  #undef RESC
  #undef ROT
}
constexpr int ATTN_LDS_BYTES=LDS_BYTES;
struct AttnTensors { const bf16* Q; const bf16* K; const bf16* V; bf16* O; };
struct AttnUnit { int bh; int qb; };
#undef SBAR
#undef WAIT_BAR
}
#define GAS __attribute__((address_space(1)))
#define LAS __attribute__((address_space(3)))
typedef short bf16x8 __attribute__((ext_vector_type(8)));
typedef GAS unsigned gu32;
#define RLX_AGENT __ATOMIC_RELAXED, __HIP_MEMORY_SCOPE_AGENT
#define LDS_WAIT() asm volatile("s_waitcnt lgkmcnt(0)" ::: "memory")
#define VM_WAIT() asm volatile("s_waitcnt vmcnt(0)" ::: "memory")

struct Args {
    const float* in[25]; float* out; unsigned char* ws; int ph_lo, ph_hi, li, pad;
};

namespace ssd {
typedef float f32x16 __attribute__((ext_vector_type(16)));
typedef short s16x4 __attribute__((ext_vector_type(4)));
typedef short v4i16_t __attribute__((ext_vector_type(4)));
constexpr int L_C = 0, L_B = 32768, L_XT = 65536;
constexpr int L_TAB = 131072 + 2048;
constexpr int T_ACS = 0, T_DT = 2048, T_WS = 4096;
constexpr int NCH = T / 128;
__device__ __forceinline__ unsigned offb(unsigned row, unsigned ch) { return 256u * row + 16u * (ch ^ (((row & 3u) << 2) | ((row >> 2) & 3u))); }
__device__ __forceinline__ int crow(int r, int hi) { return (r & 3) + 8 * (r >> 2) + 4 * hi; }
__device__ __forceinline__ bf16x8 ld16(const LAS unsigned char* p) { return *(const LAS bf16x8*)p; }
__device__ __forceinline__ s16x4 ld8(const LAS unsigned char* p) { return *(const LAS s16x4*)p; }
__device__ __forceinline__ s16x4 vtr(const LAS unsigned char* p) { return __builtin_bit_cast(s16x4, __builtin_amdgcn_ds_read_tr16_b64_v4i16((LAS v4i16_t*)p)); }
__device__ __forceinline__ bf16x8 cat8(s16x4 lo, s16x4 hi) { return (bf16x8){lo[0], lo[1], lo[2], lo[3], hi[0], hi[1], hi[2], hi[3]}; }
__device__ __forceinline__ unsigned cvtpk(float lo, float hi) { unsigned r; asm volatile("v_cvt_pk_bf16_f32 %0, %1, %2" : "=v"(r) : "v"(lo), "v"(hi)); return r; }

struct Bufs { const bf16* proj; const float* dtf; float* yd; float* states; bf16* prev; bf16* cact; float* acsg; float* atot; };

__device__ __forceinline__ void chunk_unit(const Args& A, const Bufs& Bf, LAS unsigned char* lds, int b, int c, int g) {
    int tid_ = threadIdx.x; asm volatile("" : "+v"(tid_)); const int tid = tid_, lane = tid & 63, wave = __builtin_amdgcn_readfirstlane(tid >> 6), r32 = lane & 31, hi = lane >> 5;
    const int m0 = b * T + c * 128;
    LAS float* acs2 = (LAS float*)(lds + L_TAB + T_ACS); LAS float* dtl = (LAS float*)(lds + L_TAB + T_DT); LAS float* wsum = (LAS float*)(lds + L_TAB + T_WS);
    {   const int hh = tid >> 7, l = tid & 127, h = g * 4 + hh;
        const float dtv = softplus_f(Bf.dtf[(size_t)(m0 + l) * 16 + h] + A.in[7][h]);
        const float a = dtv * (-expf(A.in[8][h])) * LOG2E;
        float incl = a;
#pragma unroll
        for (int o = 1; o < 64; o <<= 1) { const float t = __shfl_up(incl, o); if (lane >= o) incl += t; }
        if (lane == 63) wsum[wave] = incl;
        LDS_WAIT(); __syncthreads();
        if (wave & 1) incl += wsum[wave - 1];
        acs2[hh * 128 + l] = incl; dtl[hh * 128 + l] = dtv;
        Bf.acsg[(size_t)(m0 + l) * 8 + h] = incl;
        if (l == 127) Bf.atot[(b * NCH + c) * 8 + h] = incl;
        LDS_WAIT(); __syncthreads();
    }
    {   const int cg = tid & 63, seg = tid >> 6;
        const int chx = cg < 32 ? g * 256 + 8 * cg : (cg < 48 ? 512 + g * 128 + 8 * (cg - 32) : 768 + g * 128 + 8 * (cg - 48));
        const float* cw = A.in[5]; const float* cb = A.in[6];
        float w[4][8], bias[8], hx[3][8];
#pragma unroll
        for (int j = 0; j < 4; ++j) { const f32x4 a0 = *(const f32x4*)(cw + j * DXBC + chx), a1 = *(const f32x4*)(cw + j * DXBC + chx + 4);
#pragma unroll
            for (int i = 0; i < 4; ++i) { w[j][i] = a0[i]; w[j][4 + i] = a1[i]; } }
        { const f32x4 a0 = *(const f32x4*)(cb + chx), a1 = *(const f32x4*)(cb + chx + 4);
#pragma unroll
          for (int i = 0; i < 4; ++i) { bias[i] = a0[i]; bias[4 + i] = a1[i]; } }
        const bf16* src = Bf.proj + (size_t)m0 * PW + PC_XS + chx;
        const int l0 = seg * 16;
#pragma unroll
        for (int j = 0; j < 3; ++j) { const int l = l0 - 3 + j; u32x4 r = {0u, 0u, 0u, 0u}; if (l >= 0 || c > 0) r = *(const u32x4*)(src + (long)l * PW);
            hx[j][0] = bf2f(r.x); hx[j][1] = bf2f(r.x >> 16); hx[j][2] = bf2f(r.y); hx[j][3] = bf2f(r.y >> 16); hx[j][4] = bf2f(r.z); hx[j][5] = bf2f(r.z >> 16); hx[j][6] = bf2f(r.w); hx[j][7] = bf2f(r.w >> 16); }
        const int hh = cg >> 3;
        for (int grp = 0; grp < 2; ++grp) {
            unsigned pk[8][4]; float ev[8];
#pragma unroll
            for (int li = 0; li < 8; ++li) { const int l = l0 + grp * 8 + li;
                const u32x4 r = *(const u32x4*)(src + (long)l * PW);
                const float cur[8] = {bf2f(r.x), bf2f(r.x >> 16), bf2f(r.y), bf2f(r.y >> 16), bf2f(r.z), bf2f(r.z >> 16), bf2f(r.w), bf2f(r.w >> 16)};
                float act[8];
#pragma unroll
                for (int i = 0; i < 8; ++i) { const float s = bias[i] + w[0][i] * hx[0][i] + w[1][i] * hx[1][i] + w[2][i] * hx[2][i] + w[3][i] * cur[i];
                    act[i] = s * __builtin_amdgcn_rcpf(1.f + __expf(-s)); hx[0][i] = hx[1][i]; hx[1][i] = hx[2][i]; hx[2][i] = cur[i]; }
                if (cg < 32) { const float dv = dtl[hh * 128 + l];
#pragma unroll
                    for (int i = 0; i < 8; ++i) { const float xv = act[i] * dv; if (li & 1) pk[i][li >> 1] = cvtpk(ev[i], xv); else ev[i] = xv; } }
                else { u32x4 o; o.x = cvtpk(act[0], act[1]); o.y = cvtpk(act[2], act[3]); o.z = cvtpk(act[4], act[5]); o.w = cvtpk(act[6], act[7]);
                    if (cg < 48) *(LAS u32x4*)(lds + L_B + offb(l, cg - 32)) = o;
                    else { *(LAS u32x4*)(lds + L_C + offb(l, cg - 48)) = o; *(u32x4*)(Bf.cact + (size_t)(m0 + l) * 256 + g * 128 + 8 * (cg - 48)) = o; } }
            }
            if (cg < 32) { const int pb = (cg & 7) * 8, lc = (l0 + grp * 8) >> 3;
#pragma unroll
                for (int i = 0; i < 8; ++i) *(LAS u32x4*)(lds + L_XT + hh * 16384 + offb(pb + i, lc)) = (u32x4){pk[i][0], pk[i][1], pk[i][2], pk[i][3]}; }
        }
        LDS_WAIT(); __syncthreads();
    }
    {   int t3_ = threadIdx.x; asm volatile("" : "+v"(t3_)); const int lane = t3_ & 63, r32 = lane & 31, hi = lane >> 5;
        const int lb = wave & 3, hp = wave >> 2, lq = 32 * lb + r32;
        bf16x8 qf[8];
#pragma unroll
        for (int ks = 0; ks < 8; ++ks) qf[ks] = ld16(lds + L_C + offb(lq, 2 * ks + hi));
        f32x16 o[2][2];
#pragma unroll
        for (int a = 0; a < 2; ++a)
#pragma unroll
            for (int d = 0; d < 2; ++d) o[a][d] = f32x16{};
        const int nst = (lb >> 1) + 1;
        for (int st = 0; st < nst; ++st) {
            f32x16 p0 = f32x16{}, p1 = f32x16{};
#pragma unroll
            for (int ks = 0; ks < 8; ++ks) { const bf16x8 k0 = ld16(lds + L_B + offb(64 * st + r32, 2 * ks + hi)), k1 = ld16(lds + L_B + offb(64 * st + 32 + r32, 2 * ks + hi));
                p0 = __builtin_amdgcn_mfma_f32_32x32x16_bf16(k0, qf[ks], p0, 0, 0, 0); p1 = __builtin_amdgcn_mfma_f32_32x32x16_bf16(k1, qf[ks], p1, 0, 0, 0); }
#pragma unroll
            for (int hh = 0; hh < 2; ++hh) { const int hl = 2 * hp + hh, h = g * 4 + hl;
                const float al = acs2[hl * 128 + lq], dsk = A.in[9][h] * __builtin_amdgcn_rcpf(dtl[hl * 128 + lq]);
                unsigned pw[4][4];
#pragma unroll
                for (int half = 0; half < 2; ++half)
#pragma unroll
                    for (int q = 0; q < 4; ++q) { const int sb = 64 * st + 32 * half + 8 * q + 4 * hi; const f32x4 as = *(const LAS f32x4*)(acs2 + hl * 128 + sb);
                        float pv[4];
#pragma unroll
                        for (int e = 0; e < 4; ++e) { const int s = sb + e; const float sv = half ? p1[q * 4 + e] : p0[q * 4 + e];
                            float v = sv * __builtin_amdgcn_exp2f(al - as[e]); v = (s <= lq) ? v : 0.f; v = (s == lq) ? v + dsk : v; pv[e] = v; }
                        pw[half * 2 + (q >> 1)][(q & 1) * 2] = cvtpk(pv[0], pv[1]); pw[half * 2 + (q >> 1)][(q & 1) * 2 + 1] = cvtpk(pv[2], pv[3]); }
#pragma unroll
                for (int d0 = 0; d0 < 2; ++d0)
#pragma unroll
                    for (int kk = 0; kk < 4; ++kk) { const int prow = 32 * d0 + r32, chn = (64 * st + 16 * kk) >> 3;
                        const s16x4 lo = ld8(lds + L_XT + hl * 16384 + offb(prow, chn) + 8 * hi), hv = ld8(lds + L_XT + hl * 16384 + offb(prow, chn + 1) + 8 * hi);
                        o[hh][d0] = __builtin_amdgcn_mfma_f32_32x32x16_bf16(__builtin_bit_cast(bf16x8, (u32x4){pw[kk][0], pw[kk][1], pw[kk][2], pw[kk][3]}), cat8(lo, hv), o[hh][d0], 0, 0, 0); }
            }
        }
#pragma unroll
        for (int hh = 0; hh < 2; ++hh)
#pragma unroll
            for (int d0 = 0; d0 < 2; ++d0)
#pragma unroll
                for (int r = 0; r < 16; ++r) Bf.yd[(size_t)(m0 + 32 * lb + crow(r, hi)) * DSSM + (g * 4 + 2 * hp + hh) * 64 + 32 * d0 + r32] = o[hh][d0][r];
    }
    {   int t4_ = threadIdx.x; asm volatile("" : "+v"(t4_)); const int lane = t4_ & 63, r32 = lane & 31, hi = lane >> 5;
        const int hl = wave >> 1, pb = wave & 1, h = g * 4 + hl, prow = 32 * pb + r32;
        const float atot = acs2[hl * 128 + 127];
        bf16x8 af[8];
#pragma unroll
        for (int ks = 0; ks < 8; ++ks) { const u32x4 raw = *(const LAS u32x4*)(lds + L_XT + hl * 16384 + offb(prow, 2 * ks + hi));
            const f32x4 d0 = *(const LAS f32x4*)(acs2 + hl * 128 + 16 * ks + 8 * hi), d1 = *(const LAS f32x4*)(acs2 + hl * 128 + 16 * ks + 8 * hi + 4);
            const float e0 = __builtin_amdgcn_exp2f(atot - d0[0]), e1 = __builtin_amdgcn_exp2f(atot - d0[1]), e2 = __builtin_amdgcn_exp2f(atot - d0[2]), e3 = __builtin_amdgcn_exp2f(atot - d0[3]);
            const float e4 = __builtin_amdgcn_exp2f(atot - d1[0]), e5 = __builtin_amdgcn_exp2f(atot - d1[1]), e6 = __builtin_amdgcn_exp2f(atot - d1[2]), e7 = __builtin_amdgcn_exp2f(atot - d1[3]);
            u32x4 sc; sc.x = cvtpk(bf2f(raw.x) * e0, bf2f(raw.x >> 16) * e1); sc.y = cvtpk(bf2f(raw.y) * e2, bf2f(raw.y >> 16) * e3); sc.z = cvtpk(bf2f(raw.z) * e4, bf2f(raw.z >> 16) * e5); sc.w = cvtpk(bf2f(raw.w) * e6, bf2f(raw.w >> 16) * e7);
            af[ks] = __builtin_bit_cast(bf16x8, sc); }
        const unsigned blk = (lane >> 4) & 1, q4 = (lane & 15) >> 2, p4 = lane & 3;
        float* sp = Bf.states + ((size_t)((b * NCH + c) * 8 + h) * 64) * 128;
        for (int nb = 0; nb < 4; ++nb) {
            f32x16 acc = f32x16{};
#pragma unroll
            for (int ks = 0; ks < 8; ++ks) {
                const s16x4 t0 = vtr(lds + L_B + offb(16 * ks + 8 * hi + q4, 4 * nb + 2 * blk + (p4 >> 1)) + 8 * (p4 & 1));
                const s16x4 t1 = vtr(lds + L_B + offb(16 * ks + 8 * hi + 4 + q4, 4 * nb + 2 * blk + (p4 >> 1)) + 8 * (p4 & 1));
                acc = __builtin_amdgcn_mfma_f32_32x32x16_bf16(af[ks], cat8(t0, t1), acc, 0, 0, 0); }
#pragma unroll
            for (int r = 0; r < 16; ++r) sp[(size_t)(32 * pb + crow(r, hi)) * 128 + 32 * nb + r32] = acc[r];
        }
    }
    LDS_WAIT(); __syncthreads();
}

__device__ __forceinline__ void state_pass(const Bufs& Bf, int vcu, int G) {
    int tid_ = threadIdx.x; asm volatile("" : "+v"(tid_));
    for (int gid = vcu * 512 + tid_; gid < NB * NH * 64 * 32; gid += G * 512) {
        const int bh = gid >> 11, p = (gid >> 5) & 63, n4 = gid & 31, b = bh >> 3, h = bh & 7;
        f32x4 run = {0.f, 0.f, 0.f, 0.f};
        for (int c = 0; c < NCH; ++c) { const size_t idx = ((size_t)((b * NCH + c) * 8 + h) * 64 + p) * 128 + 4 * n4;
            u32x2 o; o.x = cvtpk(run[0], run[1]); o.y = cvtpk(run[2], run[3]); *(u32x2*)(Bf.prev + idx) = o;
            const f32x4 s = *(const f32x4*)(Bf.states + idx); const float dec = __builtin_amdgcn_exp2f(Bf.atot[(b * NCH + c) * 8 + h]);
            run = run * dec + s; }
    }
}

__device__ __forceinline__ void finalize_unit(const Args& A, const Bufs& Bf, LAS unsigned char* lds, bf16* ycat, int b, int c, int g) {
    int tid_ = threadIdx.x; asm volatile("" : "+v"(tid_)); const int tid = tid_, lane = tid & 63, wave = __builtin_amdgcn_readfirstlane(tid >> 6), r32 = lane & 31, hi = lane >> 5;
    const int m0 = b * T + c * 128;
    LAS float* ssq = (LAS float*)(lds + L_TAB);
#pragma unroll
    for (int i = 0; i < 4; ++i) { const int e = tid + i * 512, row = e >> 4, ch = e & 15; *(LAS u32x4*)(lds + L_C + offb(row, ch)) = *(const u32x4*)(Bf.cact + (size_t)(m0 + row) * 256 + g * 128 + 8 * ch); }
    const bf16* pv = Bf.prev + ((size_t)((b * NCH + c) * 8 + g * 4) * 64) * 128;
#pragma unroll
    for (int i = 0; i < 8; ++i) { const int e = tid + i * 512, row = e >> 4, ch = e & 15; *(LAS u32x4*)(lds + L_XT + offb(row, ch)) = *(const u32x4*)(pv + (size_t)row * 128 + 8 * ch); }
    LDS_WAIT(); __syncthreads();
    const int lb = wave & 3, hp = wave >> 2, lq = 32 * lb + r32;
    bf16x8 cf[8];
#pragma unroll
    for (int ks = 0; ks < 8; ++ks) cf[ks] = ld16(lds + L_C + offb(lq, 2 * ks + hi));
    f32x16 o[2][2];
#pragma unroll
    for (int hh = 0; hh < 2; ++hh)
#pragma unroll
        for (int d0 = 0; d0 < 2; ++d0) { f32x16 acc = f32x16{};
#pragma unroll
            for (int ks = 0; ks < 8; ++ks) acc = __builtin_amdgcn_mfma_f32_32x32x16_bf16(cf[ks], ld16(lds + L_XT + offb((2 * hp + hh) * 64 + 32 * d0 + r32, 2 * ks + hi)), acc, 0, 0, 0);
            o[hh][d0] = acc; }
    float sq[16];
#pragma unroll
    for (int r = 0; r < 16; ++r) { const int m = m0 + 32 * lb + crow(r, hi); float s = 0.f;
#pragma unroll
        for (int hh = 0; hh < 2; ++hh) { const int h = g * 4 + 2 * hp + hh; const float ea = __builtin_amdgcn_exp2f(Bf.acsg[(size_t)m * 8 + h]);
#pragma unroll
            for (int d0 = 0; d0 < 2; ++d0) { const int col = h * 64 + 32 * d0 + r32;
                const float z = bf2f(Bf.proj[(size_t)m * PW + PC_Z + col]);
                const float y = (Bf.yd[(size_t)m * DSSM + col] + ea * o[hh][d0][r]) * (z * __builtin_amdgcn_rcpf(1.f + __expf(-z)));
                o[hh][d0][r] = y; s += y * y; } }
#pragma unroll
        for (int of = 1; of < 32; of <<= 1) s += __shfl_xor(s, of);
        sq[r] = s; }
    if (r32 == 0) {
#pragma unroll
        for (int r = 0; r < 16; ++r) ssq[hp * 128 + 32 * lb + crow(r, hi)] = sq[r]; }
    LDS_WAIT(); __syncthreads();
    const float* ng = A.in[10];
#pragma unroll
    for (int r = 0; r < 16; ++r) { const int lr = 32 * lb + crow(r, hi), m = m0 + lr; const float rs = 1.f / sqrtf((ssq[lr] + ssq[128 + lr]) * (1.f / 256.f) + EPS);
#pragma unroll
        for (int hh = 0; hh < 2; ++hh)
#pragma unroll
            for (int d0 = 0; d0 < 2; ++d0) { const int col = (g * 4 + 2 * hp + hh) * 64 + 32 * d0 + r32; ycat[(size_t)m * D + col] = (bf16)f2bf(o[hh][d0][r] * rs * ng[col]); } }
    LDS_WAIT(); __syncthreads();
}
}
constexpr int NWAVES = 8;
constexpr int RING_OFF = 0, RING_BYTES = 131072;
constexpr int LDSCTL_OFF = RING_BYTES, MISC_OFF = LDSCTL_OFF + 320;
constexpr int LDS_BYTES = 147456;
static_assert(MISC_OFF + 128 <= LDS_BYTES, "LDS map");
constexpr int TAB_OFF = MISC_OFF + 128;
static_assert(TAB_OFF + 224 * 4 <= LDS_BYTES, "LDS map");
constexpr int CW_TMO = 0, CW_CODE = 1, CW_BAR = 4096, MAX_BAR_REGIONS = 8;

#define XB_TMO      128
#define XB_XCNT(j)  (256  + 64 * (j))
#define XB_XSUB(j)  (1280 + 64 * (j))
#define XB_XGEN(j)  (2304 + 64 * (j))
#define XB_TOP      3328
#define XB_TOPGEN   3392
#define XCD_BAR_WORDS 3456
#define XB_SPIN_CAP (1u << 18)

__device__ __forceinline__ unsigned xb_ld(unsigned* p)              { return __hip_atomic_load(p, __ATOMIC_RELAXED, __HIP_MEMORY_SCOPE_AGENT); }
__device__ __forceinline__ unsigned xb_add(unsigned* p, unsigned v) { return __hip_atomic_fetch_add(p, v, __ATOMIC_RELAXED, __HIP_MEMORY_SCOPE_AGENT); }
__device__ __forceinline__ unsigned xb_xcc_id() { return (unsigned)__builtin_amdgcn_s_getreg((3 << 11) | 20) & 0xFu; }
#define XB_SPIN(cond, bar) do { unsigned _sp = 0; while (cond) { __builtin_amdgcn_s_sleep(1); \
    if ((++_sp & 255u) == 0u) { if (xb_ld(&(bar)[XB_TMO])) break; if (_sp > XB_SPIN_CAP) { atomicAdd(&(bar)[XB_TMO], 1u); break; } } } } while (0)

struct XcdBarrier {
    unsigned* bar; unsigned x;
    volatile LAS unsigned* st;
};

__device__ __forceinline__ XcdBarrier xcd_barrier_post(unsigned* bar, volatile LAS unsigned* st) {
    XcdBarrier b; b.bar = bar; b.x = xb_xcc_id(); b.st = st;
    if (threadIdx.x == 0) (void)xb_add(&bar[XB_XCNT(b.x)], 1u);
    return b;
}
__device__ __forceinline__ void xcd_barrier_complete(unsigned* bar, unsigned x, unsigned& nloc, unsigned& nx) {
    const unsigned G = gridDim.x * gridDim.y * gridDim.z;
    unsigned sum, cnt, mine, sp = 0u;
    for (;;) {
        sum = 0u; cnt = 0u; mine = 0u;
#pragma unroll
        for (unsigned j = 0; j < 16; ++j) { const unsigned c = xb_ld(&bar[XB_XCNT(j)]); sum += c; cnt += (c > 0u) ? 1u : 0u; mine = (j == x) ? c : mine; }
        if (sum == G) break;
        __builtin_amdgcn_s_sleep(1);
        if ((++sp & 255u) == 0u) { if (xb_ld(&bar[XB_TMO])) break; if (sp > XB_SPIN_CAP) { atomicAdd(&bar[XB_TMO], 1u); break; } }
    }
    nloc = mine > 0u ? mine : 1u; nx = cnt > 0u ? cnt : 1u;
}

__device__ __forceinline__ void xcd_barrier(const XcdBarrier& b) {
    asm volatile("s_waitcnt vmcnt(0)" ::: "memory");
    __syncthreads();
    if (threadIdx.x == 0) {
        unsigned* bar = b.bar;
        __builtin_amdgcn_s_waitcnt(0);
        unsigned nloc = b.st[0], nx = b.st[1];
        if (nloc == 0u) { xcd_barrier_complete(bar, b.x, nloc, nx); b.st[0] = nloc; b.st[1] = nx; }
        const unsigned old = xb_add(&bar[XB_XSUB(b.x)], 1u);
        const unsigned gen = old / nloc;
        if (old + 1u == (gen + 1u) * nloc) {
            __builtin_amdgcn_fence(__ATOMIC_RELEASE, "agent");
            asm volatile("s_waitcnt vmcnt(0)" ::: "memory");
            const unsigned og = xb_add(&bar[XB_TOP], 1u);
            const unsigned tg = og / nx;
            if (og + 1u == (tg + 1u) * nx) xb_add(&bar[XB_TOPGEN], 1u);
            else XB_SPIN(xb_ld(&bar[XB_TOPGEN]) == tg, bar);
            __builtin_amdgcn_fence(__ATOMIC_ACQUIRE, "agent");
            xb_add(&bar[XB_XGEN(b.x)], 1u);
            asm volatile("s_waitcnt vmcnt(0)" ::: "memory");
        } else {
            XB_SPIN(xb_ld(&bar[XB_XGEN(b.x)]) == gen, bar);
            __builtin_amdgcn_fence(__ATOMIC_ACQUIRE, "agent");
            asm volatile("s_waitcnt vmcnt(0)" ::: "memory");
        }
    }
    __syncthreads();
}


struct Frame {
    LAS unsigned char* lds; volatile LAS unsigned* MISC; gu32* ctl;
    int tid, lane, wave, vcu, G;
};

__device__ __forceinline__ void transpose_item(const float* Wsrc, int ld, bf16* dst, int Kd, LAS float* scr, int lane) {
#pragma unroll 8
    for (int i = 0; i < 32; ++i) { const int kk = 2 * i + (lane >> 5); scr[kk * 33 + (lane & 31)] = Wsrc[(size_t)kk * ld + (lane & 31)]; }
    LDS_WAIT(); asm volatile("" ::: "memory");
    const int c = lane & 7;
#pragma unroll
    for (int j = 0; j < 4; ++j) { const int n = (lane >> 3) + 8 * j; const LAS float* s = scr + (8 * c) * 33 + n;
        u32x4 o; o.x = pk2(s[0 * 33], s[1 * 33]); o.y = pk2(s[2 * 33], s[3 * 33]); o.z = pk2(s[4 * 33], s[5 * 33]); o.w = pk2(s[6 * 33], s[7 * 33]);
        *(GAS u32x4*)(dst + (size_t)n * Kd + 8 * c) = o; }
    LDS_WAIT(); asm volatile("" ::: "memory");
}
constexpr int P0_MODT = 96 * 16;
constexpr int P0_IWIN = 16 * 96, P0_IWOUT = 16 * 32, P0_IEXP = 768;
constexpr int P0_NTASK = P0_MODT + P0_IWIN + P0_IWOUT + NE * P0_IEXP;
__device__ __forceinline__ void p0_prologue(Frame& F, const Args& A) {
    LAS float* scr = (LAS float*)(F.lds + RING_OFF + F.wave * 16384);
    const int gw = F.vcu * NWAVES + F.wave, NGW = F.G * NWAVES, lane = F.lane;
    const float* c = A.in[1]; const float* ada_w = A.in[2]; const float* w_in = A.in[4]; const float* w_out = A.in[13];
    const float* w_gate = A.in[20]; const float* w_up = A.in[21]; const float* w_down = A.in[22];
    float* modp = (float*)(A.ws + WS_MODP);
    bf16* Win = (bf16*)(A.ws + WS_WIN); bf16* Wout = (bf16*)(A.ws + WS_WOUT); bf16* Wgu = (bf16*)(A.ws + WS_WGU); bf16* Wdn = (bf16*)(A.ws + WS_WDN);
    for (int it = gw; it < P0_NTASK; it += NGW) {
        int r = it;
        if (r < P0_MODT) {
            const int cg = r % 96, ks = r / 96;
            int sv[NB]; float acc[NB];
#pragma unroll
            for (int b = 0; b < NB; ++b) { sv[b] = __builtin_bit_cast(int, silu_f(c[b * D + ks * 64 + lane])); acc[b] = 0.f; }
            const float* wp = ada_w + (size_t)(ks * 64) * 6144 + cg * 64 + lane;
#pragma unroll 16
            for (int k = 0; k < 64; ++k) { const float w = wp[(size_t)k * 6144];
#pragma unroll
                for (int b = 0; b < NB; ++b) acc[b] += __builtin_bit_cast(float, __builtin_amdgcn_readlane(sv[b], k)) * w; }
#pragma unroll
            for (int b = 0; b < NB; ++b) modp[(size_t)(ks * NB + b) * 6144 + cg * 64 + lane] = acc[b];
            continue;
        }
        r -= P0_MODT;
        if (r < P0_IWIN) { const int kb = r / 96, nb = r % 96, n0 = 32 * nb, src0 = n0 + (n0 >= 1536 ? 8 : 0);
            transpose_item(w_in + (size_t)(64 * kb) * DIN + src0, DIN, Win + (size_t)n0 * D + 64 * kb, D, scr, lane); continue; }
        r -= P0_IWIN;
        if (r < P0_IWOUT) { const int kb = r / 32, nb = r % 32;
            transpose_item(w_out + (size_t)(64 * kb) * D + 32 * nb, D, Wout + (size_t)(32 * nb) * D + 64 * kb, D, scr, lane); continue; }
        r -= P0_IWOUT;
        const int e = r / P0_IEXP, q = r % P0_IEXP;
        if (q < 512) {
            const int up = q >> 8, qq = q & 255, kb = qq / 16, nb = qq % 16; const float* W = (up ? w_up : w_gate) + (size_t)e * D * DE;
            transpose_item(W + (size_t)(64 * kb) * DE + 32 * nb, DE, Wgu + ((size_t)e * 1024 + 256 * (nb / 4) + 32 * (nb % 4) + 128 * up) * D + 64 * kb, D, scr, lane);
        } else {
            const int qq = q - 512, kb = qq / 32, nb = qq % 32;
            transpose_item(w_down + (size_t)e * DE * D + (size_t)(64 * kb) * D + 32 * nb, D, Wdn + ((size_t)e * 1024 + 32 * nb) * DE + 64 * kb, DE, scr, lane);
        }
    }
}
constexpr int W16P = 1028;
__device__ __forceinline__ void p1_modulate(Frame& F, const Args& A) {
    const float* x = A.in[0]; const float* ada_b = A.in[3]; const float* w_in = A.in[4];
    const float* modp = (const float*)(A.ws + WS_MODP); float* mod = (float*)(A.ws + WS_MOD); float* dtf = (float*)(A.ws + WS_DTF); bf16* U = (bf16*)(A.ws + WS_A);
    LAS float* sh1 = (LAS float*)(F.lds + RING_OFF); LAS float* sc1 = sh1 + 1024; LAS float* W16 = sc1 + 1024;
    const int tid = F.tid, lane = F.lane;
    for (int idx = F.vcu * 512 + tid; idx < NB * 6144; idx += F.G * 512) { const int b = idx / 6144, j = idx % 6144; float s = ada_b[j];
        for (int ks = 0; ks < 16; ++ks) s += modp[(size_t)(ks * NB + b) * 6144 + j];
        mod[idx] = s; }
    for (int e = tid; e < 16 * 1024; e += 512) { const int k = e >> 4, j = e & 15; W16[j * W16P + k] = w_in[(size_t)k * DIN + (j < 8 ? 1536 + j : 3080 + (j - 8))]; }
    for (int rb = F.vcu; rb < M / 64; rb += F.G) {
    const int row0 = rb * 64, bb = row0 / T;
    __syncthreads();
    for (int j = tid; j < 2048; j += 512) { float s = ada_b[j];
        for (int ks = 0; ks < 16; ++ks) s += modp[(size_t)(ks * NB + bb) * 6144 + j];
        if (j < 1024) sh1[j] = s; else sc1[j - 1024] = 1.f + s; }
    LDS_WAIT(); __syncthreads();
    for (int rp = 0; rp < 4; ++rp) {
        const int r0 = row0 + F.wave * 8 + rp * 2;
        f32x4 u0[4], u1[4];
#pragma unroll
        for (int j = 0; j < 4; ++j) { const int cidx = 4 * lane + 256 * j; const f32x4 s = *(const LAS f32x4*)(sc1 + cidx), h = *(const LAS f32x4*)(sh1 + cidx);
            u0[j] = *(const f32x4*)(x + (size_t)r0 * D + cidx) * s + h; u1[j] = *(const f32x4*)(x + (size_t)(r0 + 1) * D + cidx) * s + h;
            u32x2 p0, p1; p0.x = pk2(u0[j][0], u0[j][1]); p0.y = pk2(u0[j][2], u0[j][3]); p1.x = pk2(u1[j][0], u1[j][1]); p1.y = pk2(u1[j][2], u1[j][3]);
            *(u32x2*)(U + (size_t)r0 * D + cidx) = p0; *(u32x2*)(U + (size_t)(r0 + 1) * D + cidx) = p1; }
        float o0 = 0.f, o1 = 0.f;
#pragma unroll 2
        for (int j16 = 0; j16 < 16; ++j16) { float a0 = 0.f, a1 = 0.f;
#pragma unroll
            for (int j = 0; j < 4; ++j) { const f32x4 w = *(const LAS f32x4*)(W16 + j16 * W16P + 4 * lane + 256 * j);
                a0 += (u0[j][0] * w[0] + u0[j][1] * w[1]) + (u0[j][2] * w[2] + u0[j][3] * w[3]); a1 += (u1[j][0] * w[0] + u1[j][1] * w[1]) + (u1[j][2] * w[2] + u1[j][3] * w[3]); }
            a0 = wave_sum(a0); a1 = wave_sum(a1); if (lane == j16) { o0 = a0; o1 = a1; } }
        if (lane < 16) { dtf[(size_t)r0 * 16 + lane] = o0; dtf[(size_t)(r0 + 1) * 16 + lane] = o1; }
    }
    }
}

__device__ __forceinline__ void p_conv(Frame& F, const Args& A, float* xact) {
    const bf16* proj = (const bf16*)(A.ws + WS_B); const float* cw = A.in[5]; const float* cb = A.in[6];
    const int gt = F.vcu * 512 + F.tid, NT = F.G * 512;
    for (int i = gt; i < M * (DXBC / 4); i += NT) { const int m = i >> 8, c4 = (i & 255) * 4, t = m % T;
        f32x4 acc = *(const f32x4*)(cb + c4);
#pragma unroll
        for (int j = 0; j < 4; ++j) { const int tt = t - 3 + j; if (tt >= 0) { const u32x2 r = *(const u32x2*)(proj + (size_t)(m - 3 + j) * PW + PC_XS + c4); const f32x4 w = *(const f32x4*)(cw + j * DXBC + c4);
            acc[0] += w[0] * bf2f(r.x); acc[1] += w[1] * bf2f(r.x >> 16); acc[2] += w[2] * bf2f(r.y); acc[3] += w[3] * bf2f(r.y >> 16); } }
        f32x4 o; o[0] = silu_f(acc[0]); o[1] = silu_f(acc[1]); o[2] = silu_f(acc[2]); o[3] = silu_f(acc[3]);
        *(f32x4*)(xact + (size_t)m * DXBC + c4) = o; }
}
__device__ __forceinline__ void p_ssd_seq(Frame& F, const Args& A, const float* xact, float* ypre, int bh) {
    const float* dtf = (const float*)(A.ws + WS_DTF);
    const int b = bh / NH, h = bh % NH, g = h / 4, p = F.tid >> 3, nq = F.tid & 7;
    const float Ah = -expf(A.in[8][h]), Dh = A.in[9][h], dtb = A.in[7][h];
    float st[16];
#pragma unroll
    for (int i = 0; i < 16; ++i) st[i] = 0.f;
    for (int t = 0; t < T; ++t) {
        const size_t m = (size_t)b * T + t;
        const float dtv = softplus_f(dtf[m * 16 + h] + dtb), dA = expf(dtv * Ah);
        const float xv = xact[m * DXBC + h * 64 + p], xd = xv * dtv;
        const f32x4* Bp = (const f32x4*)(xact + m * DXBC + 512 + g * 128 + nq * 16);
        const f32x4* Cp = (const f32x4*)(xact + m * DXBC + 768 + g * 128 + nq * 16);
        float y = 0.f;
#pragma unroll
        for (int i = 0; i < 4; ++i) { const f32x4 bv = Bp[i], cv = Cp[i];
#pragma unroll
            for (int j = 0; j < 4; ++j) { st[i * 4 + j] = dA * st[i * 4 + j] + xd * bv[j]; y += cv[j] * st[i * 4 + j]; } }
        y += __shfl_xor(y, 1); y += __shfl_xor(y, 2); y += __shfl_xor(y, 4);
        if (nq == 0) ypre[m * DSSM + h * 64 + p] = y + Dh * xv;
    }
}
__device__ __forceinline__ void p_attn_norm(Frame& F, const Args& A) {
    const bf16* proj = (const bf16*)(A.ws + WS_B); bf16* ycat = (bf16*)(A.ws + WS_A); const float* ng = A.in[12];
    const int gw = F.vcu * NWAVES + F.wave, NGW = F.G * NWAVES, lane = F.lane;
    const f32x4 g0 = *(const f32x4*)(ng + lane * 8), g1 = *(const f32x4*)(ng + lane * 8 + 4);
    for (int m = gw; m < M; m += NGW) {
        const u32x4 r = *(const u32x4*)(proj + (size_t)m * PW + PC_Q + lane * 8);
        float v[8] = {bf2f(r.x), bf2f(r.x >> 16), bf2f(r.y), bf2f(r.y >> 16), bf2f(r.z), bf2f(r.z >> 16), bf2f(r.w), bf2f(r.w >> 16)}; float ss = 0.f;
#pragma unroll
        for (int j = 0; j < 8; ++j) ss += v[j] * v[j];
        const float rs = 1.f / sqrtf(wave_sum(ss) * (1.f / 512.f) + EPS);
        u32x4 o; o.x = pk2(v[0] * rs * g0[0], v[1] * rs * g0[1]); o.y = pk2(v[2] * rs * g0[2], v[3] * rs * g0[3]); o.z = pk2(v[4] * rs * g1[0], v[5] * rs * g1[1]); o.w = pk2(v[6] * rs * g1[2], v[7] * rs * g1[3]);
        *(u32x4*)(ycat + (size_t)m * D + 512 + lane * 8) = o; }
}
__device__ __forceinline__ void p_ssm_norm(Frame& F, const Args& A, const float* ypre) {
    const bf16* proj = (const bf16*)(A.ws + WS_B); bf16* ycat = (bf16*)(A.ws + WS_A); const float* ng = A.in[10];
    const int gw = F.vcu * NWAVES + F.wave, NGW = F.G * NWAVES, lane = F.lane;
    for (int w = gw; w < M * 2; w += NGW) { const int m = w >> 1, g = w & 1, c = g * 256 + lane * 4;
        const f32x4 y = *(const f32x4*)(ypre + (size_t)m * DSSM + c), gg = *(const f32x4*)(ng + c); const u32x2 z = *(const u32x2*)(proj + (size_t)m * PW + PC_Z + c);
        float v[4] = {y[0] * silu_f(bf2f(z.x)), y[1] * silu_f(bf2f(z.x >> 16)), y[2] * silu_f(bf2f(z.y)), y[3] * silu_f(bf2f(z.y >> 16))};
        const float rs = 1.f / sqrtf(wave_sum((v[0] * v[0] + v[1] * v[1]) + (v[2] * v[2] + v[3] * v[3])) * (1.f / 256.f) + EPS);
        u32x2 o; o.x = pk2(v[0] * rs * gg[0], v[1] * rs * gg[1]); o.y = pk2(v[2] * rs * gg[2], v[3] * rs * gg[3]);
        *(u32x2*)(ycat + (size_t)m * D + c) = o; }
}
__device__ __forceinline__ void p_ln1_router(Frame& F, const Args& A) {
    const float* x = A.in[0]; float* hx1 = A.out; const float* mod = (const float*)(A.ws + WS_MOD); const float* g1 = A.in[14]; const float* b1 = A.in[15];
    const float* rgw = A.in[16]; const float* rgb = A.in[17]; const float* rew = A.in[18]; const float* reb = A.in[19];
    bf16* u2 = (bf16*)(A.ws + WS_B); unsigned* cnt = (unsigned*)(A.ws + WS_CTL) + CW_CNT; int* list = (int*)(A.ws + WS_LIST); float* tokw = (float*)(A.ws + WS_TOKW);
    const int lane = F.lane; LAS f32x4* ub = (LAS f32x4*)(F.lds + RING_OFF + F.wave * 16384);
    const int gw = F.vcu * NWAVES + F.wave, NGW = F.G * NWAVES;
    for (int m0 = gw * 4; m0 < M; m0 += NGW * 4) {
        const float* mb = mod + (m0 / T) * 6144;
        float u[4][16]; float gl[4][4];
#pragma unroll
        for (int r = 0; r < 4; ++r) { const int m = m0 + r;
            float v[16]; float s = 0.f;
#pragma unroll
            for (int j = 0; j < 4; ++j) { const int c = 4 * lane + 256 * j; const f32x4 xv = *(const f32x4*)(x + (size_t)m * D + c), hv = *(const f32x4*)(hx1 + (size_t)m * D + c), gt = *(const f32x4*)(mb + 2 * D + c);
#pragma unroll
                for (int i = 0; i < 4; ++i) { v[j * 4 + i] = ALPHA * xv[i] + (1.f + gt[i]) * hv[i]; s += v[j * 4 + i]; } }
            const float mean = wave_sum(s) * (1.f / D); float s2 = 0.f;
#pragma unroll
            for (int i = 0; i < 16; ++i) { v[i] -= mean; s2 += v[i] * v[i]; }
            const float rstd = 1.f / sqrtf(wave_sum(s2) * (1.f / D) + EPS);
            float ga[4] = {0.f, 0.f, 0.f, 0.f};
#pragma unroll
            for (int j = 0; j < 4; ++j) { const int c = 4 * lane + 256 * j; const f32x4 gg = *(const f32x4*)(g1 + c), bb = *(const f32x4*)(b1 + c), sc = *(const f32x4*)(mb + 4 * D + c), sh = *(const f32x4*)(mb + 3 * D + c);
                f32x4 x1;
#pragma unroll
                for (int i = 0; i < 4; ++i) { x1[i] = v[j * 4 + i] * rstd * gg[i] + bb[i]; u[r][j * 4 + i] = x1[i] * (1.f + sc[i]) + sh[i]; }
                *(f32x4*)(hx1 + (size_t)m * D + c) = x1;
                u32x2 pk; pk.x = pk2(u[r][j * 4], u[r][j * 4 + 1]); pk.y = pk2(u[r][j * 4 + 2], u[r][j * 4 + 3]); *(u32x2*)(u2 + (size_t)m * D + c) = pk;
#pragma unroll
                for (int i = 0; i < 4; ++i) { const f32x4 wg = *(const f32x4*)(rgw + (size_t)(c + i) * 4);
#pragma unroll
                    for (int q = 0; q < 4; ++q) ga[q] += u[r][j * 4 + i] * wg[q]; } }
#pragma unroll
            for (int q = 0; q < 4; ++q) gl[r][q] = wave_sum(ga[q]) + rgb[q];
        }
#pragma unroll
        for (int j = 0; j < 4; ++j)
#pragma unroll
            for (int i = 0; i < 4; ++i) ub[i * 256 + j * 64 + lane] = (f32x4){u[0][j * 4 + i], u[1][j * 4 + i], u[2][j * 4 + i], u[3][j * 4 + i]};
        LDS_WAIT(); asm volatile("" ::: "memory");
        f32x4 acc = {0.f, 0.f, 0.f, 0.f};
        { const int jx = lane & 31, half = lane >> 5;
          for (int i2 = 0; i2 < 2; ++i2) { const int i = half * 2 + i2;
            for (int jj = 0; jj < 4; ++jj) { const float* wp = rew + (size_t)(256 * jj + i) * 32 + jx; const LAS f32x4* up = ub + i * 256 + jj * 64;
#pragma unroll 8
                for (int l = 0; l < 64; ++l) { const float w = wp[(size_t)l * 128]; const f32x4 uv = up[l]; acc[0] += w * uv[0]; acc[1] += w * uv[1]; acc[2] += w * uv[2]; acc[3] += w * uv[3]; } } } }
#pragma unroll
        for (int r = 0; r < 4; ++r) acc[r] += __shfl_xor(acc[r], 32);
        LDS_WAIT(); asm volatile("" ::: "memory");
#pragma unroll
        for (int r = 0; r < 4; ++r) { const int m = m0 + r;
            float mx = gl[r][0]; int gi = 0;
#pragma unroll
            for (int i = 1; i < 4; ++i) if (gl[r][i] > mx) { mx = gl[r][i]; gi = i; }
            float se = 0.f;
#pragma unroll
            for (int i = 0; i < 4; ++i) se += expf(gl[r][i] - mx);
            const float gp = 1.f / se;
            const float mine = acc[r] + reb[lane & 31];
            float pe[8]; float mxe = -INFINITY;
#pragma unroll
            for (int i = 0; i < 8; ++i) { pe[i] = __shfl(mine, gi * 8 + i); mxe = fmaxf(mxe, pe[i]); }
#pragma unroll
            for (int i = 0; i < 8; ++i) pe[i] = expf(pe[i] - mxe);
            int i1 = 0; float p1 = -1.f;
#pragma unroll
            for (int i = 0; i < 8; ++i) if (pe[i] > p1) { p1 = pe[i]; i1 = i; }
            int i2 = 0; float p2 = -1.f;
#pragma unroll
            for (int i = 0; i < 8; ++i) if (i != i1 && pe[i] > p2) { p2 = pe[i]; i2 = i; }
            const float inv = 1.f / (p1 + p2);
            if (lane == 0) {
                const int e0 = gi * 8 + i1, e1 = gi * 8 + i2;
                const unsigned q0 = atomicAdd(&cnt[e0], 1u), q1 = atomicAdd(&cnt[e1], 1u);
                list[e0 * LCAP + q0] = m * 2; list[e1 * LCAP + q1] = m * 2 + 1;
                tokw[m * 2] = gp * p1 * inv; tokw[m * 2 + 1] = gp * p2 * inv;
            }
        }
    }
}
__device__ __forceinline__ void p_final(Frame& F, const Args& A) {
    float* out = A.out; const float* mod = (const float*)(A.ws + WS_MOD); const bf16* yk0 = (const bf16*)(A.ws + WS_A); const bf16* yk1 = (const bf16*)(A.ws + WS_YK1);
    const float* tokw = (const float*)(A.ws + WS_TOKW); const float* g2 = A.in[23]; const float* b2 = A.in[24];
    const int gw = F.vcu * NWAVES + F.wave, NGW = F.G * NWAVES, lane = F.lane;
    for (int m = gw; m < M; m += NGW) {
        const float* mb = mod + (m / T) * 6144; const float w0 = tokw[m * 2], w1 = tokw[m * 2 + 1];
        float v[16]; float s = 0.f;
#pragma unroll
        for (int j = 0; j < 4; ++j) { const int c = 4 * lane + 256 * j; const f32x4 xv = *(const f32x4*)(out + (size_t)m * D + c), gt = *(const f32x4*)(mb + 5 * D + c);
            const u32x2 a = *(const u32x2*)(yk0 + (size_t)m * D + c), bq = *(const u32x2*)(yk1 + (size_t)m * D + c);
            const float y0[4] = {bf2f(a.x), bf2f(a.x >> 16), bf2f(a.y), bf2f(a.y >> 16)}, y1[4] = {bf2f(bq.x), bf2f(bq.x >> 16), bf2f(bq.y), bf2f(bq.y >> 16)};
#pragma unroll
            for (int i = 0; i < 4; ++i) { v[j * 4 + i] = ALPHA * xv[i] + (1.f + gt[i]) * (w0 * y0[i] + w1 * y1[i]); s += v[j * 4 + i]; } }
        const float mean = wave_sum(s) * (1.f / D); float s2 = 0.f;
#pragma unroll
        for (int i = 0; i < 16; ++i) { v[i] -= mean; s2 += v[i] * v[i]; }
        const float rstd = 1.f / sqrtf(wave_sum(s2) * (1.f / D) + EPS);
#pragma unroll
        for (int j = 0; j < 4; ++j) { const int c = 4 * lane + 256 * j; const f32x4 gg = *(const f32x4*)(g2 + c), bb = *(const f32x4*)(b2 + c); f32x4 o;
#pragma unroll
            for (int i = 0; i < 4; ++i) o[i] = v[j * 4 + i] * rstd * gg[i] + bb[i];
            *(f32x4*)(out + (size_t)m * D + c) = o; }
    }
}

__global__ void __launch_bounds__(NWAVES * 64, 2) mk_fwd(Args args) {
    extern __shared__ __attribute__((aligned(16))) unsigned char lds[];
    Frame F;
    F.lds = (LAS unsigned char*)lds; F.MISC = (volatile LAS unsigned*)(F.lds + MISC_OFF);
    F.tid = threadIdx.x; F.lane = F.tid & 63; F.wave = __builtin_amdgcn_readfirstlane(F.tid >> 6);
    F.G = gridDim.x; { const int bx = blockIdx.x; F.vcu = (F.G % 8 == 0) ? (bx % 8) * (F.G / 8) + bx / 8 : bx; }
    F.ctl = (gu32*)(args.ws + WS_CTL);
    for (int u = F.tid; u < (LDS_BYTES - LDSCTL_OFF) / 4; u += NWAVES * 64) ((LAS unsigned*)(F.lds + LDSCTL_OFF))[u] = 0u;
    __syncthreads();
    XcdBarrier bar = xcd_barrier_post((unsigned*)(F.ctl + CW_BAR) + args.li * XCD_BAR_WORDS, F.MISC + 8);
    const int lo = args.ph_lo, hi = args.ph_hi;
#define IN(k) (lo <= (k) && (k) < hi)
#define BOTH(k) (IN(k) && IN((k) + 1))
#define GRID_BAR() xcd_barrier(bar)
#define FRESH(Fp) Frame Fp = F; { int t_ = threadIdx.x; asm volatile("" : "+v"(t_)); Fp.tid = t_; Fp.lane = t_ & 63; Fp.wave = __builtin_amdgcn_readfirstlane(t_ >> 6); }

    if (IN(0)) { FRESH(F0); p0_prologue(F0, args); if (BOTH(0)) GRID_BAR(); }
    if (IN(1)) { FRESH(F1); p1_modulate(F1, args); __syncthreads(); if (BOTH(1)) GRID_BAR(); }
    if (IN(2)) {
        pg8::Gemm g{(const bf16*)(args.ws + WS_A), (const bf16*)(args.ws + WS_WIN), D};
        pg8::StaticOrder S; S.init(M, PW, D, F.G, (int)blockIdx.x);
        pg8::EpiProj E{(bf16*)(args.ws + WS_B), PW, PC_Q, PC_K, QSCALE};
        pg8::gemm_phase<pg8::EpiProj, pg8::StaticOrder, true>(F.lds + RING_OFF, g, S, E);
        if (BOTH(2)) GRID_BAR();
    }
    if (IN(3)) {
        using namespace attn_body;
        char* shm = (char*)lds + RING_OFF;
        const float* dtf = (const float*)(args.ws + WS_DTF); const float* fg_bias = args.in[11];
        const attn_body::bf16* P = (const attn_body::bf16*)(args.ws + WS_B);
        LAS float* ckf = (LAS float*)(F.lds + RING_OFF + LDS_CKF); LAS float* wsum = (LAS float*)(F.lds + RING_OFF + LDS_WS);
        FRESH(F3);
        if (F.vcu < NB * NH * 4) {
            const int p = F.vcu; const int bh = p >> 2, s = p & 3, b = bh / NH, h = bh % NH;
            {
                const float fb = fg_bias[h]; float v[4]; float run = 0.f;
#pragma unroll
                for (int i = 0; i < 4; ++i) { const float f = dtf[(size_t)(b * T + F3.tid * 4 + i) * 16 + 8 + h] + fb; run += -softplus_f(-f); v[i] = run; }
                float incl = run; int ln = F3.lane; asm volatile("" : "+v"(ln));
#pragma unroll
                for (int o = 1; o < 64; o <<= 1) { const float t = __builtin_bit_cast(float, __builtin_amdgcn_ds_bpermute((ln - o) << 2, __builtin_bit_cast(int, incl))); if (ln >= o) incl += t; }
                if (ln == 63) wsum[F3.wave] = incl;
                LDS_WAIT(); __syncthreads();
                float off = incl - run;
                for (int w = 0; w < F3.wave; ++w) off += wsum[w];
#pragma unroll
                for (int i = 0; i < 4; ++i) ckf[F3.tid * 4 + i] = v[i] + off;
                LDS_WAIT(); __syncthreads();
            }
            for (int j = 0; j < 2; ++j) attn_unit<8>(b, h, j ? s : 7 - s, P + PC_Q, P + PC_K, P + PC_V, (attn_body::bf16*)(args.ws + WS_B) + PC_Q, shm);
        }
        __syncthreads();
        {
            const ssd::Bufs Bf{(const ::bf16*)(args.ws + WS_B), (const float*)(args.ws + WS_DTF), args.out, args.out + (size_t)M * DSSM, (::bf16*)(args.ws + WS_YK1), (::bf16*)(args.ws + WS_YK1 + 16 * MiB), (float*)(args.ws + WS_CK), (float*)(args.ws + WS_CK + 512 * 1024)};
            if (F.vcu < NB * ssd::NCH * NG) { const int u = F.vcu; ssd::chunk_unit(args, Bf, F.lds, u >> 5, (u >> 1) & 15, u & 1); }
        }
        if (BOTH(3)) GRID_BAR();
    }
    if (IN(4)) {
        const ssd::Bufs Bf{(const bf16*)(args.ws + WS_B), (const float*)(args.ws + WS_DTF), args.out, args.out + (size_t)M * DSSM, (bf16*)(args.ws + WS_YK1), (bf16*)(args.ws + WS_YK1 + 16 * MiB), (float*)(args.ws + WS_CK), (float*)(args.ws + WS_CK + 512 * 1024)};
        ssd::state_pass(Bf, F.vcu, F.G);
        { FRESH(F4); p_attn_norm(F4, args); }
        if (BOTH(4)) GRID_BAR();
    }
    if (IN(5)) {
        const ssd::Bufs Bf{(const bf16*)(args.ws + WS_B), (const float*)(args.ws + WS_DTF), args.out, args.out + (size_t)M * DSSM, (bf16*)(args.ws + WS_YK1), (bf16*)(args.ws + WS_YK1 + 16 * MiB), (float*)(args.ws + WS_CK), (float*)(args.ws + WS_CK + 512 * 1024)};
        if (F.vcu < NB * ssd::NCH * NG) { const int u = F.vcu; ssd::finalize_unit(args, Bf, F.lds, (bf16*)(args.ws + WS_A), u >> 5, (u >> 1) & 15, u & 1); }
        if (BOTH(5)) GRID_BAR();
    }
    if (IN(6)) {
        pg8::Gemm g{(const bf16*)(args.ws + WS_A), (const bf16*)(args.ws + WS_WOUT), D};
        pg8::StaticOrder S; S.init(M, D, D, F.G, (int)blockIdx.x);
        pg8::EpiF32 E{args.out, D};
        pg8::gemm_phase<pg8::EpiF32, pg8::StaticOrder, false>(F.lds + RING_OFF, g, S, E);
        if (BOTH(6)) GRID_BAR();
    }
    if (IN(7)) { FRESH(F7); p_ln1_router(F7, args); if (BOTH(7)) GRID_BAR(); }
    if (IN(8) || IN(9)) {
        int tq_ = threadIdx.x; asm volatile("" : "+v"(tq_));
        LAS unsigned* tab = (LAS unsigned*)(F.lds + TAB_OFF); LAS unsigned* cnts = tab + 192;
        if (tq_ < NE) cnts[tq_] = __hip_atomic_load(F.ctl + CW_CNT + tq_, RLX_AGENT);
        LDS_WAIT(); __syncthreads();
        if (tq_ == 0) { int nt = 0; for (int e = 0; e < NE; ++e) { const int n = (int)cnts[e]; for (int r0 = 0; r0 < n && nt < 160; r0 += 256) tab[nt++] = (unsigned)e | ((unsigned)r0 << 8); } tab[191] = (unsigned)nt; }
        LDS_WAIT(); __syncthreads();
    }
    if (IN(8)) {
        const LAS unsigned* tab = (const LAS unsigned*)(F.lds + TAB_OFF);
        pg8::Gemm g{(const bf16*)(args.ws + WS_B), (const bf16*)(args.ws + WS_WGU), D};
        pg8::MoeOrder S{tab, tab + 192, (int)tab[191], F.G, (int)blockIdx.x, 0, (const int*)(args.ws + WS_LIST)};
        pg8::EpiMoe1 E{(bf16*)(args.ws + WS_B + 32 * MiB), DE};
        pg8::gemm_phase<pg8::EpiMoe1, pg8::MoeOrder, true>(F.lds + RING_OFF, g, S, E);
        if (BOTH(8)) GRID_BAR();
    }
    if (IN(9)) {
        const LAS unsigned* tab = (const LAS unsigned*)(F.lds + TAB_OFF);
        pg8::Gemm g{(const bf16*)(args.ws + WS_B + 32 * MiB), (const bf16*)(args.ws + WS_WDN), DE};
        pg8::MoeOrder S{tab, tab + 192, (int)tab[191], F.G, (int)blockIdx.x, 1, (const int*)(args.ws + WS_LIST)};
        pg8::EpiMoe2 E{(bf16*)(args.ws + WS_A), (long)(WS_YK1 - WS_A), D, (const int*)(args.ws + WS_LIST)};
        pg8::gemm_phase<pg8::EpiMoe2, pg8::MoeOrder, true>(F.lds + RING_OFF, g, S, E);
        if (BOTH(9)) GRID_BAR();
    }
    if (IN(10)) { FRESH(F10); p_final(F10, args); }
#undef IN
#undef BOTH
}

static void launch_mk(const Args& base, int lo, int hi, int li, int grid, hipStream_t stream) {
    Args a = base; a.ph_lo = lo; a.ph_hi = hi; a.li = li; a.pad = 0;
    hipLaunchKernelGGL(mk_fwd, dim3(grid), dim3(NWAVES * 64), LDS_BYTES, stream, a);
    const hipError_t le = hipPeekAtLastError();
    if (le != hipSuccess) fprintf(stderr, "kernel_launch: launch [%d,%d) failed: %s\n", lo, hi, hipGetErrorName(le));
}
extern "C" void kernel_launch(void* const* d_in, const int* in_sizes, int n_in, void* d_out, int out_size, void* d_ws, size_t ws_size, hipStream_t stream) {
    static int grid = 0;
    if (grid == 0) {
        if (n_in != 25 || in_sizes[0] != M * D || out_size != M * D || ws_size < WS_END) { fprintf(stderr, "kernel_launch: unexpected shapes / workspace (%zu)\n", ws_size); grid = -1; return; }
        int dev = 0, cus = 0;
        if (hipGetDevice(&dev) != hipSuccess || hipDeviceGetAttribute(&cus, hipDeviceAttributeMultiprocessorCount, dev) != hipSuccess) { grid = -1; return; }
        if (hipFuncSetAttribute((const void*)mk_fwd, hipFuncAttributeMaxDynamicSharedMemorySize, LDS_BYTES) != hipSuccess) { fprintf(stderr, "kernel_launch: hipFuncSetAttribute failed\n"); grid = -1; return; }
        (void)hipGetLastError();
        grid = cus;
    }
    if (grid < 0) return;
    const float* x = (const float*)d_in[0];
    const float* conv_w = (const float*)d_in[5]; const float* conv_b = (const float*)d_in[6]; const float* dt_bias = (const float*)d_in[7];
    const float* a_log = (const float*)d_in[8]; const float* d_skip = (const float*)d_in[9]; const float* ssm_ng = (const float*)d_in[10]; const float* fg_bias = (const float*)d_in[11];
    const float* att_ng = (const float*)d_in[12]; const float* w_out = (const float*)d_in[13]; const float* ln1_g = (const float*)d_in[14]; const float* ln1_b = (const float*)d_in[15];
    const float* rgw = (const float*)d_in[16]; const float* rgb = (const float*)d_in[17]; const float* rew = (const float*)d_in[18]; const float* reb = (const float*)d_in[19];
    const float* w_gate = (const float*)d_in[20]; const float* w_up = (const float*)d_in[21]; const float* w_down = (const float*)d_in[22]; const float* ln2_g = (const float*)d_in[23]; const float* ln2_b = (const float*)d_in[24];
    unsigned char* ws = (unsigned char*)d_ws; float* out = (float*)d_out;
    unsigned* ctl = (unsigned*)(ws + WS_CTL); unsigned* cnt = ctl + CW_CNT;
    float* mod = (float*)(ws + WS_MOD); float* dtf = (float*)(ws + WS_DTF); float* ck = (float*)(ws + WS_CK);
    int* toke = (int*)(ws + WS_TOKE); float* tokw = (float*)(ws + WS_TOKW); int* toks = (int*)(ws + WS_TOKS); int* list = (int*)(ws + WS_LIST);
    bf16* proj = (bf16*)(ws + WS_B); bf16* ycat = (bf16*)(ws + WS_A); bf16* u2 = (bf16*)(ws + WS_B); bf16* hmid = (bf16*)(ws + WS_B + 32 * MiB);
    bf16* yk0 = (bf16*)(ws + WS_A); bf16* yk1 = (bf16*)(ws + WS_YK1); float* ypre = (float*)(ws + WS_YK1); float* xact = out;

    if (hipMemsetAsync(ws + WS_CTL, 0, CTL_ZERO_BYTES, stream) != hipSuccess) return;
    Args a{};
    for (int i = 0; i < 25; ++i) a.in[i] = (const float*)d_in[i];
    a.out = out; a.ws = ws;
    launch_mk(a, 0, 11, 0, grid, stream);
}
```

```cpp
#include <hip/hip_runtime.h>
#include <cstdio>
#include <cstdint>

constexpr int NB = 8, T = 2048, D = 1024, M = NB * T;
constexpr int DSSM = 512, DATT = 512, HD = 64, NH = 8, NG = 2, NST = 128, DXBC = 1024, DIN = 3088;
constexpr int NE = 32, DE = 512, LCAP = 16384;
constexpr int PW = 3072;
constexpr int PC_Z = 0, PC_XS = 512, PC_Q = 1536, PC_K = 2048, PC_V = 2560;
constexpr float ALPHA = 1.189207115002721f;
constexpr float EPS = 1e-5f;
constexpr float LOG2E = 1.4426950408889634f;
constexpr float QSCALE = 0.125f * LOG2E;
constexpr int MAXSLOT = 160 * 256;

constexpr size_t MiB = 1u << 20;
constexpr size_t WS_CTL = 0, CTL_ZERO_BYTES = 1 * MiB;
constexpr size_t WS_WIN = 1 * MiB, WS_WOUT = 7 * MiB, WS_WGU = 9 * MiB, WS_WDN = 73 * MiB;
constexpr size_t WS_A = 105 * MiB;
constexpr size_t WS_B = 137 * MiB;
constexpr size_t WS_YK1 = 233 * MiB;
constexpr size_t WS_MISC = 265 * MiB;
constexpr size_t WS_MOD = WS_MISC;
constexpr size_t WS_DTF = WS_MISC + 1 * MiB;
constexpr size_t WS_CK = WS_MISC + 2 * MiB;
constexpr size_t WS_TOKE = WS_MISC + 3 * MiB;
constexpr size_t WS_TOKW = WS_TOKE + 256 * 1024;
constexpr size_t WS_TOKS = WS_TOKW + 256 * 1024;
constexpr size_t WS_LIST = WS_MISC + 4 * MiB;
constexpr size_t WS_MODP = WS_YK1;
constexpr size_t WS_W16B = WS_CK + 768 * 1024;
constexpr size_t WS_END = 272 * MiB;
constexpr int CW_CNT = 1024;

typedef unsigned short bf16;
typedef float f32x4 __attribute__((ext_vector_type(4)));
typedef unsigned u32x4 __attribute__((ext_vector_type(4)));
typedef unsigned u32x2 __attribute__((ext_vector_type(2)));

__device__ __forceinline__ unsigned f2bf(float f) { unsigned u = __builtin_bit_cast(unsigned, f); return (u + 0x7fffu + ((u >> 16) & 1u)) >> 16; }
__device__ __forceinline__ float bf2f(unsigned b) { return __builtin_bit_cast(float, (b & 0xffffu) << 16); }
__device__ __forceinline__ unsigned pk2(float lo, float hi) { return f2bf(lo) | (f2bf(hi) << 16); }
__device__ __forceinline__ float silu_f(float x) { return x / (1.f + expf(-x)); }
__device__ __forceinline__ float softplus_f(float x) { return fmaxf(x, 0.f) + log1pf(expf(-fabsf(x))); }
__device__ __forceinline__ float wave_sum(float v) {
#pragma unroll
    for (int o = 1; o < 64; o <<= 1) v += __shfl_xor(v, o);
    return v;
}

namespace nv {
__global__ void __launch_bounds__(256) k_mod(const float* c, const float* ada_w, const float* ada_b, float* mod) {
    const int j = blockIdx.x * 256 + threadIdx.x;
    __shared__ float sc[NB][D];
    for (int i = threadIdx.x; i < NB * D; i += 256) sc[i / D][i % D] = silu_f(c[i]);
    __syncthreads();
    float acc[NB];
#pragma unroll
    for (int b = 0; b < NB; ++b) acc[b] = 0.f;
    for (int k = 0; k < D; ++k) { const float w = ada_w[(size_t)k * 6144 + j];
#pragma unroll
        for (int b = 0; b < NB; ++b) acc[b] += sc[b][k] * w; }
#pragma unroll
    for (int b = 0; b < NB; ++b) mod[b * 6144 + j] = acc[b] + ada_b[j];
}

template <bool DUAL, class Ctx>
__global__ void __launch_bounds__(256) k_gemm(Ctx cx) {
    __shared__ float As[16][68], Bs[16][68], Bs2[DUAL ? 16 : 1][68];
    __shared__ int s_info[4];
    if (!cx.setup(s_info)) return;
    __syncthreads();
    const int tm = blockIdx.y * 64, tn = blockIdx.x * 64, tid = threadIdx.x, tx = tid & 15, ty = tid >> 4;
    const int K = cx.K();
    float acc[4][4], acc2[4][4];
#pragma unroll
    for (int i = 0; i < 4; ++i)
#pragma unroll
        for (int j = 0; j < 4; ++j) { acc[i][j] = 0.f; acc2[i][j] = 0.f; }
    for (int k0 = 0; k0 < K; k0 += 16) {
#pragma unroll
        for (int i = 0; i < 4; ++i) { const int idx = tid + i * 256, r = idx >> 4, kk = idx & 15; As[kk][r] = cx.a(s_info, tm + r, k0 + kk); }
#pragma unroll
        for (int i = 0; i < 4; ++i) { const int idx = tid + i * 256, kk = idx >> 6, n = idx & 63; Bs[kk][n] = cx.b(s_info, k0 + kk, tn + n); if (DUAL) Bs2[kk][n] = cx.b2(s_info, k0 + kk, tn + n); }
        __syncthreads();
#pragma unroll
        for (int kk = 0; kk < 16; ++kk) {
            float a[4], b[4], b2[4];
#pragma unroll
            for (int i = 0; i < 4; ++i) { a[i] = As[kk][ty * 4 + i]; b[i] = Bs[kk][tx * 4 + i]; b2[i] = DUAL ? Bs2[kk][tx * 4 + i] : 0.f; }
#pragma unroll
            for (int i = 0; i < 4; ++i)
#pragma unroll
                for (int j = 0; j < 4; ++j) { acc[i][j] += a[i] * b[j]; if (DUAL) acc2[i][j] += a[i] * b2[j]; }
        }
        __syncthreads();
    }
#pragma unroll
    for (int i = 0; i < 4; ++i)
#pragma unroll
        for (int j = 0; j < 4; ++j) cx.epi(s_info, tm + ty * 4 + i, tn + tx * 4 + j, acc[i][j], acc2[i][j]);
}

struct CxIn {
    const float* x; const float* mod; const float* w; bf16* proj; float* dtf;
    __device__ bool setup(int*) const { return true; }
    __device__ int K() const { return D; }
    __device__ float a(const int*, int m, int k) const { const int b = m / T; return x[(size_t)m * D + k] * (1.f + mod[b * 6144 + D + k]) + mod[b * 6144 + k]; }
    __device__ float b(const int*, int k, int n) const { return n < DIN ? w[(size_t)k * DIN + n] : 0.f; }
    __device__ float b2(const int*, int, int) const { return 0.f; }
    __device__ void epi(const int*, int m, int n, float v, float) const {
        if (n >= DIN) return;
        if (n < 1536) proj[(size_t)m * PW + n] = (bf16)f2bf(v);
        else if (n < 1544) dtf[m * 16 + (n - 1536)] = v;
        else if (n < 3080) { const int c = n - 8; proj[(size_t)m * PW + c] = (bf16)f2bf(c < PC_K ? v * QSCALE : v); }
        else dtf[m * 16 + 8 + (n - 3080)] = v;
    }
};
struct CxOut {
    const bf16* ycat; const float* w; float* h;
    __device__ bool setup(int*) const { return true; }
    __device__ int K() const { return D; }
    __device__ float a(const int*, int m, int k) const { return bf2f(ycat[(size_t)m * D + k]); }
    __device__ float b(const int*, int k, int n) const { return w[(size_t)k * D + n]; }
    __device__ float b2(const int*, int, int) const { return 0.f; }
    __device__ void epi(const int*, int m, int n, float v, float) const { h[(size_t)m * D + n] = v; }
};
__device__ __forceinline__ bool moe_setup(const unsigned* cnt, int* s_info) {
    const int e = blockIdx.z; const int n = (int)cnt[e];
    if ((int)blockIdx.y * 64 >= n) return false;
    if (threadIdx.x == 0) { int base = 0; for (int i = 0; i < e; ++i) base += ((int)cnt[i] + 255) / 256 * 256; s_info[0] = e; s_info[1] = n; s_info[2] = base; }
    return true;
}
struct CxMoe1 {
    const unsigned* cnt; const int* list; const bf16* u2; const float* wg; const float* wu; bf16* hmid;
    __device__ bool setup(int* s) const { return moe_setup(cnt, s); }
    __device__ int K() const { return D; }
    __device__ float a(const int* s, int m, int k) const { if (m >= s[1]) return 0.f; const int tok = list[s[0] * LCAP + m] >> 1; return bf2f(u2[(size_t)tok * D + k]); }
    __device__ float b(const int* s, int k, int n) const { return wg[((size_t)s[0] * D + k) * DE + n]; }
    __device__ float b2(const int* s, int k, int n) const { return wu[((size_t)s[0] * D + k) * DE + n]; }
    __device__ void epi(const int* s, int m, int n, float g, float u) const { if (m >= s[1]) return; hmid[(size_t)(s[2] + m) * DE + n] = (bf16)f2bf(silu_f(g) * u); }
};
struct CxMoe2 {
    const unsigned* cnt; const int* list; const bf16* hmid; const float* wd; bf16* yk0; bf16* yk1;
    __device__ bool setup(int* s) const { return moe_setup(cnt, s); }
    __device__ int K() const { return DE; }
    __device__ float a(const int* s, int m, int k) const { if (m >= s[1]) return 0.f; return bf2f(hmid[(size_t)(s[2] + m) * DE + k]); }
    __device__ float b(const int* s, int k, int n) const { return wd[((size_t)s[0] * DE + k) * D + n]; }
    __device__ float b2(const int*, int, int) const { return 0.f; }
    __device__ void epi(const int* s, int m, int n, float v, float) const { if (m >= s[1]) return; const int a = list[s[0] * LCAP + m]; bf16* y = (a & 1) ? yk1 : yk0; y[(size_t)(a >> 1) * D + n] = (bf16)f2bf(v); }
};

__global__ void k_cumf(const float* dtf, const float* fg_bias, float* ck) {
    const int bh = blockIdx.x * blockDim.x + threadIdx.x; if (bh >= NB * NH) return;
    const int b = bh / NH, h = bh % NH; const float fb = fg_bias[h]; float s = 0.f;
    for (int t = 0; t < T; ++t) { const float f = dtf[(size_t)(b * T + t) * 16 + 8 + h] + fb; s += -softplus_f(-f); ck[(size_t)bh * T + t] = s; }
}
__global__ void __launch_bounds__(256) k_conv(const bf16* proj, const float* cw, const float* cb, float* xact) {
    const size_t i = (size_t)blockIdx.x * 256 + threadIdx.x; const int m = (int)(i / DXBC), ch = (int)(i % DXBC), t = m % T;
    float acc = cb[ch];
#pragma unroll
    for (int j = 0; j < 4; ++j) { const int tt = t - 3 + j; if (tt >= 0) acc += cw[j * DXBC + ch] * bf2f(proj[(size_t)(m - 3 + j) * PW + PC_XS + ch]); }
    xact[i] = silu_f(acc);
}
__global__ void __launch_bounds__(256) k_ssd(const float* xact, const float* dtf, const float* dt_bias, const float* a_log, const float* d_skip, float* ypre) {
    const int b = blockIdx.x / NH, h = blockIdx.x % NH, g = h / 4, p = threadIdx.x >> 2, nq = threadIdx.x & 3;
    const float A = -expf(a_log[h]), Dh = d_skip[h], dtb = dt_bias[h];
    float st[32];
#pragma unroll
    for (int i = 0; i < 32; ++i) st[i] = 0.f;
    for (int t = 0; t < T; ++t) {
        const size_t m = (size_t)b * T + t;
        const float dtv = softplus_f(dtf[m * 16 + h] + dtb), dA = expf(dtv * A);
        const float xv = xact[m * DXBC + h * 64 + p], xd = xv * dtv;
        const f32x4* Bp = (const f32x4*)(xact + m * DXBC + 512 + g * 128 + nq * 32);
        const f32x4* Cp = (const f32x4*)(xact + m * DXBC + 768 + g * 128 + nq * 32);
        float y = 0.f;
#pragma unroll
        for (int i = 0; i < 8; ++i) { const f32x4 bv = Bp[i], cv = Cp[i];
#pragma unroll
            for (int j = 0; j < 4; ++j) { st[i * 4 + j] = dA * st[i * 4 + j] + xd * bv[j]; y += cv[j] * st[i * 4 + j]; } }
        y += __shfl_xor(y, 1); y += __shfl_xor(y, 2);
        if (nq == 0) ypre[m * DSSM + h * 64 + p] = y + Dh * xv;
    }
}
__global__ void __launch_bounds__(256) k_ssm_norm(const float* ypre, const bf16* proj, const float* ng, bf16* ycat) {
    const int w = (blockIdx.x * 256 + threadIdx.x) >> 6, lane = threadIdx.x & 63, m = w >> 1, g = w & 1;
    float v[4]; float ss = 0.f;
#pragma unroll
    for (int j = 0; j < 4; ++j) { const int c = g * 256 + lane * 4 + j; v[j] = ypre[(size_t)m * DSSM + c] * silu_f(bf2f(proj[(size_t)m * PW + PC_Z + c])); ss += v[j] * v[j]; }
    const float r = 1.f / sqrtf(wave_sum(ss) * (1.f / 256.f) + EPS);
#pragma unroll
    for (int j = 0; j < 4; ++j) { const int c = g * 256 + lane * 4 + j; ycat[(size_t)m * D + c] = (bf16)f2bf(v[j] * r * ng[c]); }
}
__global__ void __launch_bounds__(64) k_attn(bf16* proj, const float* ck) {
    __shared__ float Ks[64][64], Vs[64][64], cks[64];
    const int blk = blockIdx.x, qt = blk % 32, bh = blk / 32, b = bh / NH, h = bh % NH, lane = threadIdx.x;
    const int q = qt * 64 + lane; const size_t mq = (size_t)b * T + q;
    float Q[64], O[64];
#pragma unroll
    for (int d = 0; d < 64; ++d) { Q[d] = bf2f(proj[mq * PW + PC_Q + h * 64 + d]); O[d] = 0.f; }
    const float cq = ck[(size_t)bh * T + q];
    float mrun = -INFINITY, lrun = 0.f;
    for (int kt = 0; kt <= qt; ++kt) {
        __syncthreads();
        for (int i = lane; i < 64 * 64; i += 64) { const int r = i >> 6, d = i & 63; const size_t mk = (size_t)b * T + kt * 64 + r;
            Ks[r][d] = bf2f(proj[mk * PW + PC_K + h * 64 + d]); Vs[r][d] = bf2f(proj[mk * PW + PC_V + h * 64 + d]); }
        cks[lane] = ck[(size_t)bh * T + kt * 64 + lane];
        __syncthreads();
        const int jmax = (kt == qt) ? lane : 63;
        for (int j = 0; j <= jmax; ++j) {
            float s = 0.f;
#pragma unroll
            for (int d = 0; d < 64; ++d) s += Q[d] * Ks[j][d];
            s += (cq - cks[j]) * LOG2E;
            const float mn = fmaxf(mrun, s), al = exp2f(mrun - mn), pj = exp2f(s - mn);
            lrun = lrun * al + pj; mrun = mn;
#pragma unroll
            for (int d = 0; d < 64; ++d) O[d] = O[d] * al + pj * Vs[j][d];
        }
    }
    const float il = 1.f / lrun;
#pragma unroll
    for (int d = 0; d < 64; ++d) proj[mq * PW + PC_Q + h * 64 + d] = (bf16)f2bf(O[d] * il);
}
__global__ void __launch_bounds__(256) k_attn_norm(const bf16* proj, const float* ng, bf16* ycat) {
    const int m = (blockIdx.x * 256 + threadIdx.x) >> 6, lane = threadIdx.x & 63;
    float v[8]; float ss = 0.f;
#pragma unroll
    for (int j = 0; j < 8; ++j) { v[j] = bf2f(proj[(size_t)m * PW + PC_Q + lane * 8 + j]); ss += v[j] * v[j]; }
    const float r = 1.f / sqrtf(wave_sum(ss) * (1.f / 512.f) + EPS);
#pragma unroll
    for (int j = 0; j < 8; ++j) ycat[(size_t)m * D + 512 + lane * 8 + j] = (bf16)f2bf(v[j] * r * ng[lane * 8 + j]);
}
__global__ void __launch_bounds__(256) k_ln1_router(const float* x, float* hx1, const float* mod, const float* g1, const float* b1,
                                                    const float* rgw, const float* rgb, const float* rew, const float* reb,
                                                    bf16* u2, unsigned* cnt, int* list, int* toke, float* tokw, int* toks) {
    const int m = (blockIdx.x * 256 + threadIdx.x) >> 6, lane = threadIdx.x & 63, b = m / T;
    const float* mb = mod + b * 6144;
    float v[16]; float s = 0.f;
#pragma unroll
    for (int j = 0; j < 4; ++j) { const int c = 4 * lane + 256 * j; const f32x4 xv = *(const f32x4*)(x + (size_t)m * D + c), hv = *(const f32x4*)(hx1 + (size_t)m * D + c), gt = *(const f32x4*)(mb + 2 * D + c);
#pragma unroll
        for (int i = 0; i < 4; ++i) { v[j * 4 + i] = ALPHA * xv[i] + (1.f + gt[i]) * hv[i]; s += v[j * 4 + i]; } }
    const float mean = wave_sum(s) * (1.f / D); float s2 = 0.f;
#pragma unroll
    for (int i = 0; i < 16; ++i) { v[i] -= mean; s2 += v[i] * v[i]; }
    const float rstd = 1.f / sqrtf(wave_sum(s2) * (1.f / D) + EPS);
    float acc[36];
#pragma unroll
    for (int i = 0; i < 36; ++i) acc[i] = 0.f;
#pragma unroll
    for (int j = 0; j < 4; ++j) { const int c = 4 * lane + 256 * j; const f32x4 gg = *(const f32x4*)(g1 + c), bb = *(const f32x4*)(b1 + c), sc = *(const f32x4*)(mb + 4 * D + c), sh = *(const f32x4*)(mb + 3 * D + c);
        f32x4 x1, uu;
#pragma unroll
        for (int i = 0; i < 4; ++i) { x1[i] = v[j * 4 + i] * rstd * gg[i] + bb[i]; uu[i] = x1[i] * (1.f + sc[i]) + sh[i]; }
        *(f32x4*)(hx1 + (size_t)m * D + c) = x1;
        u32x2 pk; pk.x = pk2(uu[0], uu[1]); pk.y = pk2(uu[2], uu[3]); *(u32x2*)(u2 + (size_t)m * D + c) = pk;
#pragma unroll
        for (int i = 0; i < 4; ++i) { const int k = c + i; const f32x4 wg = *(const f32x4*)(rgw + (size_t)k * 4);
#pragma unroll
            for (int q = 0; q < 4; ++q) acc[q] += uu[i] * wg[q];
#pragma unroll
            for (int q8 = 0; q8 < 8; ++q8) { const f32x4 we = *(const f32x4*)(rew + (size_t)k * 32 + q8 * 4);
#pragma unroll
                for (int q = 0; q < 4; ++q) acc[4 + q8 * 4 + q] += uu[i] * we[q]; } } }
#pragma unroll
    for (int i = 0; i < 36; ++i) acc[i] = wave_sum(acc[i]);
    float lg[4]; float mx = -INFINITY; int gi = 0;
#pragma unroll
    for (int i = 0; i < 4; ++i) { lg[i] = acc[i] + rgb[i]; if (lg[i] > mx) { mx = lg[i]; gi = i; } }
    float se = 0.f;
#pragma unroll
    for (int i = 0; i < 4; ++i) se += expf(lg[i] - mx);
    const float gp = 1.f / se;
    float le[8]; float mxe = -INFINITY;
#pragma unroll
    for (int i = 0; i < 8; ++i) { float t = 0.f;
#pragma unroll
        for (int gq = 0; gq < 4; ++gq) t = (gi == gq) ? acc[4 + gq * 8 + i] + reb[gq * 8 + i] : t;
        le[i] = t; mxe = fmaxf(mxe, t); }
    float pe[8];
#pragma unroll
    for (int i = 0; i < 8; ++i) pe[i] = expf(le[i] - mxe);
    int i1 = 0; float p1 = -1.f;
#pragma unroll
    for (int i = 0; i < 8; ++i) if (pe[i] > p1) { p1 = pe[i]; i1 = i; }
    int i2 = 0; float p2 = -1.f;
#pragma unroll
    for (int i = 0; i < 8; ++i) if (i != i1 && pe[i] > p2) { p2 = pe[i]; i2 = i; }
    const float inv = 1.f / (p1 + p2);
    if (lane == 0) {
        const int e0 = gi * 8 + i1, e1 = gi * 8 + i2;
        const unsigned q0 = atomicAdd(&cnt[e0], 1u), q1 = atomicAdd(&cnt[e1], 1u);
        list[e0 * LCAP + q0] = m * 2; list[e1 * LCAP + q1] = m * 2 + 1;
        toke[m * 2] = e0; toke[m * 2 + 1] = e1; tokw[m * 2] = gp * p1 * inv; tokw[m * 2 + 1] = gp * p2 * inv; toks[m * 2] = (int)q0; toks[m * 2 + 1] = (int)q1;
    }
}
__global__ void __launch_bounds__(256) k_final(float* out, const float* mod, const bf16* yk0, const bf16* yk1, const float* tokw, const float* g2, const float* b2) {
    const int m = (blockIdx.x * 256 + threadIdx.x) >> 6, lane = threadIdx.x & 63, b = m / T;
    const float* mb = mod + b * 6144; const float w0 = tokw[m * 2], w1 = tokw[m * 2 + 1];
    float v[16]; float s = 0.f;
#pragma unroll
    for (int j = 0; j < 4; ++j) { const int c = 4 * lane + 256 * j; const f32x4 xv = *(const f32x4*)(out + (size_t)m * D + c), gt = *(const f32x4*)(mb + 5 * D + c);
        const u32x2 a = *(const u32x2*)(yk0 + (size_t)m * D + c), bq = *(const u32x2*)(yk1 + (size_t)m * D + c);
        const float y0[4] = {bf2f(a.x), bf2f(a.x >> 16), bf2f(a.y), bf2f(a.y >> 16)}, y1[4] = {bf2f(bq.x), bf2f(bq.x >> 16), bf2f(bq.y), bf2f(bq.y >> 16)};
#pragma unroll
        for (int i = 0; i < 4; ++i) { v[j * 4 + i] = ALPHA * xv[i] + (1.f + gt[i]) * (w0 * y0[i] + w1 * y1[i]); s += v[j * 4 + i]; } }
    const float mean = wave_sum(s) * (1.f / D); float s2 = 0.f;
#pragma unroll
    for (int i = 0; i < 16; ++i) { v[i] -= mean; s2 += v[i] * v[i]; }
    const float rstd = 1.f / sqrtf(wave_sum(s2) * (1.f / D) + EPS);
#pragma unroll
    for (int j = 0; j < 4; ++j) { const int c = 4 * lane + 256 * j; const f32x4 gg = *(const f32x4*)(g2 + c), bb = *(const f32x4*)(b2 + c); f32x4 o;
#pragma unroll
        for (int i = 0; i < 4; ++i) o[i] = v[j * 4 + i] * rstd * gg[i] + bb[i];
        *(f32x4*)(out + (size_t)m * D + c) = o; }
}
}
namespace pg8 {
#define PG8_LAS __attribute__((address_space(3)))
typedef unsigned short bf16_t;
typedef short bf16x8 __attribute__((ext_vector_type(8)));
typedef float f32x4 __attribute__((ext_vector_type(4)));
typedef float f32x2 __attribute__((ext_vector_type(2)));
typedef unsigned u32x4 __attribute__((ext_vector_type(4)));
constexpr int BM = 256, BK = 64, HALF = 128, HTB = HALF * BK * 2  , STAGE_BYTES = 8 * HTB, NXCD = 8, WGM = 8;

__host__ __device__ __forceinline__ int lds_byte(int r, int c) { const int st = (r >> 4) * 2 + (c >> 5), rr = r & 15, cc = c & 31, ob = rr * 64 + cc * 2; return st * 1024 + (ob ^ (((ob >> 9) & 1) << 5)); }
__host__ __device__ __forceinline__ void stage_rc(int b, int& R, int& C) { const int st = b / 1024, sb = b % 1024, swz = sb ^ (((sb >> 9) & 1) << 5); R = (st >> 1) * 16 + swz / 64; C = (st & 1) * 32 + (swz % 64) / 2; }
__host__ __device__ __forceinline__ int perm32(int rho) { const int n = rho >> 4, i = rho & 15; return 8 * (i >> 2) + 4 * n + (i & 3); }

struct Unit { int pm, pn; unsigned boff; int x0, x1, x2; };
struct Gemm { const bf16_t* A; const bf16_t* Bt; int K; };

struct StaticOrder {
    int nM, nN, nwg, G, c, K;
    __device__ void init(int M, int N, int K_, int G_, int c_) { nM = M / BM; nN = N / BM; nwg = nM * nN; G = G_; c = c_; K = K_; }
    __device__ bool next(int i, Unit& u) const {
        const long L = (long)i * G + c; if (L >= nwg) return false;
        int wgid = (int)L; { const int q = nwg / NXCD, r = nwg % NXCD, xcd = wgid % NXCD, off = wgid / NXCD; wgid = (xcd < r ? xcd * (q + 1) : r * (q + 1) + (xcd - r) * q) + off; }
        const int nig = WGM * nN, gid = wgid / nig, fm = gid * WGM, gsz = (nM - fm) < WGM ? (nM - fm) : WGM;
        u.pm = fm + ((wgid % nig) % gsz); u.pn = (wgid % nig) / gsz; u.boff = (unsigned)u.pn * (unsigned)(BM * K * 2); u.x0 = u.x1 = u.x2 = 0; return true;
    }
    __device__ __forceinline__ unsigned arow(const Unit& u, int r) const { return (unsigned)(u.pm * BM + r) * (unsigned)(K * 2); }
};

__device__ __forceinline__ unsigned cvt_pk_bf16(float lo, float hi) { unsigned r; asm volatile("v_cvt_pk_bf16_f32 %0, %1, %2" : "=v"(r) : "v"(lo), "v"(hi)); return r; }

struct EpiProj {
    static constexpr bool PERM = true;
    bf16_t* O; int ldc; int q_lo, q_hi; float qs;
    __device__ __forceinline__ void operator()(const f32x4 (&acc)[2][2][4][2], const Unit& u, int wr, int wc, int fr, int fq) const {
        const int row0 = u.pm * BM + wr * 64 + fr, colt = u.pn * BM; const float sc = (colt >= q_lo && colt < q_hi) ? qs : 1.f;
        const int col0 = colt + wc * 32 + 8 * fq;
#pragma unroll
        for (int ai = 0; ai < 2; ++ai)
#pragma unroll
            for (int m = 0; m < 4; ++m) { bf16_t* rowp = O + (size_t)(row0 + ai * HALF + m * 16) * ldc + col0;
#pragma unroll
                for (int bj = 0; bj < 2; ++bj) { const f32x4 v0 = acc[ai][bj][m][0] * sc, v1 = acc[ai][bj][m][1] * sc;
                    u32x4 w; w.x = cvt_pk_bf16(v0[0], v0[1]); w.y = cvt_pk_bf16(v0[2], v0[3]); w.z = cvt_pk_bf16(v1[0], v1[1]); w.w = cvt_pk_bf16(v1[2], v1[3]);
                    *(u32x4*)(rowp + bj * HALF) = w; } }
    }
};
struct EpiF32 {
    static constexpr bool PERM = false;
    float* O; int ldc;
    __device__ __forceinline__ void operator()(const f32x4 (&acc)[2][2][4][2], const Unit& u, int wr, int wc, int fr, int fq) const {
        const int row0 = u.pm * BM + wr * 64 + fr, col0 = u.pn * BM + wc * 32 + 4 * fq;
#pragma unroll
        for (int ai = 0; ai < 2; ++ai)
#pragma unroll
            for (int m = 0; m < 4; ++m) { float* rowp = O + (size_t)(row0 + ai * HALF + m * 16) * ldc + col0;
#pragma unroll
                for (int bj = 0; bj < 2; ++bj)
#pragma unroll
                    for (int n = 0; n < 2; ++n) *(f32x4*)(rowp + bj * HALF + n * 16) = acc[ai][bj][m][n]; }
    }
};

struct EpiMoe1 {
    static constexpr bool PERM = true;
    bf16_t* H; int ldc;
    __device__ __forceinline__ void operator()(const f32x4 (&acc)[2][2][4][2], const Unit& u, int wr, int wc, int fr, int fq) const {
        const int row0 = u.pm * BM + wr * 64 + fr, col0 = u.pn * HALF + wc * 32 + 8 * fq;
#pragma unroll
        for (int ai = 0; ai < 2; ++ai)
#pragma unroll
            for (int m = 0; m < 4; ++m) { float hv[8];
#pragma unroll
                for (int n = 0; n < 2; ++n)
#pragma unroll
                    for (int j = 0; j < 4; ++j) { const float gt = acc[ai][0][m][n][j], up = acc[ai][1][m][n][j]; hv[n * 4 + j] = gt * __builtin_amdgcn_rcpf(1.f + __expf(-gt)) * up; }
                u32x4 w; w.x = cvt_pk_bf16(hv[0], hv[1]); w.y = cvt_pk_bf16(hv[2], hv[3]); w.z = cvt_pk_bf16(hv[4], hv[5]); w.w = cvt_pk_bf16(hv[6], hv[7]);
                *(u32x4*)(H + (size_t)(row0 + ai * HALF + m * 16) * ldc + col0) = w; }
    }
};
struct EpiMoe2 {
    static constexpr bool PERM = true;
    bf16_t* Y0; long ydelta; int ldc; const int* list;
    __device__ __forceinline__ void operator()(const f32x4 (&acc)[2][2][4][2], const Unit& u, int wr, int wc, int fr, int fq) const {
        const int col0 = u.pn * BM + wc * 32 + 8 * fq; const int* lp = list + u.x0 * LCAP + u.x1;
#pragma unroll
        for (int ai = 0; ai < 2; ++ai)
#pragma unroll
            for (int m = 0; m < 4; ++m) { const int r = ai * HALF + wr * 64 + m * 16 + fr;
                if (r < u.x2) { const int a = lp[r]; bf16_t* rowp = (bf16_t*)((char*)Y0 + (long)(a & 1) * ydelta) + (size_t)(a >> 1) * ldc + col0;
#pragma unroll
                    for (int bj = 0; bj < 2; ++bj) { const f32x4 v0 = acc[ai][bj][m][0], v1 = acc[ai][bj][m][1];
                        u32x4 w; w.x = cvt_pk_bf16(v0[0], v0[1]); w.y = cvt_pk_bf16(v0[2], v0[3]); w.z = cvt_pk_bf16(v1[0], v1[1]); w.w = cvt_pk_bf16(v1[2], v1[3]);
                        *(u32x4*)(rowp + bj * HALF) = w; } } }
    }
};
struct MoeOrder {
    const PG8_LAS unsigned* tab; const PG8_LAS unsigned* cnts; int ntiles, G, c, mode; const int* list;
    __device__ bool next(int i, Unit& u) const {
        const int L = i * G + c; if (L >= ntiles * 4) return false;
        const int tile = L >> 2; const unsigned w = tab[tile]; const int e = (int)(w & 0xffu), row0 = (int)(w >> 8), rem = (int)cnts[e] - row0;
        u.pm = tile; u.pn = L & 3; u.x0 = e; u.x1 = row0; u.x2 = rem < BM ? rem : BM;
        u.boff = mode == 0 ? (unsigned)(e * 1024 + u.pn * BM) * 2048u : (unsigned)(e * 1024 + u.pn * BM) * 1024u; return true;
    }
    __device__ __forceinline__ unsigned arow(const Unit& u, int r) const {
        if (mode == 0) { const int rr = r < u.x2 ? r : 0; return (unsigned)(list[u.x0 * LCAP + u.x1 + rr] >> 1) * 2048u; }
        return (unsigned)(u.pm * BM + r) * 1024u;
    }
};

template <class Epi, class Sched, bool ALIGN_EPI>
__device__ __forceinline__ void gemm_phase(PG8_LAS unsigned char* lds, const Gemm g, const Sched& S, const Epi& E) {
    int tid_ = threadIdx.x; asm volatile("" : "+v"(tid_));
    const int tid = tid_, wid = __builtin_amdgcn_readfirstlane(tid >> 6), lane = tid & 63, wr = wid >> 2, wc = wid & 3, fr = lane & 15, fq = lane >> 4;
    const int K = g.K, nt = K / BK;
    int Rp[2], Cp[2]; unsigned voffB[2];
#pragma unroll
    for (int i = 0; i < 2; ++i) { int R, C; stage_rc(tid * 16 + i * 8192, R, C); Rp[i] = R; Cp[i] = C; const int Rb = Epi::PERM ? ((R & ~31) + perm32(R & 31)) : R; voffB[i] = (unsigned)(Rb * K + C) * 2u; }
    const size_t kstep = (size_t)(BK * 2);
    const size_t hstep = (size_t)HALF * K * 2;
    const unsigned ldsw = (unsigned)wid * 1024u;
    const int aoff = lds_byte(wr * 64 + fr, fq * 8), boff = lds_byte(wc * 32 + fr, fq * 8);
    const char* gA = (const char*)g.A;
#define PG8_SA(b, h) (((b) * 2 + (h)) * HTB)
#define PG8_SB(b, h) ((4 + (b) * 2 + (h)) * HTB)
#define PG8_STAGE(bufoff, gbase, voff) do { _Pragma("unroll") for (int _i = 0; _i < 2; ++_i) \
        __builtin_amdgcn_global_load_lds((const unsigned*)((const char*)(gbase) + (voff)[_i]), (PG8_LAS unsigned*)(lds + (bufoff) + ldsw + _i * 8192), 16, 0, 0); } while (0)
#define PG8_STAGE_A(bufoff, kb, V, h) do { _Pragma("unroll") for (int _i = 0; _i < 2; ++_i) \
        __builtin_amdgcn_global_load_lds((const unsigned*)(gA + (kb) + (V)[h][_i]), (PG8_LAS unsigned*)(lds + (bufoff) + ldsw + _i * 8192), 16, 0, 0); } while (0)
#define PG8_LDA(dst, b, h) do { _Pragma("unroll") for (int m = 0; m < 4; ++m) _Pragma("unroll") for (int k = 0; k < 2; ++k) dst[m][k] = *(const PG8_LAS bf16x8*)(lds + PG8_SA(b, h) + aoff + m * 2048 + k * 1024); } while (0)
#define PG8_LDB(dst, b, h) do { _Pragma("unroll") for (int n = 0; n < 2; ++n) _Pragma("unroll") for (int k = 0; k < 2; ++k) dst[n][k] = *(const PG8_LAS bf16x8*)(lds + PG8_SB(b, h) + boff + n * 2048 + k * 1024); } while (0)
#define PG8_MMA(ai, bj, At, Bt) do { __builtin_amdgcn_s_setprio(1); _Pragma("unroll") for (int m = 0; m < 4; ++m) _Pragma("unroll") for (int n = 0; n < 2; ++n) _Pragma("unroll") for (int k = 0; k < 2; ++k) \
        acc[ai][bj][m][n] = __builtin_amdgcn_mfma_f32_16x16x32_bf16(Bt[n][k], At[m][k], acc[ai][bj][m][n], 0, 0, 0); __builtin_amdgcn_s_setprio(0); } while (0)
#define PG8_WAIT_V(n) asm volatile("s_waitcnt vmcnt(" #n ")" ::: "memory")
#define PG8_WAIT_L(n) asm volatile("s_waitcnt lgkmcnt(" #n ")" ::: "memory")
#define PG8_BAR __builtin_amdgcn_s_barrier()
#define PG8_SCHED __builtin_amdgcn_sched_barrier(0)
    Unit cur, nxt; int ui = 0;
    if (!S.next(0, cur)) return;
    f32x4 acc[2][2][4][2];
#pragma unroll
    for (int a = 0; a < 2; ++a)
#pragma unroll
        for (int b = 0; b < 2; ++b)
#pragma unroll
            for (int m = 0; m < 4; ++m)
#pragma unroll
                for (int n = 0; n < 2; ++n) acc[a][b][m][n] = (f32x4){0.f, 0.f, 0.f, 0.f};
    bf16x8 At[4][2], B0[2][2], B1[2][2];
    unsigned vc[2][2], vn[2][2];
#pragma unroll
    for (int h = 0; h < 2; ++h)
#pragma unroll
        for (int i = 0; i < 2; ++i) vc[h][i] = S.arow(cur, h * HALF + Rp[i]) + (unsigned)(Cp[i] * 2);
    const char* cB = (const char*)g.Bt + cur.boff;
    PG8_STAGE(PG8_SB(0, 0), cB, voffB); PG8_STAGE(PG8_SB(0, 1), cB + hstep, voffB); PG8_STAGE_A(PG8_SA(0, 0), 0, vc, 0); PG8_STAGE_A(PG8_SA(0, 1), 0, vc, 1);
    if (wr == 1) PG8_BAR;
    PG8_WAIT_V(2); PG8_BAR;
    PG8_STAGE(PG8_SB(1, 0), cB + kstep, voffB); PG8_STAGE_A(PG8_SA(1, 0), kstep, vc, 0); PG8_STAGE(PG8_SB(1, 1), cB + hstep + kstep, voffB);
    PG8_WAIT_V(6); PG8_BAR;
    for (;;) {
        const bool has_next = S.next(ui + 1, nxt);
        const char* nB = has_next ? (const char*)g.Bt + nxt.boff : cB;
#pragma unroll
        for (int h = 0; h < 2; ++h)
#pragma unroll
            for (int i = 0; i < 2; ++i) vn[h][i] = has_next ? S.arow(nxt, h * HALF + Rp[i]) + (unsigned)(Cp[i] * 2) : vc[h][i];
        for (int t = 0; t < nt; t += 2) {
            const bool last = (t == nt - 2);
            const size_t k1 = (size_t)(t + 1) * kstep;
            const size_t k2 = last ? 0 : (size_t)(t + 2) * kstep, k3 = k2 + kstep;
            const char* b2 = last ? nB : cB + (size_t)(t + 2) * kstep; const char* b3 = b2 + kstep;
            unsigned v2[2][2];
#pragma unroll
            for (int h = 0; h < 2; ++h)
#pragma unroll
                for (int i = 0; i < 2; ++i) v2[h][i] = last ? vn[h][i] : vc[h][i];
            PG8_LDB(B0, 0, 0); PG8_LDB(B1, 0, 1); PG8_SCHED; PG8_LDA(At, 0, 0); PG8_STAGE_A(PG8_SA(1, 1), k1, vc, 1);
            PG8_WAIT_V(8); PG8_WAIT_L(0); PG8_BAR; PG8_MMA(0, 0, At, B0); PG8_MMA(0, 1, At, B1); PG8_BAR; PG8_SCHED;
            PG8_LDA(At, 0, 1); PG8_STAGE(PG8_SB(0, 0), b2, voffB); PG8_STAGE(PG8_SB(0, 1), b2 + hstep, voffB); PG8_STAGE_A(PG8_SA(0, 0), k2, v2, 0);
            PG8_WAIT_V(8); PG8_WAIT_L(0); PG8_BAR; PG8_MMA(1, 0, At, B0); PG8_MMA(1, 1, At, B1); PG8_BAR; PG8_SCHED;
            PG8_LDB(B0, 1, 0); PG8_LDB(B1, 1, 1); PG8_SCHED; PG8_LDA(At, 1, 0); PG8_STAGE_A(PG8_SA(0, 1), k2, v2, 1);
            PG8_WAIT_V(8); PG8_WAIT_L(0); PG8_BAR; PG8_MMA(0, 0, At, B0); PG8_MMA(0, 1, At, B1); PG8_BAR; PG8_SCHED;
            PG8_LDA(At, 1, 1); PG8_STAGE(PG8_SB(1, 0), b3, voffB); PG8_STAGE(PG8_SB(1, 1), b3 + hstep, voffB); PG8_STAGE_A(PG8_SA(1, 0), k3, v2, 0);
            PG8_WAIT_V(8); PG8_WAIT_L(0); PG8_BAR; PG8_MMA(1, 0, At, B0); PG8_MMA(1, 1, At, B1); PG8_BAR; PG8_SCHED;
        }
        if constexpr (ALIGN_EPI) { if (wr == 0) PG8_BAR; }
        E(acc, cur, wr, wc, fr, fq);
        if (!has_next) break;
#pragma unroll
        for (int a = 0; a < 2; ++a)
#pragma unroll
            for (int b = 0; b < 2; ++b)
#pragma unroll
                for (int m = 0; m < 4; ++m)
#pragma unroll
                    for (int n = 0; n < 2; ++n) acc[a][b][m][n] = (f32x4){0.f, 0.f, 0.f, 0.f};
        cur = nxt; cB = nB; ++ui;
#pragma unroll
        for (int h = 0; h < 2; ++h)
#pragma unroll
            for (int i = 0; i < 2; ++i) vc[h][i] = vn[h][i];
        if constexpr (ALIGN_EPI) { if (wr == 1) PG8_BAR; }
    }
    PG8_WAIT_V(0);
    if constexpr (!ALIGN_EPI) { if (wr == 0) PG8_BAR; }
    PG8_BAR;
#undef PG8_SA
#undef PG8_SB
#undef PG8_STAGE
#undef PG8_STAGE_A
#undef PG8_LDA
#undef PG8_LDB
#undef PG8_MMA
#undef PG8_WAIT_V
#undef PG8_WAIT_L
#undef PG8_BAR
#undef PG8_SCHED
}
}
#include <hip/hip_bf16.h>
#include <cmath>
namespace attn_body {
using bf16=__hip_bfloat16;
using bf16x8=__attribute__((ext_vector_type(8)))short;
using s16x4=__attribute__((ext_vector_type(4)))short;
using f32x16=__attribute__((ext_vector_type(16)))float;
using u32x4=__attribute__((ext_vector_type(4)))unsigned;
constexpr int BATCH=8,NHEAD=8,SEQ=2048,D=64,DM=3072;
constexpr int NW=8,QBLK=32,QB=QBLK*NW,KVBLK=64,NQB=SEQ/QB;
constexpr int ATTN_PITCH=DM, ATTN_UNIT_ROWS=QB;
__device__ __forceinline__ int crow(int r,int hi){return (r&3)+8*(r>>2)+4*hi;}
#define SBAR() __builtin_amdgcn_sched_barrier(0)
__device__ __forceinline__ void cmask(f32x16&p0,f32x16&p1,int jb,int qrel,int hi){
  const float NEG=-INFINITY; int kb=64*jb+4*hi;
  #pragma unroll
  for(int r=0;r<16;++r){int kv=kb+(r&3)+8*(r>>2); if(kv>qrel)p0[r]=NEG; if(kv+32>qrel)p1[r]=NEG;}
}

constexpr int NSLOT=3, SLOTB=8192;
constexpr int LDS_K=0, LDS_V=NSLOT*SLOTB, LDS_WS=2*NSLOT*SLOTB, LDS_OST=LDS_WS+NW*64*4, LDS_CKF=LDS_OST+NW*4096, LDS_CKP=LDS_CKF+SEQ*4, LDS_BYTES=LDS_CKP+SEQ*4;
constexpr float C2=0.125f*1.4426950408889634f;
__device__ __forceinline__ void glds16(const void*gsrc,unsigned lds_dst){unsigned keep;
  asm volatile("s_mov_b32 %0, m0\n\ts_mov_b32 m0, %2\n\ts_nop 0\n\tglobal_load_lds_dwordx4 %1, off\n\ts_mov_b32 m0, %0":"=&s"(keep):"v"(gsrc),"s"(lds_dst):"memory");}
__device__ __forceinline__ float max3f(float a,float b,float c){float r;asm("v_max3_f32 %0, %1, %2, %3":"=v"(r):"v"(a),"v"(b),"v"(c));return r;}
__device__ __forceinline__ float max2f(float a,float b){float r;asm("v_max_f32_e32 %0, %1, %2":"=v"(r):"v"(a),"v"(b));return r;}
__device__ __forceinline__ float fadd_s(float a,float b){float r;asm("v_add_f32_e32 %0, %1, %2":"=v"(r):"v"(a),"v"(b));return r;}
__device__ __forceinline__ float fsub_s(float a,float b){float r;asm("v_sub_f32_e32 %0, %1, %2":"=v"(r):"v"(a),"v"(b));return r;}
typedef float f32x2_t __attribute__((ext_vector_type(2))); typedef __bf16 bf16x2_t __attribute__((ext_vector_type(2)));
__device__ __forceinline__ unsigned cvtpk_s(float lo,float hi){f32x2_t v={lo,hi};bf16x2_t b=__builtin_convertvector(v,bf16x2_t);return __builtin_bit_cast(unsigned,b);}
#define WAIT_BAR(N) asm volatile("s_waitcnt vmcnt(" #N ") lgkmcnt(0)\n\ts_barrier":::"memory")

__device__ __forceinline__ unsigned f2bf_rne(float f){unsigned u=__float_as_uint(f);return (u+0x7fffu+((u>>16)&1u))>>16;}
__device__ __forceinline__ void qkt(f32x16&p0,f32x16&p1,const char*Kslot,const bf16x8*qr,int r32,int hi,bf16x8 kx0,bf16x8 kx1,bf16x8 qx){
  const char*kb=Kslot+hi*1024+r32*16;
  #pragma unroll
  for(int d0=0;d0<4;++d0){
    const bf16x8 b0=*reinterpret_cast<const bf16x8*>(kb+d0*2048);
    const bf16x8 b1=*reinterpret_cast<const bf16x8*>(kb+d0*2048+512);
    if(d0==0){p0=__builtin_amdgcn_mfma_f32_32x32x16_bf16(b0,qr[0],f32x16{},0,0,0);p1=__builtin_amdgcn_mfma_f32_32x32x16_bf16(b1,qr[0],f32x16{},0,0,0);}
    else{p0=__builtin_amdgcn_mfma_f32_32x32x16_bf16(b0,qr[d0],p0,0,0,0);p1=__builtin_amdgcn_mfma_f32_32x32x16_bf16(b1,qr[d0],p1,0,0,0);}}
  p0=__builtin_amdgcn_mfma_f32_32x32x16_bf16(kx0,qx,p0,0,0,0);p1=__builtin_amdgcn_mfma_f32_32x32x16_bf16(kx1,qx,p1,0,0,0);
}
typedef __attribute__((address_space(3))) const char* lds_cptr;
typedef short v4i16_t __attribute__((ext_vector_type(4)));
__device__ __forceinline__ void kload8(bf16x8*kf,lds_cptr kp){
  kf[0]=*(const __attribute__((address_space(3))) bf16x8*)(kp);      kf[1]=*(const __attribute__((address_space(3))) bf16x8*)(kp+512);
  kf[2]=*(const __attribute__((address_space(3))) bf16x8*)(kp+2048); kf[3]=*(const __attribute__((address_space(3))) bf16x8*)(kp+2560);
  kf[4]=*(const __attribute__((address_space(3))) bf16x8*)(kp+4096); kf[5]=*(const __attribute__((address_space(3))) bf16x8*)(kp+4608);
  kf[6]=*(const __attribute__((address_space(3))) bf16x8*)(kp+6144); kf[7]=*(const __attribute__((address_space(3))) bf16x8*)(kp+6656);
}
__device__ __forceinline__ void kload2(bf16x8*kf,lds_cptr kp,int j){ kf[2*j]=*(const __attribute__((address_space(3))) bf16x8*)(kp+j*2048); kf[2*j+1]=*(const __attribute__((address_space(3))) bf16x8*)(kp+j*2048+512); }
__device__ __forceinline__ s16x4 vtr(lds_cptr p){ return __builtin_bit_cast(s16x4,__builtin_amdgcn_ds_read_tr16_b64_v4i16((__attribute__((address_space(3))) v4i16_t*)p)); }
__device__ __forceinline__ float rowmax(const f32x16&p0,const f32x16&p1){
  float a=max3f(p0[0],p0[1],p1[0]),b=max3f(p0[2],p0[3],p1[1]);a=max3f(a,p1[2],p1[3]);
  #pragma unroll
  for(int r=4;r<16;r+=4){a=max3f(a,p0[r],p0[r+1]);b=max3f(b,p0[r+2],p0[r+3]);a=max3f(a,p1[r],p1[r+1]);b=max3f(b,p1[r+2],p1[r+3]);}
  const float m=max2f(a,b);
  auto rr=__builtin_amdgcn_permlane32_swap(__float_as_uint(m),__float_as_uint(m),false,false);
  return max2f(__uint_as_float(rr[0]),__uint_as_float(rr[1]));
}
__device__ __forceinline__ void pv(f32x16*o,int vb,bf16x8 pa0,bf16x8 pa1,bf16x8 pa2,bf16x8 pa3){
  #pragma unroll
  for(int d0=0;d0<2;++d0){s16x4 lo[4],hi[4];
    #pragma unroll
    for(int ks=0;ks<4;++ks){
      asm volatile("ds_read_b64_tr_b16 %0,%1 offset:%c2":"=&v"(lo[ks]):"v"(vb),"i"(d0*4096+ks*1024):"memory");
      asm volatile("ds_read_b64_tr_b16 %0,%1 offset:%c2":"=&v"(hi[ks]):"v"(vb),"i"(d0*4096+ks*1024+512):"memory");}
    asm volatile("s_waitcnt lgkmcnt(0)":::"memory");SBAR();
    #define PK(k) (bf16x8){lo[k][0],lo[k][1],lo[k][2],lo[k][3],hi[k][0],hi[k][1],hi[k][2],hi[k][3]}
    o[d0]=__builtin_amdgcn_mfma_f32_32x32x16_bf16(pa0,PK(0),o[d0],0,0,0);
    o[d0]=__builtin_amdgcn_mfma_f32_32x32x16_bf16(pa1,PK(1),o[d0],0,0,0);
    o[d0]=__builtin_amdgcn_mfma_f32_32x32x16_bf16(pa2,PK(2),o[d0],0,0,0);
    o[d0]=__builtin_amdgcn_mfma_f32_32x32x16_bf16(pa3,PK(3),o[d0],0,0,0);
    #undef PK
  }
}

#ifndef ATTN_STORE16
#define ATTN_STORE16(p,v) (*(u32x4*)(p)=(v))
#endif
template<int THRL,bool DUMMY=false> __device__ __forceinline__ void attn_unit(int b,int h,int qb,const bf16*Q,const bf16*__restrict__ K,const bf16*__restrict__ V,bf16*O,char*shm){
  int tid_=threadIdx.x; asm volatile("":"+v"(tid_)); const int tid=tid_,lane=tid&63,r32=lane&31,hi=lane>>5; const int wid=__builtin_amdgcn_readfirstlane(tid>>6);
  const long rowbase=(long)b*SEQ; const int q0=qb*QB;
  { const __attribute__((address_space(3))) float* ckf=(const __attribute__((address_space(3))) float*)((__attribute__((address_space(3))) char*)shm+LDS_CKF); __attribute__((address_space(3))) unsigned* ckpw=(__attribute__((address_space(3))) unsigned*)((__attribute__((address_space(3))) char*)shm+LDS_CKP);
    const float c0=ckf[q0];
    for(int k=tid;k<q0+QB;k+=NW*64){ const float x=(ckf[k]-c0)*1.4426950408889634f; const unsigned hb=f2bf_rne(x); const float xh=__uint_as_float(hb<<16); ckpw[k]=hb|(f2bf_rne(x-xh)<<16); }
    asm volatile("s_waitcnt lgkmcnt(0)\n\ts_barrier":::"memory"); }
  const __attribute__((address_space(3))) unsigned* ckp=(const __attribute__((address_space(3))) unsigned*)((__attribute__((address_space(3))) char*)shm+LDS_CKP);
  const bf16*Qw=Q+(rowbase+q0+wid*QBLK)*DM+h*D;
  const bf16*Kh=K+rowbase*DM+h*D,*Vh=V+rowbase*DM+h*D;
  const unsigned lds0=(unsigned)(uintptr_t)shm;
  float*wsf=(float*)(shm+LDS_WS)+wid*64;
  const bf16*ksrc=Kh+(long)lane*DM+wid*8;
  const bf16*vsrc=Vh+(long)(16*(wid&3)+(lane>>2))*DM+(wid>>2)*32+(lane&3)*8;
  const unsigned kdst=lds0+LDS_K+wid*1024, vdst=lds0+LDS_V+wid*1024;
  #define DMA_K(t,slot) glds16(ksrc+(long)(t)*KVBLK*DM,(unsigned)__builtin_amdgcn_readfirstlane(kdst+(slot)))
  #define DMA_V(t,slot) glds16(vsrc+(long)(t)*KVBLK*DM,(unsigned)__builtin_amdgcn_readfirstlane(vdst+(slot)))
  const int vb0=(int)(lds0+LDS_V)+((lane>>4)&1)*32+(lane&3)*8+(4*hi+((lane&15)>>2))*64;
  const char*Kbase=shm+LDS_K; bf16x8 kf[8];
  const lds_cptr shm3=(lds_cptr)shm; const lds_cptr kp0=shm3+LDS_K+hi*1024+r32*16; const lds_cptr vp0=shm3+LDS_V+((lane>>4)&1)*32+(lane&3)*8+(4*hi+((lane&15)>>2))*64;
  const int NT=(q0+QB)/KVBLK;
  DMA_K(0,0);DMA_V(0,0);DMA_K(1,SLOTB);
  bf16x8 qr[4];
  #pragma unroll
  for(int d0=0;d0<4;++d0)qr[d0]=*reinterpret_cast<const bf16x8*>(&Qw[(long)r32*DM+d0*16+hi*8]);
  const unsigned cqw=hi?0u:ckp[q0+wid*QBLK+r32]; bf16x8 qx=__builtin_bit_cast(bf16x8,(u32x4){hi?0u:0xbf80bf80u,cqw,0u,0u});
  #define SETQX() do{ const unsigned hb_=f2bf_rne(mhat); const unsigned mw_=hb_|(f2bf_rne(mhat-__uint_as_float(hb_<<16))<<16); qx=__builtin_bit_cast(bf16x8,(u32x4){hi?0u:0xbf80bf80u,cqw,hi?0u:mw_,0u}); }while(0)
  #define KXW(w) __builtin_bit_cast(bf16x8,(u32x4){(w),0x3f803f80u,0xbf80bf80u,0u})
  #define KX(key) __builtin_bit_cast(bf16x8,(u32x4){ckp[(key)+r32],0x3f803f80u,0xbf80bf80u,0u})
  float mhat=0.f,l_reg=0.f;f32x16 o[2];o[0]=f32x16{};o[1]=f32x16{};
  const int qrel=wid*QBLK+r32;
  #define CMASK(P0,P1,t) do{int jb_=(t)-(NT-4); if(jb_>=0)cmask(P0,P1,jb_,qrel,hi);}while(0)
  bool resc=false;
  #define START(P0,P1) do{ const float rm=rowmax(P0,P1); resc=false; \
    { const float dl=__builtin_ceilf(rm); mhat=fadd_s(mhat,dl); \
      _Pragma("unroll") for(int r=0;r<16;++r){P0[r]=fsub_s(P0[r],dl);P1[r]=fsub_s(P1[r],dl);} \
      SETQX(); } \
    _Pragma("unroll") for(int r=0;r<16;++r)P0[r]=__builtin_amdgcn_exp2f(P0[r]); }while(0)
  #define RESC() do{ if(resc){ asm volatile("s_waitcnt lgkmcnt(0)":::"memory"); \
      _Pragma("unroll") for(int d_=0;d_<2;++d_) _Pragma("unroll") for(int r=0;r<16;++r)o[d_][r]*=wsf[crow(r,hi)]; } }while(0)
  f32x16 pA0,pA1,pB0,pB1;
  int sl_prev=0,sl_cur=0,sl_next=SLOTB;
  #define ROT() do{sl_prev=sl_cur;sl_cur=sl_next;sl_next=(sl_next==(NSLOT-1)*SLOTB)?0:sl_next+SLOTB;}while(0)
  DMA_K(2,2*SLOTB);
  WAIT_BAR(3);
  qkt(pA0,pA1,Kbase,qr,r32,hi,KX(0),KX(32),qx);asm volatile("s_nop 15\n\ts_nop 7":"+v"(pA0),"+v"(pA1));CMASK(pA0,pA1,0);
  START(pA0,pA1);
  _Pragma("unroll") for(int r=0;r<16;++r)pA1[r]=__builtin_amdgcn_exp2f(pA1[r]);
  WAIT_BAR(0);
  DMA_K(3,0);DMA_V(1,SLOTB);
  ROT();
  kload8(kf,kp0+sl_cur);
  unsigned kw0=ckp[KVBLK+r32], kw1=ckp[KVBLK+32+r32];
  WAIT_BAR(2);
  s16x4 vlo[8],vhi[8]; u32x4 pw0,pw1,pw2,pw3;
  #define PKW(P,B) cvtpk_s(P[B],P[B+1])
  #define PAF(k) __builtin_bit_cast(bf16x8,pw##k)
  #define VFR(i) (bf16x8){vlo[i][0],vlo[i][1],vlo[i][2],vlo[i][3],vhi[i][0],vhi[i][1],vhi[i][2],vhi[i][3]}
  #define PIN(x) asm volatile("":"+v"(x))
  #define MX3(a,b,c) __builtin_fmaxf(__builtin_fmaxf((a),(b)),(c))
  #define GAPA(MF,A0,A1,A2,A3,W0,W1,PW) do{ MF; sacc+=A0; sacc+=A1; sacc+=A2; sacc+=A3; PIN(sacc); W0; W1; PIN(PW); SBAR(); }while(0)
  #define EX(v) __builtin_amdgcn_exp2f(v)
  #define GAPB(MF,X,B) do{ MF; X[B]=EX(X[B]); X[B+1]=EX(X[B+1]); X[B+2]=EX(X[B+2]); X[B+3]=EX(X[B+3]); PIN(X); SBAR(); }while(0)
  #define VRD(i) do{ vlo[i]=vtr(vp_+(((i)>>2)*4096+((i)&3)*1024)); vhi[i]=vtr(vp_+(((i)>>2)*4096+((i)&3)*1024+512)); }while(0)
  #define KRD(G,j) do{ if(G){ kload2(kf,kp0+sl_next,j); SBAR(); } }while(0)
  #define STEP(C0,C1,P0,P1,t,GK,GV,GL) do{ SBAR(); \
    C0=__builtin_amdgcn_mfma_f32_32x32x16_bf16(KXW(kw0),qx,f32x16{},0,0,0); C1=__builtin_amdgcn_mfma_f32_32x32x16_bf16(KXW(kw1),qx,f32x16{},0,0,0); SBAR(); \
    const lds_cptr vp_=vp0+sl_prev; \
    VRD(0); SBAR(); float sacc=(P0[0]+P0[1]); \
    GAPA(C0=__builtin_amdgcn_mfma_f32_32x32x16_bf16(kf[0],qr[0],C0,0,0,0), P0[2],P0[3],P0[4],P0[5],     pw0[0]=PKW(P0,0), pw0[1]=PKW(P0,2), pw0); \
    VRD(4); SBAR(); GAPA(C1=__builtin_amdgcn_mfma_f32_32x32x16_bf16(kf[1],qr[0],C1,0,0,0), P0[6],P0[7],P0[8],P0[9],     pw0[2]=PKW(P0,4), pw0[3]=PKW(P0,6), pw0); \
    VRD(1); SBAR(); GAPA(C0=__builtin_amdgcn_mfma_f32_32x32x16_bf16(kf[2],qr[1],C0,0,0,0),   P0[10],P0[11],P0[12],P0[13], pw1[0]=PKW(P0,8), pw1[1]=PKW(P0,10), pw1); \
    VRD(5); SBAR(); GAPA(C1=__builtin_amdgcn_mfma_f32_32x32x16_bf16(kf[3],qr[1],C1,0,0,0),   P0[14],P0[15],P1[0],P1[1],   pw1[2]=PKW(P0,12),pw1[3]=PKW(P0,14), pw1); \
    VRD(2); SBAR(); GAPA(C0=__builtin_amdgcn_mfma_f32_32x32x16_bf16(kf[4],qr[2],C0,0,0,0),   P1[2],P1[3],P1[4],P1[5],     pw2[0]=PKW(P1,0), pw2[1]=PKW(P1,2), pw2); \
    VRD(6); SBAR(); GAPA(C1=__builtin_amdgcn_mfma_f32_32x32x16_bf16(kf[5],qr[2],C1,0,0,0),   P1[6],P1[7],P1[8],P1[9],     pw2[2]=PKW(P1,4), pw2[3]=PKW(P1,6), pw2); \
    VRD(3); SBAR(); GAPA(C0=__builtin_amdgcn_mfma_f32_32x32x16_bf16(kf[6],qr[3],C0,0,0,0),   P1[10],P1[11],P1[12],P1[13], pw3[0]=PKW(P1,8), pw3[1]=PKW(P1,10), pw3); \
    VRD(7); SBAR(); GAPA(C1=__builtin_amdgcn_mfma_f32_32x32x16_bf16(kf[7],qr[3],C1,0,0,0),   P1[14],P1[15],0.f,0.f,       pw3[2]=PKW(P1,12),pw3[3]=PKW(P1,14), pw3); \
    l_reg+=sacc; \
    if(GK){DMA_K((t)+3,sl_cur);} if(GV){DMA_V((t)+1,sl_next);} \
    CMASK(C0,C1,t); \
    { float a=MX3(C0[0],C0[1],C1[0]),b=MX3(C0[2],C0[3],C1[1]); a=MX3(a,C1[2],C1[3]); \
      _Pragma("unroll") for(int r=4;r<16;r+=4){a=MX3(a,C0[r],C0[r+1]);b=MX3(b,C0[r+2],C0[r+3]);a=MX3(a,C1[r],C1[r+1]);b=MX3(b,C1[r+2],C1[r+3]);} \
      float rm=__builtin_fmaxf(a,b); { auto rr=__builtin_amdgcn_permlane32_swap(__float_as_uint(rm),__float_as_uint(rm),false,false); rm=__builtin_fmaxf(__uint_as_float(rr[0]),__uint_as_float(rr[1])); } \
      resc=false; \
      if(__builtin_expect(__any(rm>(float)THRL),0)){ const float dl=__builtin_ceilf(__builtin_fmaxf(rm,0.f)); mhat+=dl; \
        _Pragma("unroll") for(int r=0;r<16;++r){C0[r]-=dl;C1[r]-=dl;} \
        SETQX(); \
        const float f=__builtin_amdgcn_exp2f(-dl); l_reg*=f; if(hi==0)wsf[r32]=f; resc=true; } } \
    SBAR(); \
    GAPB(o[0]=__builtin_amdgcn_mfma_f32_32x32x16_bf16(PAF(0),VFR(0),o[0],0,0,0), C0,0); \
    GAPB(o[1]=__builtin_amdgcn_mfma_f32_32x32x16_bf16(PAF(0),VFR(4),o[1],0,0,0), C0,4); \
    KRD(GL,0); GAPB(o[0]=__builtin_amdgcn_mfma_f32_32x32x16_bf16(PAF(1),VFR(1),o[0],0,0,0), C0,8); \
    KRD(GL,1); GAPB(o[1]=__builtin_amdgcn_mfma_f32_32x32x16_bf16(PAF(1),VFR(5),o[1],0,0,0), C0,12); \
    KRD(GL,2); GAPB(o[0]=__builtin_amdgcn_mfma_f32_32x32x16_bf16(PAF(2),VFR(2),o[0],0,0,0), C1,0); \
    KRD(GL,3); GAPB(o[1]=__builtin_amdgcn_mfma_f32_32x32x16_bf16(PAF(2),VFR(6),o[1],0,0,0), C1,4); \
    if(GL){ kw0=ckp[((t)+1)*KVBLK+r32]; kw1=ckp[((t)+1)*KVBLK+32+r32]; SBAR(); } \
    GAPB(o[0]=__builtin_amdgcn_mfma_f32_32x32x16_bf16(PAF(3),VFR(3),o[0],0,0,0), C1,8); \
    GAPB(o[1]=__builtin_amdgcn_mfma_f32_32x32x16_bf16(PAF(3),VFR(7),o[1],0,0,0), C1,12); \
    }while(0)
  int t=1;
  #undef CMASK
  #define CMASK(P0,P1,t) do{}while(0)
  for(;t+5<NT;t+=2){
    STEP(pB0,pB1,pA0,pA1,t,true,true,true);     WAIT_BAR(2); RESC(); ROT();
    STEP(pA0,pA1,pB0,pB1,t+1,true,true,true);   WAIT_BAR(2); RESC(); ROT();
  }
  #undef CMASK
  #define CMASK(P0,P1,t) do{int jb_=(t)-(NT-4); if(jb_>=0)cmask(P0,P1,jb_,qrel,hi);}while(0)
  #define ENDW(tt) do{ if((tt)+3<NT){WAIT_BAR(2);} else if((tt)+2<NT){WAIT_BAR(1);} else {WAIT_BAR(0);} }while(0)
  for(;t+1<NT;t+=2){
    STEP(pB0,pB1,pA0,pA1,t,(t+3<NT),(t+1<NT),(t+1<NT));       ENDW(t);   RESC(); ROT();
    STEP(pA0,pA1,pB0,pB1,t+1,(t+4<NT),(t+2<NT),(t+2<NT));     ENDW(t+1); RESC(); ROT();
  }
  STEP(pB0,pB1,pA0,pA1,NT-1,false,false,false); RESC();
  { float sacc=pB0[0]+pB0[1]; _Pragma("unroll") for(int r=2;r<16;++r)sacc+=pB0[r]; _Pragma("unroll") for(int r=0;r<16;++r)sacc+=pB1[r]; l_reg+=sacc;
    pw0=(u32x4){PKW(pB0,0),PKW(pB0,2),PKW(pB0,4),PKW(pB0,6)};pw1=(u32x4){PKW(pB0,8),PKW(pB0,10),PKW(pB0,12),PKW(pB0,14)};pw2=(u32x4){PKW(pB1,0),PKW(pB1,2),PKW(pB1,4),PKW(pB1,6)};pw3=(u32x4){PKW(pB1,8),PKW(pB1,10),PKW(pB1,12),PKW(pB1,14)};
    SBAR(); pv(o,vb0+sl_cur,PAF(0),PAF(1),PAF(2),PAF(3)); }
  #undef PKW
  #undef PAF
  #undef VFR
  #undef PIN
  #undef MX3
  #undef GAPA
  #undef GAPB
  #undef EX
  #undef VRD
  #undef KRD
  #undef STEP
  #undef ENDW
  {auto rr=__builtin_amdgcn_permlane32_swap(__float_as_uint(l_reg),__float_as_uint(l_reg),false,false);l_reg=__uint_as_float(rr[0])+__uint_as_float(rr[1]);}
  if(hi==0)wsf[32+r32]=l_reg;asm volatile("s_waitcnt lgkmcnt(0)":::"memory");
  float rli[16];
  #pragma unroll
  for(int r=0;r<16;++r)rli[r]=__builtin_amdgcn_rcpf(wsf[32+crow(r,hi)]);
  bf16*Ow=O+(rowbase+q0+wid*QBLK)*DM+h*D;
  { bf16*stg=(bf16*)(shm+LDS_OST)+wid*2048;
    #pragma unroll
    for(int r=0;r<16;++r){const int orow=crow(r,hi);
      #pragma unroll
      for(int d0=0;d0<2;++d0)stg[orow*64+d0*32+r32]=__float2bfloat16(o[d0][r]*rli[r]);}
    asm volatile("s_waitcnt lgkmcnt(0)":::"memory");
    #pragma unroll
    for(int i=0;i<4;++i){const int row=i*8+(lane>>3),ch=lane&7; const u32x4 v=*(const u32x4*)(stg+row*64+ch*8); ATTN_STORE16(DUMMY?(bf16*)O+(long)threadIdx.x*8:Ow+(long)row*DM+ch*8,v);} }
  asm volatile("s_waitcnt lgkmcnt(0)\n\ts_barrier":::"memory");
  #undef KX
  #undef KXW
  #undef SETQX
  #undef DMA_K
  #undef DMA_V
  #undef CMASK
  #undef START
  #undef RESC
  #undef ROT
}
constexpr int ATTN_LDS_BYTES=LDS_BYTES;
struct AttnTensors { const bf16* Q; const bf16* K; const bf16* V; bf16* O; };
struct AttnUnit { int bh; int qb; };
#undef SBAR
#undef WAIT_BAR
}
#define GAS __attribute__((address_space(1)))
#define LAS __attribute__((address_space(3)))
typedef short bf16x8 __attribute__((ext_vector_type(8)));
typedef GAS unsigned gu32;
#define RLX_AGENT __ATOMIC_RELAXED, __HIP_MEMORY_SCOPE_AGENT
#define LDS_WAIT() asm volatile("s_waitcnt lgkmcnt(0)" ::: "memory")
#define VM_WAIT() asm volatile("s_waitcnt vmcnt(0)" ::: "memory")

struct Args {
    const float* in[25]; float* out; unsigned char* ws; int ph_lo, ph_hi, li, pad;
};

namespace ssd {
typedef float f32x16 __attribute__((ext_vector_type(16)));
typedef short s16x4 __attribute__((ext_vector_type(4)));
typedef short v4i16_t __attribute__((ext_vector_type(4)));
constexpr int L_C = 0, L_B = 32768, L_XT = 65536;
constexpr int L_TAB = 131072 + 2048;
constexpr int T_ACS = 0, T_DT = 2048, T_WS = 4096;
constexpr int NCH = T / 128;
__device__ __forceinline__ unsigned offb(unsigned row, unsigned ch) { return 256u * row + 16u * (ch ^ (((row & 3u) << 2) | ((row >> 2) & 3u))); }
__device__ __forceinline__ int crow(int r, int hi) { return (r & 3) + 8 * (r >> 2) + 4 * hi; }
__device__ __forceinline__ bf16x8 ld16(const LAS unsigned char* p) { return *(const LAS bf16x8*)p; }
__device__ __forceinline__ s16x4 ld8(const LAS unsigned char* p) { return *(const LAS s16x4*)p; }
__device__ __forceinline__ s16x4 vtr(const LAS unsigned char* p) { return __builtin_bit_cast(s16x4, __builtin_amdgcn_ds_read_tr16_b64_v4i16((LAS v4i16_t*)p)); }
__device__ __forceinline__ bf16x8 cat8(s16x4 lo, s16x4 hi) { return (bf16x8){lo[0], lo[1], lo[2], lo[3], hi[0], hi[1], hi[2], hi[3]}; }
__device__ __forceinline__ unsigned cvtpk(float lo, float hi) { unsigned r; asm volatile("v_cvt_pk_bf16_f32 %0, %1, %2" : "=v"(r) : "v"(lo), "v"(hi)); return r; }

struct Bufs { const bf16* proj; const float* dtf; float* yd; float* states; bf16* prev; bf16* cact; float* acsg; float* atot; };

__device__ __forceinline__ void chunk_unit(const Args& A, const Bufs& Bf, LAS unsigned char* lds, int b, int c, int g) {
    int tid_ = threadIdx.x; asm volatile("" : "+v"(tid_)); const int tid = tid_, lane = tid & 63, wave = __builtin_amdgcn_readfirstlane(tid >> 6), r32 = lane & 31, hi = lane >> 5;
    const int m0 = b * T + c * 128;
    LAS float* acs2 = (LAS float*)(lds + L_TAB + T_ACS); LAS float* dtl = (LAS float*)(lds + L_TAB + T_DT); LAS float* wsum = (LAS float*)(lds + L_TAB + T_WS);
    {   const int hh = tid >> 7, l = tid & 127, h = g * 4 + hh;
        const float dtv = softplus_f(Bf.dtf[(size_t)(m0 + l) * 16 + h] + A.in[7][h]);
        const float a = dtv * (-expf(A.in[8][h])) * LOG2E;
        float incl = a;
#pragma unroll
        for (int o = 1; o < 64; o <<= 1) { const float t = __shfl_up(incl, o); if (lane >= o) incl += t; }
        if (lane == 63) wsum[wave] = incl;
        LDS_WAIT(); __syncthreads();
        if (wave & 1) incl += wsum[wave - 1];
        acs2[hh * 128 + l] = incl; dtl[hh * 128 + l] = dtv;
        Bf.acsg[(size_t)(m0 + l) * 8 + h] = incl;
        if (l == 127) Bf.atot[(b * NCH + c) * 8 + h] = incl;
        LDS_WAIT(); __syncthreads();
    }
    {   const int cg = tid & 63, seg = tid >> 6;
        const int chx = cg < 32 ? g * 256 + 8 * cg : (cg < 48 ? 512 + g * 128 + 8 * (cg - 32) : 768 + g * 128 + 8 * (cg - 48));
        const float* cw = A.in[5]; const float* cb = A.in[6];
        float w[4][8], bias[8], hx[3][8];
#pragma unroll
        for (int j = 0; j < 4; ++j) { const f32x4 a0 = *(const f32x4*)(cw + j * DXBC + chx), a1 = *(const f32x4*)(cw + j * DXBC + chx + 4);
#pragma unroll
            for (int i = 0; i < 4; ++i) { w[j][i] = a0[i]; w[j][4 + i] = a1[i]; } }
        { const f32x4 a0 = *(const f32x4*)(cb + chx), a1 = *(const f32x4*)(cb + chx + 4);
#pragma unroll
          for (int i = 0; i < 4; ++i) { bias[i] = a0[i]; bias[4 + i] = a1[i]; } }
        const bf16* src = Bf.proj + (size_t)m0 * PW + PC_XS + chx;
        const int l0 = seg * 16;
#pragma unroll
        for (int j = 0; j < 3; ++j) { const int l = l0 - 3 + j; u32x4 r = {0u, 0u, 0u, 0u}; if (l >= 0 || c > 0) r = *(const u32x4*)(src + (long)l * PW);
            hx[j][0] = bf2f(r.x); hx[j][1] = bf2f(r.x >> 16); hx[j][2] = bf2f(r.y); hx[j][3] = bf2f(r.y >> 16); hx[j][4] = bf2f(r.z); hx[j][5] = bf2f(r.z >> 16); hx[j][6] = bf2f(r.w); hx[j][7] = bf2f(r.w >> 16); }
        const int hh = cg >> 3;
        for (int grp = 0; grp < 2; ++grp) {
            unsigned pk[8][4]; float ev[8];
#pragma unroll
            for (int li = 0; li < 8; ++li) { const int l = l0 + grp * 8 + li;
                const u32x4 r = *(const u32x4*)(src + (long)l * PW);
                const float cur[8] = {bf2f(r.x), bf2f(r.x >> 16), bf2f(r.y), bf2f(r.y >> 16), bf2f(r.z), bf2f(r.z >> 16), bf2f(r.w), bf2f(r.w >> 16)};
                float act[8];
#pragma unroll
                for (int i = 0; i < 8; ++i) { const float s = bias[i] + w[0][i] * hx[0][i] + w[1][i] * hx[1][i] + w[2][i] * hx[2][i] + w[3][i] * cur[i];
                    act[i] = s * __builtin_amdgcn_rcpf(1.f + __expf(-s)); hx[0][i] = hx[1][i]; hx[1][i] = hx[2][i]; hx[2][i] = cur[i]; }
                if (cg < 32) { const float dv = dtl[hh * 128 + l];
#pragma unroll
                    for (int i = 0; i < 8; ++i) { const float xv = act[i] * dv; if (li & 1) pk[i][li >> 1] = cvtpk(ev[i], xv); else ev[i] = xv; } }
                else { u32x4 o; o.x = cvtpk(act[0], act[1]); o.y = cvtpk(act[2], act[3]); o.z = cvtpk(act[4], act[5]); o.w = cvtpk(act[6], act[7]);
                    if (cg < 48) *(LAS u32x4*)(lds + L_B + offb(l, cg - 32)) = o;
                    else { *(LAS u32x4*)(lds + L_C + offb(l, cg - 48)) = o; *(u32x4*)(Bf.cact + (size_t)(m0 + l) * 256 + g * 128 + 8 * (cg - 48)) = o; } }
            }
            if (cg < 32) { const int pb = (cg & 7) * 8, lc = (l0 + grp * 8) >> 3;
#pragma unroll
                for (int i = 0; i < 8; ++i) *(LAS u32x4*)(lds + L_XT + hh * 16384 + offb(pb + i, lc)) = (u32x4){pk[i][0], pk[i][1], pk[i][2], pk[i][3]}; }
        }
        LDS_WAIT(); __syncthreads();
    }
    {   int t3_ = threadIdx.x; asm volatile("" : "+v"(t3_)); const int lane = t3_ & 63, r32 = lane & 31, hi = lane >> 5;
        const int lb = wave & 3, hp = wave >> 2, lq = 32 * lb + r32;
        bf16x8 qf[8];
#pragma unroll
        for (int ks = 0; ks < 8; ++ks) qf[ks] = ld16(lds + L_C + offb(lq, 2 * ks + hi));
        f32x16 o[2][2];
#pragma unroll
        for (int a = 0; a < 2; ++a)
#pragma unroll
            for (int d = 0; d < 2; ++d) o[a][d] = f32x16{};
        const int nst = (lb >> 1) + 1;
        for (int st = 0; st < nst; ++st) {
            f32x16 p0 = f32x16{}, p1 = f32x16{};
#pragma unroll
            for (int ks = 0; ks < 8; ++ks) { const bf16x8 k0 = ld16(lds + L_B + offb(64 * st + r32, 2 * ks + hi)), k1 = ld16(lds + L_B + offb(64 * st + 32 + r32, 2 * ks + hi));
                p0 = __builtin_amdgcn_mfma_f32_32x32x16_bf16(k0, qf[ks], p0, 0, 0, 0); p1 = __builtin_amdgcn_mfma_f32_32x32x16_bf16(k1, qf[ks], p1, 0, 0, 0); }
#pragma unroll
            for (int hh = 0; hh < 2; ++hh) { const int hl = 2 * hp + hh, h = g * 4 + hl;
                const float al = acs2[hl * 128 + lq], dsk = A.in[9][h] * __builtin_amdgcn_rcpf(dtl[hl * 128 + lq]);
                unsigned pw[4][4];
#pragma unroll
                for (int half = 0; half < 2; ++half)
#pragma unroll
                    for (int q = 0; q < 4; ++q) { const int sb = 64 * st + 32 * half + 8 * q + 4 * hi; const f32x4 as = *(const LAS f32x4*)(acs2 + hl * 128 + sb);
                        float pv[4];
#pragma unroll
                        for (int e = 0; e < 4; ++e) { const int s = sb + e; const float sv = half ? p1[q * 4 + e] : p0[q * 4 + e];
                            float v = sv * __builtin_amdgcn_exp2f(al - as[e]); v = (s <= lq) ? v : 0.f; v = (s == lq) ? v + dsk : v; pv[e] = v; }
                        pw[half * 2 + (q >> 1)][(q & 1) * 2] = cvtpk(pv[0], pv[1]); pw[half * 2 + (q >> 1)][(q & 1) * 2 + 1] = cvtpk(pv[2], pv[3]); }
#pragma unroll
                for (int d0 = 0; d0 < 2; ++d0)
#pragma unroll
                    for (int kk = 0; kk < 4; ++kk) { const int prow = 32 * d0 + r32, chn = (64 * st + 16 * kk) >> 3;
                        const s16x4 lo = ld8(lds + L_XT + hl * 16384 + offb(prow, chn) + 8 * hi), hv = ld8(lds + L_XT + hl * 16384 + offb(prow, chn + 1) + 8 * hi);
                        o[hh][d0] = __builtin_amdgcn_mfma_f32_32x32x16_bf16(__builtin_bit_cast(bf16x8, (u32x4){pw[kk][0], pw[kk][1], pw[kk][2], pw[kk][3]}), cat8(lo, hv), o[hh][d0], 0, 0, 0); }
            }
        }
#pragma unroll
        for (int hh = 0; hh < 2; ++hh)
#pragma unroll
            for (int d0 = 0; d0 < 2; ++d0)
#pragma unroll
                for (int r = 0; r < 16; ++r) Bf.yd[(size_t)(m0 + 32 * lb + crow(r, hi)) * DSSM + (g * 4 + 2 * hp + hh) * 64 + 32 * d0 + r32] = o[hh][d0][r];
    }
    {   int t4_ = threadIdx.x; asm volatile("" : "+v"(t4_)); const int lane = t4_ & 63, r32 = lane & 31, hi = lane >> 5;
        const int hl = wave >> 1, pb = wave & 1, h = g * 4 + hl, prow = 32 * pb + r32;
        const float atot = acs2[hl * 128 + 127];
        bf16x8 af[8];
#pragma unroll
        for (int ks = 0; ks < 8; ++ks) { const u32x4 raw = *(const LAS u32x4*)(lds + L_XT + hl * 16384 + offb(prow, 2 * ks + hi));
            const f32x4 d0 = *(const LAS f32x4*)(acs2 + hl * 128 + 16 * ks + 8 * hi), d1 = *(const LAS f32x4*)(acs2 + hl * 128 + 16 * ks + 8 * hi + 4);
            const float e0 = __builtin_amdgcn_exp2f(atot - d0[0]), e1 = __builtin_amdgcn_exp2f(atot - d0[1]), e2 = __builtin_amdgcn_exp2f(atot - d0[2]), e3 = __builtin_amdgcn_exp2f(atot - d0[3]);
            const float e4 = __builtin_amdgcn_exp2f(atot - d1[0]), e5 = __builtin_amdgcn_exp2f(atot - d1[1]), e6 = __builtin_amdgcn_exp2f(atot - d1[2]), e7 = __builtin_amdgcn_exp2f(atot - d1[3]);
            u32x4 sc; sc.x = cvtpk(bf2f(raw.x) * e0, bf2f(raw.x >> 16) * e1); sc.y = cvtpk(bf2f(raw.y) * e2, bf2f(raw.y >> 16) * e3); sc.z = cvtpk(bf2f(raw.z) * e4, bf2f(raw.z >> 16) * e5); sc.w = cvtpk(bf2f(raw.w) * e6, bf2f(raw.w >> 16) * e7);
            af[ks] = __builtin_bit_cast(bf16x8, sc); }
        const unsigned blk = (lane >> 4) & 1, q4 = (lane & 15) >> 2, p4 = lane & 3;
        float* sp = Bf.states + ((size_t)((b * NCH + c) * 8 + h) * 64) * 128;
        for (int nb = 0; nb < 4; ++nb) {
            f32x16 acc = f32x16{};
#pragma unroll
            for (int ks = 0; ks < 8; ++ks) {
                const s16x4 t0 = vtr(lds + L_B + offb(16 * ks + 8 * hi + q4, 4 * nb + 2 * blk + (p4 >> 1)) + 8 * (p4 & 1));
                const s16x4 t1 = vtr(lds + L_B + offb(16 * ks + 8 * hi + 4 + q4, 4 * nb + 2 * blk + (p4 >> 1)) + 8 * (p4 & 1));
                acc = __builtin_amdgcn_mfma_f32_32x32x16_bf16(af[ks], cat8(t0, t1), acc, 0, 0, 0); }
#pragma unroll
            for (int r = 0; r < 16; ++r) sp[(size_t)(32 * pb + crow(r, hi)) * 128 + 32 * nb + r32] = acc[r];
        }
    }
    LDS_WAIT(); __syncthreads();
}

__device__ __forceinline__ void state_pass(const Bufs& Bf, int vcu, int G) {
    int tid_ = threadIdx.x; asm volatile("" : "+v"(tid_));
    for (int gid = vcu * 512 + tid_; gid < NB * NH * 64 * 32; gid += G * 512) {
        const int bh = gid >> 11, p = (gid >> 5) & 63, n4 = gid & 31, b = bh >> 3, h = bh & 7;
        f32x4 run = {0.f, 0.f, 0.f, 0.f};
        for (int c = 0; c < NCH; ++c) { const size_t idx = ((size_t)((b * NCH + c) * 8 + h) * 64 + p) * 128 + 4 * n4;
            u32x2 o; o.x = cvtpk(run[0], run[1]); o.y = cvtpk(run[2], run[3]); *(u32x2*)(Bf.prev + idx) = o;
            const f32x4 s = *(const f32x4*)(Bf.states + idx); const float dec = __builtin_amdgcn_exp2f(Bf.atot[(b * NCH + c) * 8 + h]);
            run = run * dec + s; }
    }
}

__device__ __forceinline__ void finalize_unit(const Args& A, const Bufs& Bf, LAS unsigned char* lds, bf16* ycat, int b, int c, int g) {
    int tid_ = threadIdx.x; asm volatile("" : "+v"(tid_)); const int tid = tid_, lane = tid & 63, wave = __builtin_amdgcn_readfirstlane(tid >> 6), r32 = lane & 31, hi = lane >> 5;
    const int m0 = b * T + c * 128;
    LAS float* ssq = (LAS float*)(lds + L_TAB);
#pragma unroll
    for (int i = 0; i < 4; ++i) { const int e = tid + i * 512, row = e >> 4, ch = e & 15; *(LAS u32x4*)(lds + L_C + offb(row, ch)) = *(const u32x4*)(Bf.cact + (size_t)(m0 + row) * 256 + g * 128 + 8 * ch); }
    const bf16* pv = Bf.prev + ((size_t)((b * NCH + c) * 8 + g * 4) * 64) * 128;
#pragma unroll
    for (int i = 0; i < 8; ++i) { const int e = tid + i * 512, row = e >> 4, ch = e & 15; *(LAS u32x4*)(lds + L_XT + offb(row, ch)) = *(const u32x4*)(pv + (size_t)row * 128 + 8 * ch); }
    LDS_WAIT(); __syncthreads();
    const int lb = wave & 3, hp = wave >> 2, lq = 32 * lb + r32;
    bf16x8 cf[8];
#pragma unroll
    for (int ks = 0; ks < 8; ++ks) cf[ks] = ld16(lds + L_C + offb(lq, 2 * ks + hi));
    f32x16 o[2][2];
#pragma unroll
    for (int hh = 0; hh < 2; ++hh)
#pragma unroll
        for (int d0 = 0; d0 < 2; ++d0) { f32x16 acc = f32x16{};
#pragma unroll
            for (int ks = 0; ks < 8; ++ks) acc = __builtin_amdgcn_mfma_f32_32x32x16_bf16(cf[ks], ld16(lds + L_XT + offb((2 * hp + hh) * 64 + 32 * d0 + r32, 2 * ks + hi)), acc, 0, 0, 0);
            o[hh][d0] = acc; }
    float sq[16];
#pragma unroll
    for (int r = 0; r < 16; ++r) { const int m = m0 + 32 * lb + crow(r, hi); float s = 0.f;
#pragma unroll
        for (int hh = 0; hh < 2; ++hh) { const int h = g * 4 + 2 * hp + hh; const float ea = __builtin_amdgcn_exp2f(Bf.acsg[(size_t)m * 8 + h]);
#pragma unroll
            for (int d0 = 0; d0 < 2; ++d0) { const int col = h * 64 + 32 * d0 + r32;
                const float z = bf2f(Bf.proj[(size_t)m * PW + PC_Z + col]);
                const float y = (Bf.yd[(size_t)m * DSSM + col] + ea * o[hh][d0][r]) * (z * __builtin_amdgcn_rcpf(1.f + __expf(-z)));
                o[hh][d0][r] = y; s += y * y; } }
#pragma unroll
        for (int of = 1; of < 32; of <<= 1) s += __shfl_xor(s, of);
        sq[r] = s; }
    if (r32 == 0) {
#pragma unroll
        for (int r = 0; r < 16; ++r) ssq[hp * 128 + 32 * lb + crow(r, hi)] = sq[r]; }
    LDS_WAIT(); __syncthreads();
    const float* ng = A.in[10];
#pragma unroll
    for (int r = 0; r < 16; ++r) { const int lr = 32 * lb + crow(r, hi), m = m0 + lr; const float rs = 1.f / sqrtf((ssq[lr] + ssq[128 + lr]) * (1.f / 256.f) + EPS);
#pragma unroll
        for (int hh = 0; hh < 2; ++hh)
#pragma unroll
            for (int d0 = 0; d0 < 2; ++d0) { const int col = (g * 4 + 2 * hp + hh) * 64 + 32 * d0 + r32; ycat[(size_t)m * D + col] = (bf16)f2bf(o[hh][d0][r] * rs * ng[col]); } }
    LDS_WAIT(); __syncthreads();
}
}
constexpr int NWAVES = 8;
constexpr int RING_OFF = 0, RING_BYTES = 131072;
constexpr int LDSCTL_OFF = RING_BYTES, MISC_OFF = LDSCTL_OFF + 320;
constexpr int LDS_BYTES = 147456;
static_assert(MISC_OFF + 128 <= LDS_BYTES, "LDS map");
constexpr int TAB_OFF = MISC_OFF + 128;
static_assert(TAB_OFF + 224 * 4 <= LDS_BYTES, "LDS map");
constexpr int CW_TMO = 0, CW_CODE = 1, CW_BAR = 4096, MAX_BAR_REGIONS = 8;

#define XB_TMO      128
#define XB_XCNT(j)  (256  + 64 * (j))
#define XB_XSUB(j)  (1280 + 64 * (j))
#define XB_XGEN(j)  (2304 + 64 * (j))
#define XB_TOP      3328
#define XB_TOPGEN   3392
#define XCD_BAR_WORDS 3456
#define XB_SPIN_CAP (1u << 18)

__device__ __forceinline__ unsigned xb_ld(unsigned* p)              { return __hip_atomic_load(p, __ATOMIC_RELAXED, __HIP_MEMORY_SCOPE_AGENT); }
__device__ __forceinline__ unsigned xb_add(unsigned* p, unsigned v) { return __hip_atomic_fetch_add(p, v, __ATOMIC_RELAXED, __HIP_MEMORY_SCOPE_AGENT); }
__device__ __forceinline__ unsigned xb_xcc_id() { return (unsigned)__builtin_amdgcn_s_getreg((3 << 11) | 20) & 0xFu; }
#define XB_SPIN(cond, bar) do { unsigned _sp = 0; while (cond) { __builtin_amdgcn_s_sleep(1); \
    if ((++_sp & 255u) == 0u) { if (xb_ld(&(bar)[XB_TMO])) break; if (_sp > XB_SPIN_CAP) { atomicAdd(&(bar)[XB_TMO], 1u); break; } } } } while (0)

struct XcdBarrier {
    unsigned* bar; unsigned x;
    volatile LAS unsigned* st;
};

__device__ __forceinline__ XcdBarrier xcd_barrier_post(unsigned* bar, volatile LAS unsigned* st) {
    XcdBarrier b; b.bar = bar; b.x = xb_xcc_id(); b.st = st;
    if (threadIdx.x == 0) (void)xb_add(&bar[XB_XCNT(b.x)], 1u);
    return b;
}
__device__ __forceinline__ void xcd_barrier_complete(unsigned* bar, unsigned x, unsigned& nloc, unsigned& nx) {
    const unsigned G = gridDim.x * gridDim.y * gridDim.z;
    unsigned sum, cnt, mine, sp = 0u;
    for (;;) {
        sum = 0u; cnt = 0u; mine = 0u;
#pragma unroll
        for (unsigned j = 0; j < 16; ++j) { const unsigned c = xb_ld(&bar[XB_XCNT(j)]); sum += c; cnt += (c > 0u) ? 1u : 0u; mine = (j == x) ? c : mine; }
        if (sum == G) break;
        __builtin_amdgcn_s_sleep(1);
        if ((++sp & 255u) == 0u) { if (xb_ld(&bar[XB_TMO])) break; if (sp > XB_SPIN_CAP) { atomicAdd(&bar[XB_TMO], 1u); break; } }
    }
    nloc = mine > 0u ? mine : 1u; nx = cnt > 0u ? cnt : 1u;
}

__device__ __forceinline__ void xcd_barrier(const XcdBarrier& b) {
    asm volatile("s_waitcnt vmcnt(0)" ::: "memory");
    __syncthreads();
    if (threadIdx.x == 0) {
        unsigned* bar = b.bar;
        __builtin_amdgcn_s_waitcnt(0);
        unsigned nloc = b.st[0], nx = b.st[1];
        if (nloc == 0u) { xcd_barrier_complete(bar, b.x, nloc, nx); b.st[0] = nloc; b.st[1] = nx; }
        const unsigned old = xb_add(&bar[XB_XSUB(b.x)], 1u);
        const unsigned gen = old / nloc;
        if (old + 1u == (gen + 1u) * nloc) {
            __builtin_amdgcn_fence(__ATOMIC_RELEASE, "agent");
            asm volatile("s_waitcnt vmcnt(0)" ::: "memory");
            const unsigned og = xb_add(&bar[XB_TOP], 1u);
            const unsigned tg = og / nx;
            if (og + 1u == (tg + 1u) * nx) xb_add(&bar[XB_TOPGEN], 1u);
            else XB_SPIN(xb_ld(&bar[XB_TOPGEN]) == tg, bar);
            __builtin_amdgcn_fence(__ATOMIC_ACQUIRE, "agent");
            xb_add(&bar[XB_XGEN(b.x)], 1u);
            asm volatile("s_waitcnt vmcnt(0)" ::: "memory");
        } else {
            XB_SPIN(xb_ld(&bar[XB_XGEN(b.x)]) == gen, bar);
            __builtin_amdgcn_fence(__ATOMIC_ACQUIRE, "agent");
            asm volatile("s_waitcnt vmcnt(0)" ::: "memory");
        }
    }
    __syncthreads();
}


struct Frame {
    LAS unsigned char* lds; volatile LAS unsigned* MISC; gu32* ctl;
    int tid, lane, wave, vcu, G;
};

constexpr int P0_MODT = 96 * 16;
constexpr int P0_W16T = 16;
constexpr int P0_IWIN = 16 * 96, P0_IWOUT = 16 * 32, P0_IEXP = 768;
constexpr int P0_NITEM_ALL = P0_IWIN + P0_IWOUT + NE * P0_IEXP;
struct CvtItem { const float* src; bf16* dst; int ld, Kd; };
__device__ __forceinline__ CvtItem p0_item(const Args& A, int r) {
    const float* w_in = A.in[4]; const float* w_out = A.in[13]; const float* w_gate = A.in[20]; const float* w_up = A.in[21]; const float* w_down = A.in[22];
    bf16* Win = (bf16*)(A.ws + WS_WIN); bf16* Wout = (bf16*)(A.ws + WS_WOUT); bf16* Wgu = (bf16*)(A.ws + WS_WGU); bf16* Wdn = (bf16*)(A.ws + WS_WDN);
    CvtItem it;
    if (r < P0_IWIN) { const int kb = r / 96, nb = r % 96, n0 = 32 * nb, src0 = n0 + (n0 >= 1536 ? 8 : 0);
        it.src = w_in + (size_t)(64 * kb) * DIN + src0; it.ld = DIN; it.dst = Win + (size_t)n0 * D + 64 * kb; it.Kd = D; return it; }
    r -= P0_IWIN;
    if (r < P0_IWOUT) { const int kb = r / 32, nb = r % 32;
        it.src = w_out + (size_t)(64 * kb) * D + 32 * nb; it.ld = D; it.dst = Wout + (size_t)(32 * nb) * D + 64 * kb; it.Kd = D; return it; }
    r -= P0_IWOUT;
    const int e = r / P0_IEXP, q = r % P0_IEXP;
    if (q < 512) {
        const int up = q >> 8, qq = q & 255, kb = qq / 16, nb = qq % 16; const float* W = (up ? w_up : w_gate) + (size_t)e * D * DE;
        it.src = W + (size_t)(64 * kb) * DE + 32 * nb; it.ld = DE; it.dst = Wgu + ((size_t)e * 1024 + 256 * (nb / 4) + 32 * (nb % 4) + 128 * up) * D + 64 * kb; it.Kd = D;
    } else {
        const int qq = q - 512, kb = qq / 32, nb = qq % 32;
        it.src = w_down + (size_t)e * DE * D + (size_t)(64 * kb) * D + 32 * nb; it.ld = D; it.dst = Wdn + ((size_t)e * 1024 + 32 * nb) * DE + 64 * kb; it.Kd = DE;
    }
    return it;
}
__device__ __forceinline__ void p0_convert(Frame& F, const Args& A, const int lo, const int P0_NITEM);
__device__ __forceinline__ void p0_prologue(Frame& F, const Args& A) {
    LAS float* scr = (LAS float*)(F.lds + RING_OFF + F.wave * 16384);
    const int gw = F.vcu * NWAVES + F.wave, NGW = F.G * NWAVES, lane = F.lane;
    const float* c = A.in[1]; const float* ada_w = A.in[2]; const float* w_in = A.in[4];
    float* modp = (float*)(A.ws + WS_MODP); bf16* W16b = (bf16*)(A.ws + WS_W16B);
    for (int r = gw; r < P0_MODT + P0_W16T; r += NGW) {
        if (r < P0_MODT) {
            const int cg = r % 96, ks = r / 96;
            int sv[NB]; float acc[NB];
#pragma unroll
            for (int b = 0; b < NB; ++b) { sv[b] = __builtin_bit_cast(int, silu_f(c[b * D + ks * 64 + lane])); acc[b] = 0.f; }
            const float* wp = ada_w + (size_t)(ks * 64) * 6144 + cg * 64 + lane;
#pragma unroll 16
            for (int k = 0; k < 64; ++k) { const float w = wp[(size_t)k * 6144];
#pragma unroll
                for (int b = 0; b < NB; ++b) acc[b] += __builtin_bit_cast(float, __builtin_amdgcn_readlane(sv[b], k)) * w; }
#pragma unroll
            for (int b = 0; b < NB; ++b) modp[(size_t)(ks * NB + b) * 6144 + cg * 64 + lane] = acc[b];
        } else {
            const int k = (r - P0_MODT) * 64 + lane;
#pragma unroll
            for (int j = 0; j < 16; ++j) W16b[j * D + k] = (bf16)f2bf(w_in[(size_t)k * DIN + (j < 8 ? 1536 + j : 3080 + (j - 8))]);
        }
    }
    p0_convert(F, A, 0, P0_IWIN + P0_IWOUT);
}
__device__ __forceinline__ void p0_convert(Frame& F, const Args& A, const int lo, const int P0_NITEM) {
    LAS float* scr = (LAS float*)(F.lds + RING_OFF + F.wave * 16384);
    const int gw = F.vcu * NWAVES + F.wave, NGW = F.G * NWAVES, lane = F.lane;
    int it = lo + gw;
    CvtItem cur = p0_item(A, it < P0_NITEM ? it : 0); float v[32];
    if (it < P0_NITEM) {
#pragma unroll
        for (int i = 0; i < 32; ++i) v[i] = cur.src[(size_t)(2 * i + (lane >> 5)) * cur.ld + (lane & 31)]; }
    while (it < P0_NITEM) {
        const int nx = it + NGW; const bool hn = nx < P0_NITEM;
        const CvtItem nxt = p0_item(A, hn ? nx : it); float w[32];
        if (hn) {
#pragma unroll
            for (int i = 0; i < 32; ++i) w[i] = nxt.src[(size_t)(2 * i + (lane >> 5)) * nxt.ld + (lane & 31)]; }
#pragma unroll
        for (int i = 0; i < 32; ++i) scr[(2 * i + (lane >> 5)) * 33 + (lane & 31)] = v[i];
        LDS_WAIT(); asm volatile("" ::: "memory");
        const int cc = lane & 7;
#pragma unroll
        for (int j = 0; j < 4; ++j) { const int n = (lane >> 3) + 8 * j; const LAS float* s = scr + (8 * cc) * 33 + n;
            u32x4 o; o.x = pk2(s[0 * 33], s[1 * 33]); o.y = pk2(s[2 * 33], s[3 * 33]); o.z = pk2(s[4 * 33], s[5 * 33]); o.w = pk2(s[6 * 33], s[7 * 33]);
            *(GAS u32x4*)(cur.dst + (size_t)n * cur.Kd + 8 * cc) = o; }
        LDS_WAIT(); asm volatile("" ::: "memory");
#pragma unroll
        for (int i = 0; i < 32; ++i) v[i] = w[i];
        cur = nxt; it = nx;
    }
}
__device__ __forceinline__ void p1_modulate(Frame& F, const Args& A) {
    const float* x = A.in[0]; const float* ada_b = A.in[3];
    const float* modp = (const float*)(A.ws + WS_MODP); float* mod = (float*)(A.ws + WS_MOD); bf16* U = (bf16*)(A.ws + WS_A);
    LAS float* sh1 = (LAS float*)(F.lds + RING_OFF); LAS float* sc1 = sh1 + 1024;
    const int tid = F.tid, lane = F.lane;
    for (int idx = F.vcu * 512 + tid; idx < NB * 6144; idx += F.G * 512) { const int b = idx / 6144, j = idx % 6144; float s = ada_b[j];
#pragma unroll
        for (int ks = 0; ks < 16; ++ks) s += modp[(size_t)(ks * NB + b) * 6144 + j];
        mod[idx] = s; }
    for (int rb = F.vcu; rb < M / 64; rb += F.G) {
        const int row0 = rb * 64, bb = row0 / T;
        __syncthreads();
        for (int j = tid; j < 2048; j += 512) { float s = ada_b[j];
#pragma unroll
            for (int ks = 0; ks < 16; ++ks) s += modp[(size_t)(ks * NB + bb) * 6144 + j];
            if (j < 1024) sh1[j] = s; else sc1[j - 1024] = 1.f + s; }
        LDS_WAIT(); __syncthreads();
#pragma unroll
        for (int rp = 0; rp < 2; ++rp) { const int r0 = row0 + F.wave * 8 + rp * 4;
            f32x4 xv[4][4];
#pragma unroll
            for (int r = 0; r < 4; ++r)
#pragma unroll
                for (int j = 0; j < 4; ++j) xv[r][j] = *(const f32x4*)(x + (size_t)(r0 + r) * D + 4 * lane + 256 * j);
#pragma unroll
            for (int j = 0; j < 4; ++j) { const int cidx = 4 * lane + 256 * j; const f32x4 sc = *(const LAS f32x4*)(sc1 + cidx), sh = *(const LAS f32x4*)(sh1 + cidx);
#pragma unroll
                for (int r = 0; r < 4; ++r) { const f32x4 u = xv[r][j] * sc + sh; u32x2 pk; pk.x = pk2(u[0], u[1]); pk.y = pk2(u[2], u[3]); *(u32x2*)(U + (size_t)(r0 + r) * D + cidx) = pk; } }
        }
    }
}
__device__ __forceinline__ void p2_dtf_tail(Frame& F, const Args& A) {
    typedef float f32x4v __attribute__((ext_vector_type(4)));
    const bf16* U = (const bf16*)(A.ws + WS_A); const bf16* W16b = (const bf16*)(A.ws + WS_W16B); float* dtf = (float*)(A.ws + WS_DTF);
    LAS f32x4v* part = (LAS f32x4v*)(F.lds + RING_OFF);
    const int lane = F.lane, rb = F.wave & 3, kh = F.wave >> 2, i16 = lane & 15, kq = lane >> 4;
    for (int blk = F.vcu; blk < M / 64; blk += F.G) {
        const bf16* ap = U + (size_t)(blk * 64 + rb * 16 + i16) * D + kh * 512 + 8 * kq; const bf16* bp = W16b + (size_t)i16 * D + kh * 512 + 8 * kq;
        f32x4v acc = {0.f, 0.f, 0.f, 0.f};
#pragma unroll 4
        for (int ks = 0; ks < 16; ++ks) acc = __builtin_amdgcn_mfma_f32_16x16x32_bf16(*(const bf16x8*)(ap + 32 * ks), *(const bf16x8*)(bp + 32 * ks), acc, 0, 0, 0);
        __syncthreads();
        if (kh == 1) part[rb * 64 + lane] = acc;
        LDS_WAIT(); __syncthreads();
        if (kh == 0) { const f32x4v o = acc + part[rb * 64 + lane];
#pragma unroll
            for (int r = 0; r < 4; ++r) dtf[(size_t)(blk * 64 + rb * 16 + 4 * kq + r) * 16 + i16] = o[r]; }
    }
}

__device__ __forceinline__ void p_conv(Frame& F, const Args& A, float* xact) {
    const bf16* proj = (const bf16*)(A.ws + WS_B); const float* cw = A.in[5]; const float* cb = A.in[6];
    const int gt = F.vcu * 512 + F.tid, NT = F.G * 512;
    for (int i = gt; i < M * (DXBC / 4); i += NT) { const int m = i >> 8, c4 = (i & 255) * 4, t = m % T;
        f32x4 acc = *(const f32x4*)(cb + c4);
#pragma unroll
        for (int j = 0; j < 4; ++j) { const int tt = t - 3 + j; if (tt >= 0) { const u32x2 r = *(const u32x2*)(proj + (size_t)(m - 3 + j) * PW + PC_XS + c4); const f32x4 w = *(const f32x4*)(cw + j * DXBC + c4);
            acc[0] += w[0] * bf2f(r.x); acc[1] += w[1] * bf2f(r.x >> 16); acc[2] += w[2] * bf2f(r.y); acc[3] += w[3] * bf2f(r.y >> 16); } }
        f32x4 o; o[0] = silu_f(acc[0]); o[1] = silu_f(acc[1]); o[2] = silu_f(acc[2]); o[3] = silu_f(acc[3]);
        *(f32x4*)(xact + (size_t)m * DXBC + c4) = o; }
}
__device__ __forceinline__ void p_ssd_seq(Frame& F, const Args& A, const float* xact, float* ypre, int bh) {
    const float* dtf = (const float*)(A.ws + WS_DTF);
    const int b = bh / NH, h = bh % NH, g = h / 4, p = F.tid >> 3, nq = F.tid & 7;
    const float Ah = -expf(A.in[8][h]), Dh = A.in[9][h], dtb = A.in[7][h];
    float st[16];
#pragma unroll
    for (int i = 0; i < 16; ++i) st[i] = 0.f;
    for (int t = 0; t < T; ++t) {
        const size_t m = (size_t)b * T + t;
        const float dtv = softplus_f(dtf[m * 16 + h] + dtb), dA = expf(dtv * Ah);
        const float xv = xact[m * DXBC + h * 64 + p], xd = xv * dtv;
        const f32x4* Bp = (const f32x4*)(xact + m * DXBC + 512 + g * 128 + nq * 16);
        const f32x4* Cp = (const f32x4*)(xact + m * DXBC + 768 + g * 128 + nq * 16);
        float y = 0.f;
#pragma unroll
        for (int i = 0; i < 4; ++i) { const f32x4 bv = Bp[i], cv = Cp[i];
#pragma unroll
            for (int j = 0; j < 4; ++j) { st[i * 4 + j] = dA * st[i * 4 + j] + xd * bv[j]; y += cv[j] * st[i * 4 + j]; } }
        y += __shfl_xor(y, 1); y += __shfl_xor(y, 2); y += __shfl_xor(y, 4);
        if (nq == 0) ypre[m * DSSM + h * 64 + p] = y + Dh * xv;
    }
}
__device__ __forceinline__ void p_attn_norm(Frame& F, const Args& A) {
    const bf16* proj = (const bf16*)(A.ws + WS_B); bf16* ycat = (bf16*)(A.ws + WS_A); const float* ng = A.in[12];
    const int gw = F.vcu * NWAVES + F.wave, NGW = F.G * NWAVES, lane = F.lane;
    const f32x4 g0 = *(const f32x4*)(ng + lane * 8), g1 = *(const f32x4*)(ng + lane * 8 + 4);
    for (int m = gw; m < M; m += NGW) {
        const u32x4 r = *(const u32x4*)(proj + (size_t)m * PW + PC_Q + lane * 8);
        float v[8] = {bf2f(r.x), bf2f(r.x >> 16), bf2f(r.y), bf2f(r.y >> 16), bf2f(r.z), bf2f(r.z >> 16), bf2f(r.w), bf2f(r.w >> 16)}; float ss = 0.f;
#pragma unroll
        for (int j = 0; j < 8; ++j) ss += v[j] * v[j];
        const float rs = 1.f / sqrtf(wave_sum(ss) * (1.f / 512.f) + EPS);
        u32x4 o; o.x = pk2(v[0] * rs * g0[0], v[1] * rs * g0[1]); o.y = pk2(v[2] * rs * g0[2], v[3] * rs * g0[3]); o.z = pk2(v[4] * rs * g1[0], v[5] * rs * g1[1]); o.w = pk2(v[6] * rs * g1[2], v[7] * rs * g1[3]);
        *(u32x4*)(ycat + (size_t)m * D + 512 + lane * 8) = o; }
}
__device__ __forceinline__ void p_ssm_norm(Frame& F, const Args& A, const float* ypre) {
    const bf16* proj = (const bf16*)(A.ws + WS_B); bf16* ycat = (bf16*)(A.ws + WS_A); const float* ng = A.in[10];
    const int gw = F.vcu * NWAVES + F.wave, NGW = F.G * NWAVES, lane = F.lane;
    for (int w = gw; w < M * 2; w += NGW) { const int m = w >> 1, g = w & 1, c = g * 256 + lane * 4;
        const f32x4 y = *(const f32x4*)(ypre + (size_t)m * DSSM + c), gg = *(const f32x4*)(ng + c); const u32x2 z = *(const u32x2*)(proj + (size_t)m * PW + PC_Z + c);
        float v[4] = {y[0] * silu_f(bf2f(z.x)), y[1] * silu_f(bf2f(z.x >> 16)), y[2] * silu_f(bf2f(z.y)), y[3] * silu_f(bf2f(z.y >> 16))};
        const float rs = 1.f / sqrtf(wave_sum((v[0] * v[0] + v[1] * v[1]) + (v[2] * v[2] + v[3] * v[3])) * (1.f / 256.f) + EPS);
        u32x2 o; o.x = pk2(v[0] * rs * gg[0], v[1] * rs * gg[1]); o.y = pk2(v[2] * rs * gg[2], v[3] * rs * gg[3]);
        *(u32x2*)(ycat + (size_t)m * D + c) = o; }
}
template <bool DUMMY> __device__ __forceinline__ void p_ln1_router(Frame& F, const Args& A) {
    const float* x = A.in[0]; float* hx1 = A.out; const float* mod = (const float*)(A.ws + WS_MOD); const float* g1 = A.in[14]; const float* b1 = A.in[15];
    const float* rgw = A.in[16]; const float* rgb = A.in[17]; const float* rew = A.in[18]; const float* reb = A.in[19];
    bf16* u2 = (bf16*)(A.ws + WS_B); unsigned* cnt = (unsigned*)(A.ws + WS_CTL) + CW_CNT; int* list = (int*)(A.ws + WS_LIST); float* tokw = (float*)(A.ws + WS_TOKW);
    const int lane = F.lane; LAS f32x4* ub = (LAS f32x4*)(F.lds + RING_OFF + F.wave * 16384);
    const int gw = F.vcu * NWAVES + F.wave, NGW = F.G * NWAVES;
    for (int m0 = gw * 4; m0 < M; m0 += NGW * 4) {
        const float* mb = mod + (m0 / T) * 6144;
        float u[4][16]; float gl[4][4];
#pragma unroll
        for (int r = 0; r < 4; ++r) { const int m = m0 + r;
            float v[16]; float s = 0.f;
#pragma unroll
            for (int j = 0; j < 4; ++j) { const int c = 4 * lane + 256 * j; const f32x4 xv = *(const f32x4*)(x + (size_t)m * D + c), hv = *(const f32x4*)(hx1 + (size_t)m * D + c), gt = *(const f32x4*)(mb + 2 * D + c);
#pragma unroll
                for (int i = 0; i < 4; ++i) { v[j * 4 + i] = ALPHA * xv[i] + (1.f + gt[i]) * hv[i]; s += v[j * 4 + i]; } }
            const float mean = wave_sum(s) * (1.f / D); float s2 = 0.f;
#pragma unroll
            for (int i = 0; i < 16; ++i) { v[i] -= mean; s2 += v[i] * v[i]; }
            const float rstd = 1.f / sqrtf(wave_sum(s2) * (1.f / D) + EPS);
            float ga[4] = {0.f, 0.f, 0.f, 0.f};
#pragma unroll
            for (int j = 0; j < 4; ++j) { const int c = 4 * lane + 256 * j; const f32x4 gg = *(const f32x4*)(g1 + c), bb = *(const f32x4*)(b1 + c), sc = *(const f32x4*)(mb + 4 * D + c), sh = *(const f32x4*)(mb + 3 * D + c);
                f32x4 x1;
#pragma unroll
                for (int i = 0; i < 4; ++i) { x1[i] = v[j * 4 + i] * rstd * gg[i] + bb[i]; u[r][j * 4 + i] = x1[i] * (1.f + sc[i]) + sh[i]; }
                const size_t orow = DUMMY ? (size_t)(gw * 4 + r) : (size_t)m;
                *(f32x4*)((DUMMY ? (float*)(A.ws + WS_YK1) : hx1) + orow * D + c) = x1;
                u32x2 pk; pk.x = pk2(u[r][j * 4], u[r][j * 4 + 1]); pk.y = pk2(u[r][j * 4 + 2], u[r][j * 4 + 3]); *(u32x2*)((DUMMY ? (bf16*)(A.ws + WS_A) : u2) + orow * D + c) = pk;
#pragma unroll
                for (int i = 0; i < 4; ++i) { const f32x4 wg = *(const f32x4*)(rgw + (size_t)(c + i) * 4);
#pragma unroll
                    for (int q = 0; q < 4; ++q) ga[q] += u[r][j * 4 + i] * wg[q]; } }
#pragma unroll
            for (int q = 0; q < 4; ++q) gl[r][q] = wave_sum(ga[q]) + rgb[q];
        }
#pragma unroll
        for (int j = 0; j < 4; ++j)
#pragma unroll
            for (int i = 0; i < 4; ++i) ub[i * 256 + j * 64 + lane] = (f32x4){u[0][j * 4 + i], u[1][j * 4 + i], u[2][j * 4 + i], u[3][j * 4 + i]};
        LDS_WAIT(); asm volatile("" ::: "memory");
        f32x4 acc = {0.f, 0.f, 0.f, 0.f};
        { const int jx = lane & 31, half = lane >> 5;
          for (int i2 = 0; i2 < 2; ++i2) { const int i = half * 2 + i2;
            for (int jj = 0; jj < 4; ++jj) { const float* wp = rew + (size_t)(256 * jj + i) * 32 + jx; const LAS f32x4* up = ub + i * 256 + jj * 64;
#pragma unroll 8
                for (int l = 0; l < 64; ++l) { const float w = wp[(size_t)l * 128]; const f32x4 uv = up[l]; acc[0] += w * uv[0]; acc[1] += w * uv[1]; acc[2] += w * uv[2]; acc[3] += w * uv[3]; } } } }
#pragma unroll
        for (int r = 0; r < 4; ++r) acc[r] += __shfl_xor(acc[r], 32);
        LDS_WAIT(); asm volatile("" ::: "memory");
#pragma unroll
        for (int r = 0; r < 4; ++r) { const int m = m0 + r;
            float mx = gl[r][0]; int gi = 0;
#pragma unroll
            for (int i = 1; i < 4; ++i) if (gl[r][i] > mx) { mx = gl[r][i]; gi = i; }
            float se = 0.f;
#pragma unroll
            for (int i = 0; i < 4; ++i) se += expf(gl[r][i] - mx);
            const float gp = 1.f / se;
            const float mine = acc[r] + reb[lane & 31];
            float pe[8]; float mxe = -INFINITY;
#pragma unroll
            for (int i = 0; i < 8; ++i) { pe[i] = __shfl(mine, gi * 8 + i); mxe = fmaxf(mxe, pe[i]); }
#pragma unroll
            for (int i = 0; i < 8; ++i) pe[i] = expf(pe[i] - mxe);
            int i1 = 0; float p1 = -1.f;
#pragma unroll
            for (int i = 0; i < 8; ++i) if (pe[i] > p1) { p1 = pe[i]; i1 = i; }
            int i2 = 0; float p2 = -1.f;
#pragma unroll
            for (int i = 0; i < 8; ++i) if (i != i1 && pe[i] > p2) { p2 = pe[i]; i2 = i; }
            const float inv = 1.f / (p1 + p2);
            if (lane == 0 && !DUMMY) {
                const int e0 = gi * 8 + i1, e1 = gi * 8 + i2;
                const unsigned q0 = atomicAdd(&cnt[e0], 1u), q1 = atomicAdd(&cnt[e1], 1u);
                list[e0 * LCAP + q0] = m * 2; list[e1 * LCAP + q1] = m * 2 + 1;
                tokw[m * 2] = gp * p1 * inv; tokw[m * 2 + 1] = gp * p2 * inv;
            }
        }
    }
}
template <bool DUMMY> __device__ __forceinline__ void p_final(Frame& F, const Args& A) {
    float* out = A.out; const float* mod = (const float*)(A.ws + WS_MOD); const bf16* yk0 = (const bf16*)(A.ws + WS_A); const bf16* yk1 = (const bf16*)(A.ws + WS_YK1);
    const float* tokw = (const float*)(A.ws + WS_TOKW); const float* g2 = A.in[23]; const float* b2 = A.in[24];
    const int gw = F.vcu * NWAVES + F.wave, NGW = F.G * NWAVES, lane = F.lane;
    for (int m = gw; m < M; m += NGW) {
        const float* mb = mod + (m / T) * 6144; const float w0 = tokw[m * 2], w1 = tokw[m * 2 + 1];
        float v[16]; float s = 0.f;
#pragma unroll
        for (int j = 0; j < 4; ++j) { const int c = 4 * lane + 256 * j; const f32x4 xv = *(const f32x4*)(out + (size_t)m * D + c), gt = *(const f32x4*)(mb + 5 * D + c);
            const u32x2 a = *(const u32x2*)(yk0 + (size_t)m * D + c), bq = *(const u32x2*)(yk1 + (size_t)m * D + c);
            const float y0[4] = {bf2f(a.x), bf2f(a.x >> 16), bf2f(a.y), bf2f(a.y >> 16)}, y1[4] = {bf2f(bq.x), bf2f(bq.x >> 16), bf2f(bq.y), bf2f(bq.y >> 16)};
#pragma unroll
            for (int i = 0; i < 4; ++i) { v[j * 4 + i] = ALPHA * xv[i] + (1.f + gt[i]) * (w0 * y0[i] + w1 * y1[i]); s += v[j * 4 + i]; } }
        const float mean = wave_sum(s) * (1.f / D); float s2 = 0.f;
#pragma unroll
        for (int i = 0; i < 16; ++i) { v[i] -= mean; s2 += v[i] * v[i]; }
        const float rstd = 1.f / sqrtf(wave_sum(s2) * (1.f / D) + EPS);
#pragma unroll
        for (int j = 0; j < 4; ++j) { const int c = 4 * lane + 256 * j; const f32x4 gg = *(const f32x4*)(g2 + c), bb = *(const f32x4*)(b2 + c); f32x4 o;
#pragma unroll
            for (int i = 0; i < 4; ++i) o[i] = v[j * 4 + i] * rstd * gg[i] + bb[i];
            *(f32x4*)((DUMMY ? (float*)(A.ws + WS_B) + (size_t)gw * D : out + (size_t)m * D) + c) = o; }
    }
}

__global__ void __launch_bounds__(NWAVES * 64, 2) mk_fwd(Args args) {
    extern __shared__ __attribute__((aligned(16))) unsigned char lds[];
    Frame F;
    F.lds = (LAS unsigned char*)lds; F.MISC = (volatile LAS unsigned*)(F.lds + MISC_OFF);
    F.tid = threadIdx.x; F.lane = F.tid & 63; F.wave = __builtin_amdgcn_readfirstlane(F.tid >> 6);
    F.G = gridDim.x; { const int bx = blockIdx.x; F.vcu = (F.G % 8 == 0) ? (bx % 8) * (F.G / 8) + bx / 8 : bx; }
    F.ctl = (gu32*)(args.ws + WS_CTL);
    for (int u = F.tid; u < (LDS_BYTES - LDSCTL_OFF) / 4; u += NWAVES * 64) ((LAS unsigned*)(F.lds + LDSCTL_OFF))[u] = 0u;
    __syncthreads();
    XcdBarrier bar = xcd_barrier_post((unsigned*)(F.ctl + CW_BAR) + args.li * XCD_BAR_WORDS, F.MISC + 8);
    const int lo = args.ph_lo, hi = args.ph_hi;
#define IN(k) (lo <= (k) && (k) < hi)
#define BOTH(k) (IN(k) && IN((k) + 1))
#define GRID_BAR() do { xcd_barrier(bar); if (PROBE_REP & (1 << 13)) { xcd_barrier(bar); xcd_barrier(bar); } } while (0)
#ifndef PROBE_REP
#define PROBE_REP 0
#endif
#define REP(k, ...) do { __VA_ARGS__; if (PROBE_REP & (1 << (k))) { __syncthreads(); __VA_ARGS__; } } while (0)
#define FRESH(Fp) Frame Fp = F; { int t_ = threadIdx.x; asm volatile("" : "+v"(t_)); Fp.tid = t_; Fp.lane = t_ & 63; Fp.wave = __builtin_amdgcn_readfirstlane(t_ >> 6); }

    if (IN(0)) { FRESH(F0); REP(0, p0_prologue(F0, args)); if (BOTH(0)) GRID_BAR(); }
    if (IN(1)) { FRESH(F1); REP(1, p1_modulate(F1, args)); __syncthreads(); if (BOTH(1)) GRID_BAR(); }
    if (IN(2)) {
        pg8::Gemm g{(const bf16*)(args.ws + WS_A), (const bf16*)(args.ws + WS_WIN), D};
        pg8::StaticOrder S; S.init(M, PW, D, F.G, (int)blockIdx.x);
        pg8::EpiProj E{(bf16*)(args.ws + WS_B), PW, PC_Q, PC_K, QSCALE};
        REP(2, pg8::gemm_phase<pg8::EpiProj, pg8::StaticOrder, true>(F.lds + RING_OFF, g, S, E));
        { FRESH(F2); p2_dtf_tail(F2, args); }
        if (BOTH(2)) GRID_BAR();
    }
    if (IN(3)) {
        using namespace attn_body;
        char* shm = (char*)lds + RING_OFF;
        const float* dtf = (const float*)(args.ws + WS_DTF); const float* fg_bias = args.in[11];
        const attn_body::bf16* P = (const attn_body::bf16*)(args.ws + WS_B);
        LAS float* ckf = (LAS float*)(F.lds + RING_OFF + LDS_CKF); LAS float* wsum = (LAS float*)(F.lds + RING_OFF + LDS_WS);
        FRESH(F3);
        if (F.vcu < NB * NH * 4) {
            const int p = F.vcu; const int bh = p >> 2, s = p & 3, b = bh / NH, h = bh % NH;
            {
                const float fb = fg_bias[h]; float v[4]; float run = 0.f;
#pragma unroll
                for (int i = 0; i < 4; ++i) { const float f = dtf[(size_t)(b * T + F3.tid * 4 + i) * 16 + 8 + h] + fb; run += -softplus_f(-f); v[i] = run; }
                float incl = run; int ln = F3.lane; asm volatile("" : "+v"(ln));
#pragma unroll
                for (int o = 1; o < 64; o <<= 1) { const float t = __builtin_bit_cast(float, __builtin_amdgcn_ds_bpermute((ln - o) << 2, __builtin_bit_cast(int, incl))); if (ln >= o) incl += t; }
                if (ln == 63) wsum[F3.wave] = incl;
                LDS_WAIT(); __syncthreads();
                float off = incl - run;
                for (int w = 0; w < F3.wave; ++w) off += wsum[w];
#pragma unroll
                for (int i = 0; i < 4; ++i) ckf[F3.tid * 4 + i] = v[i] + off;
                LDS_WAIT(); __syncthreads();
            }
            if (PROBE_REP & (1 << 12)) { for (int j = 0; j < 2; ++j) attn_unit<8, true>(b, h, j ? s : 7 - s, P + PC_Q, P + PC_K, P + PC_V, (attn_body::bf16*)(args.ws + WS_A) + (size_t)F.vcu * 8192, shm); }
            for (int j = 0; j < 2; ++j) attn_unit<8>(b, h, j ? s : 7 - s, P + PC_Q, P + PC_K, P + PC_V, (attn_body::bf16*)(args.ws + WS_B) + PC_Q, shm);
        }
        __syncthreads();
        {
            const ssd::Bufs Bf{(const ::bf16*)(args.ws + WS_B), (const float*)(args.ws + WS_DTF), args.out, args.out + (size_t)M * DSSM, (::bf16*)(args.ws + WS_YK1), (::bf16*)(args.ws + WS_YK1 + 16 * MiB), (float*)(args.ws + WS_CK), (float*)(args.ws + WS_CK + 512 * 1024)};
            if (F.vcu < NB * ssd::NCH * NG) { const int u = F.vcu; for (int rep_ = 0; rep_ < ((PROBE_REP >> 3) & 1) + 1; ++rep_) ssd::chunk_unit(args, Bf, F.lds, u >> 5, (u >> 1) & 15, u & 1); }
        }
        if (BOTH(3)) GRID_BAR();
    }
    if (IN(4)) {
        const ssd::Bufs Bf{(const bf16*)(args.ws + WS_B), (const float*)(args.ws + WS_DTF), args.out, args.out + (size_t)M * DSSM, (bf16*)(args.ws + WS_YK1), (bf16*)(args.ws + WS_YK1 + 16 * MiB), (float*)(args.ws + WS_CK), (float*)(args.ws + WS_CK + 512 * 1024)};
        REP(4, ssd::state_pass(Bf, F.vcu, F.G));
        { FRESH(F4); REP(11, p_attn_norm(F4, args)); }
        if (BOTH(4)) GRID_BAR();
    }
    if (IN(5)) {
        const ssd::Bufs Bf{(const bf16*)(args.ws + WS_B), (const float*)(args.ws + WS_DTF), args.out, args.out + (size_t)M * DSSM, (bf16*)(args.ws + WS_YK1), (bf16*)(args.ws + WS_YK1 + 16 * MiB), (float*)(args.ws + WS_CK), (float*)(args.ws + WS_CK + 512 * 1024)};
        if (F.vcu < NB * ssd::NCH * NG) { const int u = F.vcu; REP(5, ssd::finalize_unit(args, Bf, F.lds, (bf16*)(args.ws + WS_A), u >> 5, (u >> 1) & 15, u & 1)); }
        if (BOTH(5)) GRID_BAR();
    }
    if (IN(6)) {
        pg8::Gemm g{(const bf16*)(args.ws + WS_A), (const bf16*)(args.ws + WS_WOUT), D};
        pg8::StaticOrder S; S.init(M, D, D, F.G, (int)blockIdx.x);
        pg8::EpiF32 E{args.out, D};
        REP(6, pg8::gemm_phase<pg8::EpiF32, pg8::StaticOrder, false>(F.lds + RING_OFF, g, S, E));
        if (BOTH(6)) GRID_BAR();
    }
    if (IN(7)) { FRESH(F7); if (PROBE_REP & (1 << 7)) { p_ln1_router<true>(F7, args); __syncthreads(); } p_ln1_router<false>(F7, args); __syncthreads(); REP(14, p0_convert(F7, args, P0_IWIN + P0_IWOUT, P0_NITEM_ALL));   if (BOTH(7)) GRID_BAR(); }
    if (IN(8) || IN(9)) {
        int tq_ = threadIdx.x; asm volatile("" : "+v"(tq_));
        LAS unsigned* tab = (LAS unsigned*)(F.lds + TAB_OFF); LAS unsigned* cnts = tab + 192;
        if (tq_ < NE) cnts[tq_] = __hip_atomic_load(F.ctl + CW_CNT + tq_, RLX_AGENT);
        LDS_WAIT(); __syncthreads();
        if (tq_ == 0) { int nt = 0; for (int e = 0; e < NE; ++e) { const int n = (int)cnts[e]; for (int r0 = 0; r0 < n && nt < 160; r0 += 256) tab[nt++] = (unsigned)e | ((unsigned)r0 << 8); } tab[191] = (unsigned)nt; }
        LDS_WAIT(); __syncthreads();
    }
    if (IN(8)) {
        const LAS unsigned* tab = (const LAS unsigned*)(F.lds + TAB_OFF);
        pg8::Gemm g{(const bf16*)(args.ws + WS_B), (const bf16*)(args.ws + WS_WGU), D};
        pg8::MoeOrder S{tab, tab + 192, (int)tab[191], F.G, (int)blockIdx.x, 0, (const int*)(args.ws + WS_LIST)};
        pg8::EpiMoe1 E{(bf16*)(args.ws + WS_B + 32 * MiB), DE};
        REP(8, pg8::gemm_phase<pg8::EpiMoe1, pg8::MoeOrder, true>(F.lds + RING_OFF, g, S, E));
        if (BOTH(8)) GRID_BAR();
    }
    if (IN(9)) {
        const LAS unsigned* tab = (const LAS unsigned*)(F.lds + TAB_OFF);
        pg8::Gemm g{(const bf16*)(args.ws + WS_B + 32 * MiB), (const bf16*)(args.ws + WS_WDN), DE};
        pg8::MoeOrder S{tab, tab + 192, (int)tab[191], F.G, (int)blockIdx.x, 1, (const int*)(args.ws + WS_LIST)};
        pg8::EpiMoe2 E{(bf16*)(args.ws + WS_A), (long)(WS_YK1 - WS_A), D, (const int*)(args.ws + WS_LIST)};
        REP(9, pg8::gemm_phase<pg8::EpiMoe2, pg8::MoeOrder, true>(F.lds + RING_OFF, g, S, E));
        if (BOTH(9)) GRID_BAR();
    }
    if (IN(10)) { FRESH(F10); if (PROBE_REP & (1 << 10)) { p_final<true>(F10, args); __syncthreads(); } p_final<false>(F10, args); }
#undef IN
#undef BOTH
}

static void launch_mk(const Args& base, int lo, int hi, int li, int grid, hipStream_t stream) {
    Args a = base; a.ph_lo = lo; a.ph_hi = hi; a.li = li; a.pad = 0;
    hipLaunchKernelGGL(mk_fwd, dim3(grid), dim3(NWAVES * 64), LDS_BYTES, stream, a);
    const hipError_t le = hipPeekAtLastError();
    if (le != hipSuccess) fprintf(stderr, "kernel_launch: launch [%d,%d) failed: %s\n", lo, hi, hipGetErrorName(le));
}
extern "C" void kernel_launch(void* const* d_in, const int* in_sizes, int n_in, void* d_out, int out_size, void* d_ws, size_t ws_size, hipStream_t stream) {
    static int grid = 0;
    if (grid == 0) {
        if (n_in != 25 || in_sizes[0] != M * D || out_size != M * D || ws_size < WS_END) { fprintf(stderr, "kernel_launch: unexpected shapes / workspace (%zu)\n", ws_size); grid = -1; return; }
        int dev = 0, cus = 0;
        if (hipGetDevice(&dev) != hipSuccess || hipDeviceGetAttribute(&cus, hipDeviceAttributeMultiprocessorCount, dev) != hipSuccess) { grid = -1; return; }
        if (hipFuncSetAttribute((const void*)mk_fwd, hipFuncAttributeMaxDynamicSharedMemorySize, LDS_BYTES) != hipSuccess) { fprintf(stderr, "kernel_launch: hipFuncSetAttribute failed\n"); grid = -1; return; }
        (void)hipGetLastError();
        grid = cus;
    }
    if (grid < 0) return;
    const float* x = (const float*)d_in[0];
    const float* conv_w = (const float*)d_in[5]; const float* conv_b = (const float*)d_in[6]; const float* dt_bias = (const float*)d_in[7];
    const float* a_log = (const float*)d_in[8]; const float* d_skip = (const float*)d_in[9]; const float* ssm_ng = (const float*)d_in[10]; const float* fg_bias = (const float*)d_in[11];
    const float* att_ng = (const float*)d_in[12]; const float* w_out = (const float*)d_in[13]; const float* ln1_g = (const float*)d_in[14]; const float* ln1_b = (const float*)d_in[15];
    const float* rgw = (const float*)d_in[16]; const float* rgb = (const float*)d_in[17]; const float* rew = (const float*)d_in[18]; const float* reb = (const float*)d_in[19];
    const float* w_gate = (const float*)d_in[20]; const float* w_up = (const float*)d_in[21]; const float* w_down = (const float*)d_in[22]; const float* ln2_g = (const float*)d_in[23]; const float* ln2_b = (const float*)d_in[24];
    unsigned char* ws = (unsigned char*)d_ws; float* out = (float*)d_out;
    unsigned* ctl = (unsigned*)(ws + WS_CTL); unsigned* cnt = ctl + CW_CNT;
    float* mod = (float*)(ws + WS_MOD); float* dtf = (float*)(ws + WS_DTF); float* ck = (float*)(ws + WS_CK);
    int* toke = (int*)(ws + WS_TOKE); float* tokw = (float*)(ws + WS_TOKW); int* toks = (int*)(ws + WS_TOKS); int* list = (int*)(ws + WS_LIST);
    bf16* proj = (bf16*)(ws + WS_B); bf16* ycat = (bf16*)(ws + WS_A); bf16* u2 = (bf16*)(ws + WS_B); bf16* hmid = (bf16*)(ws + WS_B + 32 * MiB);
    bf16* yk0 = (bf16*)(ws + WS_A); bf16* yk1 = (bf16*)(ws + WS_YK1); float* ypre = (float*)(ws + WS_YK1); float* xact = out;

    if (hipMemsetAsync(ws + WS_CTL, 0, CTL_ZERO_BYTES, stream) != hipSuccess) return;
    Args a{};
    for (int i = 0; i < 25; ++i) a.in[i] = (const float*)d_in[i];
    a.out = out; a.ws = ws;
    launch_mk(a, 0, 11, 0, grid, stream);
}
```
